# Optimizing an MI355X kernel written in HIP

```python
import math, functools
import jax
import jax.numpy as jnp
from jax import lax
import numpy as np

D_MODEL = 1024
BATCH = 4
SEQ = 8192
DEPTH = 2

GRID_W = 64
CTX_LEN = 256
N_MIXERS = 4
D_MIX = D_MODEL
D_GROUP = D_MIX // N_MIXERS
CHUNK = 64
SHORT_CONV = 3
N_DIR = 2
EPS = 1e-6
N_MOD = 6

GLA_HEADS = 4
GLA_DK = D_GROUP // (2 * GLA_HEADS)
GLA_DV = D_GROUP // GLA_HEADS
GLA_RANK = 16
GLA_TAU = 16.0

HY_ORDER = 2
HY_EMB = 33
HY_BANDS = (HY_EMB - 1) // 2
HY_FILTER_HIDDEN = 64
HY_DECAY_TARGET = 1e-2
HY_FAST_DECAY = 0.3
HY_SLOW_DECAY = 1.5

MB_HEADS = 4
MB_HEADDIM = D_GROUP // MB_HEADS
MB_STATE = 128
MB_GROUPS = 2
MB_CONV_CH = D_GROUP + 2 * MB_GROUPS * MB_STATE

DN_HEADS = 4
DN_DK = D_GROUP // DN_HEADS
DN_DV = D_GROUP // DN_HEADS

N_EXPERTS = 16
EC_CAPACITY = 2
D_EXPERT = 1024

GLA_COLS = 2 * GLA_HEADS * GLA_DK + 2 * D_GROUP + N_DIR * GLA_RANK
HY_COLS = (HY_ORDER + 1) * D_GROUP
MB_COLS = D_GROUP + MB_CONV_CH + N_DIR * MB_HEADS
DN_COLS = 4 * D_GROUP + 2 * N_DIR * DN_HEADS
D_IN_PROJ = GLA_COLS + HY_COLS + MB_COLS + DN_COLS

kernel_name = 'hybrid_parallel_heads_ec_moe_diffusion'

F32 = jnp.float32


def rmsnorm(x, w):
    xf = x.astype(F32)
    y = xf * lax.rsqrt(jnp.mean(xf * xf, axis=-1, keepdims=True) + EPS)
    return (y * w.astype(F32)).astype(x.dtype)


def head_rmsnorm(o, w, n_heads):
    b_, l_, hd = o.shape
    oh = o.reshape(b_, l_, n_heads, hd // n_heads)
    oh = oh * lax.rsqrt(jnp.mean(oh * oh, axis=-1, keepdims=True) + EPS)
    return oh.reshape(b_, l_, hd) * w.astype(F32)


def l2norm(t):
    return t * lax.rsqrt(jnp.sum(t * t, axis=-1, keepdims=True) + EPS)


def to_heads(t, n_heads):
    b_, l_, hd = t.shape
    return t.reshape(b_, l_, n_heads, hd // n_heads).transpose(0, 2, 1, 3).astype(F32)


def from_heads(t):
    b_, h_, l_, d_ = t.shape
    return t.transpose(0, 2, 1, 3).reshape(b_, l_, h_ * d_)


def to_col_major(u, rows):
    b_, l_, ch = u.shape
    return u.reshape(b_, rows, GRID_W, ch).transpose(0, 2, 1, 3).reshape(b_, l_, ch)


def to_row_major(u, rows):
    b_, l_, ch = u.shape
    return u.reshape(b_, GRID_W, rows, ch).transpose(0, 2, 1, 3).reshape(b_, l_, ch)


def short_conv(u, w, b=None):
    k_, ch = w.shape
    y = lax.conv_general_dilated(u, w[:, None, :].astype(u.dtype), window_strides=(1,),
                                 padding=[(k_ // 2, k_ // 2)], dimension_numbers=('NWC', 'WIO', 'NWC'),
                                 feature_group_count=ch)
    if b is not None:
        y = y + b.astype(u.dtype)
    return y


def modulation(cond, w_mod, b_mod):
    m = jax.nn.silu(cond.astype(F32)) @ w_mod.astype(F32) + b_mod.astype(F32)
    return jnp.split(m, N_MOD, axis=-1)


def modulate(x, g, shift, scale):
    return (rmsnorm(x, g).astype(F32) * (1.0 + scale) + shift).astype(x.dtype)


def bidirectional_scan(scan_f, scan_b, ctx_in, lat_in, s0, t_axis, need_ctx):
    rev = lambda ts: tuple(jnp.flip(t, t_axis) for t in ts)
    oc_f, s_f = scan_f(*ctx_in[0], s0)
    oc_b, s_b = scan_b(*rev(ctx_in[1]), s0)
    ol_f, _ = scan_f(*lat_in[0], s_f)
    ol_b, _ = scan_b(*rev(lat_in[1]), s_b)
    o_lat = ol_f + jnp.flip(ol_b, t_axis)
    o_ctx = (oc_f + jnp.flip(oc_b, t_axis)) if need_ctx else None
    return o_ctx, o_lat


def gla_scan(q, k, v, g, s0):
    b_, h_, l_, dk = q.shape
    dv = v.shape[-1]
    n = l_ // CHUNK
    q, k, v, g = [t.reshape(b_, h_, n, CHUNK, t.shape[-1]) for t in (q, k, v, g)]
    cum = jnp.cumsum(g, axis=-2)
    cum_last = cum[..., -1:, :]
    q_g = q * jnp.exp(cum)
    k_g = k * jnp.exp(-cum)
    k_end = k * jnp.exp(cum_last - cum)
    causal = jnp.tril(jnp.ones((CHUNK, CHUNK), bool))
    attn = jnp.where(causal, jnp.einsum('bhnid,bhnjd->bhnij', q_g, k_g), 0.0)
    o_intra = jnp.einsum('bhnij,bhnjv->bhniv', attn, v)
    chunk_decay = jnp.exp(cum_last[..., 0, :])

    def step(s, inp):
        qg, ke, vv, dec = inp
        o = jnp.einsum('bhcd,bhdv->bhcv', qg, s)
        s = s * dec[..., None] + jnp.einsum('bhcd,bhcv->bhdv', ke, vv)
        return s, o

    xs = tuple(jnp.moveaxis(t, 2, 0) for t in (q_g, k_end, v, chunk_decay))
    s_fin, o_inter = lax.scan(step, s0, xs)
    o = o_intra + jnp.moveaxis(o_inter, 0, 2)
    return o.reshape(b_, h_, l_, dv), s_fin


def gla_mixer(u_ctx, u_lat, w2, b, norm_w, need_ctx):
    nq = GLA_HEADS * GLA_DK

    def prep(u):
        q, k, v, og, lr = jnp.split(u, [nq, 2 * nq, 2 * nq + D_GROUP, 2 * nq + 2 * D_GROUP], axis=-1)
        q = to_heads(q, GLA_HEADS) * GLA_DK ** -0.5
        k = to_heads(k, GLA_HEADS)
        v = to_heads(v, GLA_HEADS)
        lr = lr.astype(F32).reshape(lr.shape[0], lr.shape[1], N_DIR, GLA_RANK)
        z = jnp.einsum('blsr,srk->blsk', lr, w2.astype(F32)) + b.astype(F32)
        log_alpha = jax.nn.log_sigmoid(z) / GLA_TAU
        g_f = to_heads(log_alpha[:, :, 0], GLA_HEADS)
        g_b = to_heads(log_alpha[:, :, 1], GLA_HEADS)
        return ((q, k, v, g_f), (q, k, v, g_b)), og

    ctx_in, og_c = prep(u_ctx)
    lat_in, og_l = prep(u_lat)
    s0 = jnp.zeros((u_lat.shape[0], GLA_HEADS, GLA_DK, GLA_DV), F32)
    o_c, o_l = bidirectional_scan(gla_scan, gla_scan, ctx_in, lat_in, s0, 2, need_ctx)

    def out(o, og):
        return (head_rmsnorm(from_heads(o), norm_w, GLA_HEADS) * jax.nn.silu(og.astype(F32))).astype(u_lat.dtype)

    return (out(o_c, og_c) if need_ctx else None), out(o_l, og_l)


def hyena_filters(l_, w1, b1, w2, b2, w3, b3, w4, freq):
    pos = jnp.arange(l_, dtype=F32)
    t = pos / max(l_ - 1, 1)
    bands = jnp.linspace(1e-4, HY_BANDS - 1, HY_BANDS, dtype=F32)
    ang = (2.0 * math.pi / l_) * pos[:, None] * bands[None, :]
    feats = jnp.concatenate([t[:, None], jnp.cos(ang), -jnp.sin(ang)], axis=-1)
    f = freq.astype(F32)
    h = jnp.sin(f[0] * (feats @ w1.astype(F32) + b1.astype(F32)))
    h = jnp.sin(f[1] * (h @ w2.astype(F32) + b2.astype(F32)))
    h = jnp.sin(f[2] * (h @ w3.astype(F32) + b3.astype(F32)))
    h = h @ w4.astype(F32)
    max_decay = math.log(HY_DECAY_TARGET) / HY_FAST_DECAY
    min_decay = math.log(HY_DECAY_TARGET) / HY_SLOW_DECAY
    deltas = jnp.abs(jnp.linspace(min_decay, max_decay, D_GROUP, dtype=F32))
    window = jnp.exp(-t[:, None] * deltas[None, :])
    return h.reshape(l_, HY_ORDER, N_DIR, D_GROUP) * window[:, None, None, :]


def long_conv(u, h_fwd, h_bwd, d_skip):
    l_, ch = h_fwd.shape
    kern = jnp.concatenate([h_fwd, jnp.zeros((1, ch), F32), jnp.flip(h_bwd[1:], 0)], axis=0)
    spec = jnp.fft.rfft(u, n=2 * l_, axis=1) * jnp.fft.rfft(kern, axis=0)[None]
    y = jnp.fft.irfft(spec, n=2 * l_, axis=1)[:, :l_]
    return y + u * d_skip


def hyena_mixer(u_ctx, u_lat, conv_w, conv_b, w1, b1, w2, b2, w3, b3, w4, freq, d_skip, need_ctx):
    d = d_skip.astype(F32)

    def run(u):
        l_ = u.shape[1]
        uc = short_conv(u, conv_w, conv_b).astype(F32)
        v, x1, x2 = jnp.split(uc, [D_GROUP, 2 * D_GROUP], axis=-1)
        h = hyena_filters(l_, w1, b1, w2, b2, w3, b3, w4, freq)
        z = x1 * long_conv(v, h[:, 0, 0], h[:, 0, 1], d[0])
        return (x2 * long_conv(z, h[:, 1, 0], h[:, 1, 1], d[1])).astype(u.dtype)

    return (run(u_ctx) if need_ctx else None), run(u_lat)


def ssd_scan(x, dt, bm, cm, s0, a):
    b_, l_, h_, p_ = x.shape
    g_, n_ = bm.shape[-2:]
    r_ = h_ // g_
    n = l_ // CHUNK
    cum = jnp.cumsum((dt * a).reshape(b_, n, CHUNK, g_, r_), axis=2)
    xdt = (x * dt[..., None]).reshape(b_, n, CHUNK, g_, r_, p_)
    bc = bm.reshape(b_, n, CHUNK, g_, n_)
    cc = cm.reshape(b_, n, CHUNK, g_, n_)
    cum_t = jnp.moveaxis(cum, 2, -1)
    causal = jnp.tril(jnp.ones((CHUNK, CHUNK), bool))
    seg = jnp.exp(jnp.where(causal, cum_t[..., :, None] - cum_t[..., None, :], -jnp.inf))
    cb = jnp.einsum('bnigs,bnjgs->bngij', cc, bc)
    y_diag = jnp.einsum('bngij,bngrij,bnjgrp->bnigrp', cb, seg, xdt)
    to_end = jnp.exp(cum[:, :, -1:] - cum)
    states = jnp.einsum('bncgs,bncgr,bncgrp->bngrsp', bc, to_end, xdt)
    chunk_decay = jnp.exp(cum[:, :, -1])
    c_dec = jnp.exp(cum)

    def step(s, inp):
        c_i, cd_i, st_i, dec_i = inp
        y_off = jnp.einsum('bcgs,bcgr,bgrsp->bcgrp', c_i, cd_i, s)
        s = s * dec_i[..., None, None] + st_i
        return s, y_off

    xs = tuple(jnp.moveaxis(t, 1, 0) for t in (cc, c_dec, states, chunk_decay))
    s_fin, y_off = lax.scan(step, s0, xs)
    y = y_diag + jnp.moveaxis(y_off, 0, 1)
    return y.reshape(b_, l_, h_, p_), s_fin


def mamba_mixer(u_ctx, u_lat, conv_w, conv_b, a_log, dt_bias, d_skip, norm_w, rows, need_ctx):
    nx = MB_HEADS * MB_HEADDIM
    nbc = MB_GROUPS * MB_STATE

    def prep(u):
        b_, l_, _ = u.shape
        z, xbc, dt_raw = jnp.split(u, [D_GROUP, D_GROUP + MB_CONV_CH], axis=-1)
        xbc = jax.nn.silu(short_conv(xbc, conv_w, conv_b)).astype(F32)
        xs, bm, cm = jnp.split(xbc, [nx, nx + nbc], axis=-1)
        xs = xs.reshape(b_, l_, MB_HEADS, MB_HEADDIM)
        bm = bm.reshape(b_, l_, MB_GROUPS, MB_STATE)
        cm = cm.reshape(b_, l_, MB_GROUPS, MB_STATE)
        dt = jax.nn.softplus(dt_raw.astype(F32).reshape(b_, l_, N_DIR, MB_HEADS) + dt_bias.astype(F32))
        return ((xs, dt[:, :, 0], bm, cm), (xs, dt[:, :, 1], bm, cm)), xs, z

    u_lat = to_col_major(u_lat, rows)
    ctx_in, x_c, z_c = prep(u_ctx)
    lat_in, x_l, z_l = prep(u_lat)
    a = -jnp.exp(a_log.astype(F32))
    s0 = jnp.zeros((u_lat.shape[0], MB_GROUPS, MB_HEADS // MB_GROUPS, MB_STATE, MB_HEADDIM), F32)
    o_c, o_l = bidirectional_scan(functools.partial(ssd_scan, a=a[0]), functools.partial(ssd_scan, a=a[1]),
                                  ctx_in, lat_in, s0, 1, need_ctx)
    d = d_skip.astype(F32)

    def out(o, xs, z):
        y = (o + xs * d[:, None]).reshape(o.shape[0], o.shape[1], D_GROUP)
        return head_rmsnorm(y * jax.nn.silu(z.astype(F32)), norm_w, MB_HEADS).astype(u_lat.dtype)

    y_l = to_row_major(out(o_l, x_l, z_l), rows)
    return (out(o_c, x_c, z_c) if need_ctx else None), y_l


def delta_scan(q, k, v, beta, g, s0):
    b_, h_, l_, dk = q.shape
    dv = v.shape[-1]
    n = l_ // CHUNK
    q, k, v = [t.reshape(b_, h_, n, CHUNK, t.shape[-1]) for t in (q, k, v)]
    beta = beta.reshape(b_, h_, n, CHUNK)
    cum = jnp.cumsum(g.reshape(b_, h_, n, CHUNK), axis=-1)
    incl = jnp.tril(jnp.ones((CHUNK, CHUNK), bool))
    strict = jnp.tril(jnp.ones((CHUNK, CHUNK), bool), -1)
    decay = jnp.exp(jnp.where(incl, cum[..., :, None] - cum[..., None, :], -jnp.inf))
    k_beta = k * beta[..., None]
    m = jnp.where(strict, jnp.einsum('bhnid,bhnjd->bhnij', k_beta, k) * decay, 0.0)
    rhs = jnp.concatenate([v * beta[..., None], k_beta * jnp.exp(cum)[..., None]], axis=-1)
    sol = lax.linalg.triangular_solve(m + jnp.eye(CHUNK, dtype=m.dtype), rhs, left_side=True, lower=True,
                                      unit_diagonal=True)
    u_val, w_key = sol[..., :dv], sol[..., dv:]
    attn = jnp.where(incl, jnp.einsum('bhnid,bhnjd->bhnij', q, k) * decay, 0.0)
    q_dec = q * jnp.exp(cum)[..., None]
    k_end = k * jnp.exp(cum[..., -1:] - cum)[..., None]
    chunk_decay = jnp.exp(cum[..., -1])

    def step(s, inp):
        qd, ke, uu, ww, aa, dc = inp
        v_new = uu - jnp.einsum('bhcd,bhdv->bhcv', ww, s)
        o = jnp.einsum('bhcd,bhdv->bhcv', qd, s) + jnp.einsum('bhcs,bhsv->bhcv', aa, v_new)
        s = s * dc[..., None, None] + jnp.einsum('bhcd,bhcv->bhdv', ke, v_new)
        return s, o

    xs = tuple(jnp.moveaxis(t, 2, 0) for t in (q_dec, k_end, u_val, w_key, attn, chunk_decay))
    s_fin, o = lax.scan(step, s0, xs)
    return jnp.moveaxis(o, 0, 2).reshape(b_, h_, l_, dv), s_fin


def deltanet_mixer(u_ctx, u_lat, conv_w, a_log, dt_bias, norm_w, need_ctx):
    nqk = DN_HEADS * DN_DK
    nv = DN_HEADS * DN_DV

    def prep(u):
        b_, l_, _ = u.shape
        qkv, og, beta_raw, a_raw = jnp.split(u, [2 * nqk + nv, 2 * nqk + 2 * nv, 2 * nqk + 2 * nv + N_DIR * DN_HEADS],
                                             axis=-1)
        qkv = jax.nn.silu(short_conv(qkv, conv_w))
        q, k, v = jnp.split(qkv, [nqk, 2 * nqk], axis=-1)
        q = l2norm(to_heads(q, DN_HEADS)) * DN_DK ** -0.5
        k = l2norm(to_heads(k, DN_HEADS))
        v = to_heads(v, DN_HEADS)
        beta = jax.nn.sigmoid(beta_raw.astype(F32)).reshape(b_, l_, N_DIR, DN_HEADS).transpose(2, 0, 3, 1)
        g = -jnp.exp(a_log.astype(F32)) * jax.nn.softplus(
            a_raw.astype(F32).reshape(b_, l_, N_DIR, DN_HEADS) + dt_bias.astype(F32))
        g = g.transpose(2, 0, 3, 1)
        return ((q, k, v, beta[0], g[0]), (q, k, v, beta[1], g[1])), og

    ctx_in, og_c = prep(u_ctx)
    lat_in, og_l = prep(u_lat)
    s0 = jnp.zeros((u_lat.shape[0], DN_HEADS, DN_DK, DN_DV), F32)
    o_c, o_l = bidirectional_scan(delta_scan, delta_scan, ctx_in, lat_in, s0, 2, need_ctx)

    def out(o, og):
        return (head_rmsnorm(from_heads(o), norm_w, DN_HEADS) * jax.nn.silu(og.astype(F32))).astype(u_lat.dtype)

    return (out(o_c, og_c) if need_ctx else None), out(o_l, og_l)


def ec_moe(h, router, w_gate, w_up, w_down):
    b_, t_, d_ = h.shape
    cap = EC_CAPACITY * t_ // N_EXPERTS
    aff = jax.nn.softmax(jnp.einsum('btd,de->bte', h, router).astype(F32), axis=-1)
    weight, idx = lax.top_k(jnp.swapaxes(aff, 1, 2), cap)
    xs = jax.vmap(lambda hb, ib: hb[ib])(h, idx)
    a = jnp.einsum('becd,edf->becf', xs, w_gate)
    u = jnp.einsum('becd,edf->becf', xs, w_up)
    y = jnp.einsum('becf,efd->becd', jax.nn.silu(a) * u, w_down) * weight[..., None].astype(h.dtype)
    scatter = lambda ib, yb: jnp.zeros((t_, d_), h.dtype).at[ib.reshape(-1)].add(yb.reshape(-1, d_))
    return jax.vmap(scatter)(idx, y)


def setup_inputs(seed: int = 0) -> dict:
    key = jax.random.key(seed)
    keys = iter(jax.random.split(key, 48))

    def nrm(shape, scale):
        return jax.random.normal(next(keys), shape, F32) * scale

    def gains(shape):
        return 1.0 + nrm(shape, 0.05)

    def a_log(shape):
        return jnp.log(jax.random.uniform(next(keys), shape, F32, 1.0, 16.0))

    def dt_bias(shape):
        dt = jnp.exp(jax.random.uniform(next(keys), shape, F32, math.log(1e-3), math.log(1e-1)))
        return dt + jnp.log(-jnp.expm1(-dt))

    d = D_MODEL
    hf = HY_FILTER_HIDDEN
    return {
        'x': nrm((BATCH, SEQ, d), 1.0),
        'c': nrm((BATCH, d), 1.0),
        'ctx': nrm((BATCH, CTX_LEN, d), 1.0),
        'c_ctx': nrm((d,), 1.0),
        'w_mod': nrm((DEPTH, d, N_MOD * d), 0.5 * d ** -0.5),
        'b_mod': nrm((DEPTH, N_MOD * d), 0.02),
        'norm_g': gains((DEPTH, 4, d)),
        'w_in': nrm((DEPTH, d, D_IN_PROJ), d ** -0.5),
        'w_out': nrm((DEPTH, D_MIX, d), D_MIX ** -0.5),
        'gla_w2': nrm((DEPTH, N_DIR, GLA_RANK, GLA_HEADS * GLA_DK), GLA_RANK ** -0.5),
        'gla_b': nrm((DEPTH, N_DIR, GLA_HEADS * GLA_DK), 0.1),
        'gla_norm': gains((DEPTH, D_GROUP)),
        'hy_conv_w': nrm((DEPTH, SHORT_CONV, HY_COLS), SHORT_CONV ** -0.5),
        'hy_conv_b': nrm((DEPTH, HY_COLS), 0.02),
        'hy_w1': nrm((DEPTH, HY_EMB, hf), HY_EMB ** -0.5),
        'hy_b1': nrm((DEPTH, hf), 0.1),
        'hy_w2': nrm((DEPTH, hf, hf), hf ** -0.5),
        'hy_b2': nrm((DEPTH, hf), 0.1),
        'hy_w3': nrm((DEPTH, hf, hf), hf ** -0.5),
        'hy_b3': nrm((DEPTH, hf), 0.1),
        'hy_w4': nrm((DEPTH, hf, HY_ORDER * N_DIR * D_GROUP), 0.1 * hf ** -0.5),
        'hy_freq': gains((DEPTH, 3, hf)),
        'hy_d': nrm((DEPTH, HY_ORDER, D_GROUP), 1.0),
        'mb_conv_w': nrm((DEPTH, SHORT_CONV, MB_CONV_CH), SHORT_CONV ** -0.5),
        'mb_conv_b': nrm((DEPTH, MB_CONV_CH), 0.02),
        'mb_a_log': a_log((DEPTH, N_DIR, MB_HEADS)),
        'mb_dt_bias': dt_bias((DEPTH, N_DIR, MB_HEADS)),
        'mb_d': gains((DEPTH, MB_HEADS)),
        'mb_norm': gains((DEPTH, D_GROUP)),
        'dn_conv_w': nrm((DEPTH, SHORT_CONV, 2 * DN_HEADS * DN_DK + DN_HEADS * DN_DV), SHORT_CONV ** -0.5),
        'dn_a_log': a_log((DEPTH, N_DIR, DN_HEADS)),
        'dn_dt_bias': dt_bias((DEPTH, N_DIR, DN_HEADS)),
        'dn_norm': gains((DEPTH, D_GROUP)),
        'moe_router': nrm((DEPTH, d, N_EXPERTS), d ** -0.5),
        'moe_w_gate': nrm((DEPTH, N_EXPERTS, d, D_EXPERT), d ** -0.5),
        'moe_w_up': nrm((DEPTH, N_EXPERTS, d, D_EXPERT), d ** -0.5),
        'moe_w_down': nrm((DEPTH, N_EXPERTS, D_EXPERT, d), D_EXPERT ** -0.5),
    }


def reference(x, c, ctx, c_ctx, w_mod, b_mod, norm_g, w_in, w_out, gla_w2, gla_b, gla_norm,
              hy_conv_w, hy_conv_b, hy_w1, hy_b1, hy_w2, hy_b2, hy_w3, hy_b3, hy_w4, hy_freq, hy_d,
              mb_conv_w, mb_conv_b, mb_a_log, mb_dt_bias, mb_d, mb_norm,
              dn_conv_w, dn_a_log, dn_dt_bias, dn_norm,
              moe_router, moe_w_gate, moe_w_up, moe_w_down):
    rows = x.shape[1] // GRID_W
    xc = ctx
    splits = [GLA_COLS, GLA_COLS + HY_COLS, GLA_COLS + HY_COLS + MB_COLS]
    for i in range(DEPTH):
        need_ctx = i < DEPTH - 1
        sh1, sc1, g1, sh2, sc2, g2 = [t[:, None, :] for t in modulation(c, w_mod[i], b_mod[i])]
        sh1c, sc1c, g1c, sh2c, sc2c, g2c = modulation(c_ctx, w_mod[i], b_mod[i])

        u_l = modulate(x, norm_g[i, 0], sh1, sc1) @ w_in[i]
        u_c = modulate(xc, norm_g[i, 0], sh1c, sc1c) @ w_in[i]
        ua_c, ub_c, uc_c, ud_c = jnp.split(u_c, splits, axis=-1)
        ua_l, ub_l, uc_l, ud_l = jnp.split(u_l, splits, axis=-1)
        ya_c, ya_l = gla_mixer(ua_c, ua_l, gla_w2[i], gla_b[i], gla_norm[i], need_ctx)
        yb_c, yb_l = hyena_mixer(ub_c, ub_l, hy_conv_w[i], hy_conv_b[i], hy_w1[i], hy_b1[i], hy_w2[i], hy_b2[i],
                                 hy_w3[i], hy_b3[i], hy_w4[i], hy_freq[i], hy_d[i], need_ctx)
        yc_c, yc_l = mamba_mixer(uc_c, uc_l, mb_conv_w[i], mb_conv_b[i], mb_a_log[i], mb_dt_bias[i], mb_d[i],
                                 mb_norm[i], rows, need_ctx)
        yd_c, yd_l = deltanet_mixer(ud_c, ud_l, dn_conv_w[i], dn_a_log[i], dn_dt_bias[i], dn_norm[i], need_ctx)
        y_l = jnp.concatenate([ya_l, yb_l, yc_l, yd_l], axis=-1) @ w_out[i]
        x = x + (g1 * rmsnorm(y_l, norm_g[i, 1]).astype(F32)).astype(x.dtype)

        h_l = modulate(x, norm_g[i, 2], sh2, sc2)
        m_l = ec_moe(h_l, moe_router[i], moe_w_gate[i], moe_w_up[i], moe_w_down[i])
        x = x + (g2 * rmsnorm(m_l, norm_g[i, 3]).astype(F32)).astype(x.dtype)

        if need_ctx:
            y_c = jnp.concatenate([ya_c, yb_c, yc_c, yd_c], axis=-1) @ w_out[i]
            xc = xc + (g1c * rmsnorm(y_c, norm_g[i, 1]).astype(F32)).astype(xc.dtype)
            h_c = modulate(xc, norm_g[i, 2], sh2c, sc2c)
            m_c = ec_moe(h_c, moe_router[i], moe_w_gate[i], moe_w_up[i], moe_w_down[i])
            xc = xc + (g2c * rmsnorm(m_c, norm_g[i, 3]).astype(F32)).astype(xc.dtype)
    return x
```

```cpp
#include <hip/hip_runtime.h>
#include <hip/hip_cooperative_groups.h>
#include <stdint.h>
#include <stdio.h>

typedef unsigned short bf16_t;
using bf16x8 = __attribute__((ext_vector_type(8))) short;
using f32x4 = __attribute__((ext_vector_type(4))) float;

constexpr int D = 1024, NB = 4, SEQ = 8192, CTX = 256, DEPTH = 2;
constexpr int TL = NB * SEQ, TC = NB * CTX, TT = TL + TC;
constexpr int NUS = 3640, NU = 3840, NUP = 3840;
constexpr int NE = 16, CAP_L = 1024, CAP_C = 32, SLOTS_E = NB * CAP_L + 256, NSLOT = NE * SLOTS_E;
constexpr int NT = 512, NW = NT / 64;
constexpr int U_GLA = 0, U_HY = 800, U_MB = 1568, U_DN = 2600;

struct Params {
  const float *x, *c, *ctx, *c_ctx, *w_mod, *b_mod, *norm_g, *w_in, *w_out, *gla_w2, *gla_b, *gla_norm,
      *hy_conv_w, *hy_conv_b, *hy_w1, *hy_b1, *hy_w2, *hy_b2, *hy_w3, *hy_b3, *hy_w4, *hy_freq, *hy_d,
      *mb_conv_w, *mb_conv_b, *mb_a_log, *mb_dt_bias, *mb_d, *mb_norm, *dn_conv_w, *dn_a_log, *dn_dt_bias, *dn_norm,
      *moe_router, *moe_w_gate, *moe_w_up, *moe_w_down;
  float* out;
  bf16_t *win_t, *wout_t, *wgu_t, *wdn_t, *hb, *prep, *u, *y, *act, *ymoe;
  float *mod, *xc, *aff, *slot_w, *dt, *bg, *filt, *filtc, *obuf, *zbuf; bf16_t* yo;
  int *slot_tok, *tok_slot;
  bf16_t* gla_l; float* gla_dec;
  bf16_t* mb_l; float* mb_dec;
  bf16_t *dn_m, *dn_l;
  float* yt;
  unsigned* bar;
  float2* specg;
};

typedef const __attribute__((address_space(4))) Params CParams;

__device__ __forceinline__ bf16_t f2bf(float f) { unsigned u = __float_as_uint(f); u += 0x7fffu + ((u >> 16) & 1u); return (bf16_t)(u >> 16); }
__device__ __forceinline__ float bf2f(bf16_t h) { return __uint_as_float(((unsigned)h) << 16); }
__device__ __forceinline__ float siluf(float v) { return v / (1.f + __expf(-v)); }
__device__ __forceinline__ float sigmoidf_(float v) { return 1.f / (1.f + __expf(-v)); }
__device__ __forceinline__ float softplusf_(float v) { const float e = __expf(v); return v > 15.f ? v : (v < -8.f ? e : __logf(1.f + e)); }
__device__ __forceinline__ float logsigmoidf_(float z) { return -softplusf_(-z); }
__device__ __forceinline__ float wave_sum(float v) {
#pragma unroll
  for (int o = 32; o > 0; o >>= 1) v += __shfl_xor(v, o);
  return v;
}
__device__ __forceinline__ float rdlane(float v, int l) { return __int_as_float(__builtin_amdgcn_readlane(__float_as_int(v), l)); }
__device__ __forceinline__ float* xrow_ptr(CParams& p, int row) { return row < TL ? p.out + (size_t)row * D : p.xc + (size_t)(row - TL) * D; }
__device__ __forceinline__ int mod_idx(int row) { return row < TL ? row / SEQ : 4; }

__device__ __forceinline__ int seq_nb(int row, int delta, bool mamba) {
  if (row < TL) {
    int b = row / SEQ, t = row % SEQ;
    if (mamba) { int pos = (t & 63) * 128 + (t >> 6) + delta; if (pos < 0 || pos >= SEQ) return -1; return b * SEQ + (pos & 127) * 64 + (pos >> 7); }
    int t2 = t + delta; if (t2 < 0 || t2 >= SEQ) return -1; return b * SEQ + t2;
  }
  int r = row - TL, b = r / CTX, t = r % CTX + delta; if (t < 0 || t >= CTX) return -1; return TL + b * CTX + t;
}

__device__ __forceinline__ void conv8(const bf16_t* u, int ucol, int row, int rm, int rp, const float* w, const float* bias, int c, float (&o)[8]) {
  const uint4 x1 = *(const uint4*)(u + (size_t)row * NU + ucol + c);
  uint4 x0 = make_uint4(0u, 0u, 0u, 0u), x2 = make_uint4(0u, 0u, 0u, 0u);
  if (rm >= 0) x0 = *(const uint4*)(u + (size_t)rm * NU + ucol + c);
  if (rp >= 0) x2 = *(const uint4*)(u + (size_t)rp * NU + ucol + c);
  const unsigned a0[4] = {x0.x, x0.y, x0.z, x0.w}, a1[4] = {x1.x, x1.y, x1.z, x1.w}, a2[4] = {x2.x, x2.y, x2.z, x2.w};
#pragma unroll
  for (int h = 0; h < 2; ++h) {
    const float4 w0 = *(const float4*)(w + c + h * 4), w1 = *(const float4*)(w + 768 + c + h * 4), w2 = *(const float4*)(w + 1536 + c + h * 4);
    const float4 bb = bias ? *(const float4*)(bias + c + h * 4) : make_float4(0.f, 0.f, 0.f, 0.f);
    const float ww0[4] = {w0.x, w0.y, w0.z, w0.w}, ww1[4] = {w1.x, w1.y, w1.z, w1.w}, ww2[4] = {w2.x, w2.y, w2.z, w2.w}, bv[4] = {bb.x, bb.y, bb.z, bb.w};
#pragma unroll
    for (int e = 0; e < 4; ++e) { const int wd = h * 2 + (e >> 1); const bool hi = e & 1;
      const float v0 = hi ? __uint_as_float(a0[wd] & 0xffff0000u) : __uint_as_float(a0[wd] << 16), v1 = hi ? __uint_as_float(a1[wd] & 0xffff0000u) : __uint_as_float(a1[wd] << 16), v2 = hi ? __uint_as_float(a2[wd] & 0xffff0000u) : __uint_as_float(a2[wd] << 16);
      o[h * 4 + e] = bv[e] + ww0[e] * v0 + ww1[e] * v1 + ww2[e] * v2; }
  }
}

template <int MAP>
__device__ __forceinline__ void conv_tile4(const float* src0, const float* src1, int ldsrc, int ncols, bf16_t* dst, int K, int k0, int n0, float* tile, int tid_) {
  const int t = tid_;
  {
    const int nn = t & 63, kk = t >> 6;
    float v[4][8];
#pragma unroll
    for (int q = 0; q < 4; ++q) { const int R = n0 + q * 64 + nn; const float* sp; int col;
      if (MAP == 0) { sp = src0; col = R < ncols ? R : -1; }
      else { int j = R >> 8, rem = R & 255; col = j * 128 + (rem & 127); sp = (rem >> 7) ? src1 : src0; }
#pragma unroll
      for (int i = 0; i < 8; ++i) { int k = i * 8 + kk; v[q][i] = col >= 0 ? sp[(size_t)(k0 + k) * ldsrc + col] : 0.f; } }
#pragma unroll
    for (int q = 0; q < 4; ++q)
#pragma unroll
      for (int i = 0; i < 8; ++i) tile[q * 64 * 65 + (i * 8 + kk) * 65 + nn] = v[q][i];
  }
  __syncthreads();
  {
    const int k2 = (t & 31) * 2, nn = t >> 5;
#pragma unroll
    for (int q = 0; q < 4; ++q)
#pragma unroll
      for (int i = 0; i < 4; ++i) { int n = i * 16 + nn; unsigned v = (unsigned)f2bf(tile[q * 64 * 65 + k2 * 65 + n]) | ((unsigned)f2bf(tile[q * 64 * 65 + (k2 + 1) * 65 + n]) << 16);
        *(unsigned*)(dst + (size_t)(n0 + q * 64 + n) * K + k0 + k2) = v; }
  }
  __syncthreads();
}
__device__ __forceinline__ void phase_conv_small(CParams& p, int bid, int nb, int tid_, char* smem) {
  float* tile = (float*)smem;
  const int n_in = 16 * (NUP / 256), n_out = 16 * 4;
  for (int i = bid; i < DEPTH * (n_in + n_out); i += nb) {
    int l = i / (n_in + n_out), r = i % (n_in + n_out);
    if (r < n_in) { int kt = r % 16, nt = r / 16; conv_tile4<0>(p.w_in + (size_t)l * D * NUS, nullptr, NUS, NUS, p.win_t + (size_t)l * NUP * D, D, kt * 64, nt * 256, tile, tid_); }
    else { r -= n_in; int kt = r % 16, nt = r / 16; conv_tile4<0>(p.w_out + (size_t)l * D * D, nullptr, D, D, p.wout_t + (size_t)l * D * D, D, kt * 64, nt * 256, tile, tid_); }
  }
}
__device__ __forceinline__ void phase_conv_moe(CParams& p, int layer, int bid, int nb, int tid_, char* smem) {
  float* tile = (float*)smem;
  const int n_gu = 16 * 8, n_dn = 16 * 4;
  for (int i = bid; i < NE * (n_gu + n_dn); i += nb) {
    int e = i / (n_gu + n_dn), r = i % (n_gu + n_dn);
    size_t wo = ((size_t)layer * NE + e) * D * D;
    if (r < n_gu) { int kt = r % 16, nt = r / 16; conv_tile4<1>(p.moe_w_gate + wo, p.moe_w_up + wo, D, D, p.wgu_t + (size_t)e * 2048 * D, D, kt * 64, nt * 256, tile, tid_); }
    else { r -= n_gu; int kt = r % 16, nt = r / 16; conv_tile4<0>(p.moe_w_down + wo, nullptr, D, D, p.wdn_t + (size_t)e * D * D, D, kt * 64, nt * 256, tile, tid_); }
  }
}

__device__ __forceinline__ void phase_mod(CParams& p, int bid, int nb, int tid_, char* smem) {
  float* sc = (float*)smem;
  float* red = sc + 5 * D;
  const int lane = tid_ & 63, wv = tid_ >> 6;
  for (int i = tid_; i < 5 * D; i += NT) { int r = i / D, k = i % D; float v = r < 4 ? p.c[r * D + k] : p.c_ctx[k]; sc[i] = siluf(v); }
  __syncthreads();
  for (int blk = bid; blk < DEPTH * 6 * D / 64; blk += nb) {
    const int g = blk * 64 + lane, l = g / (6 * D), n = g % (6 * D);
    const float* w = p.w_mod + (size_t)l * D * 6 * D + n;
    float a0 = 0, a1 = 0, a2 = 0, a3 = 0, a4 = 0;
#pragma unroll 8
    for (int k = wv * 128; k < wv * 128 + 128; ++k) { float wvv = w[(size_t)k * 6 * D]; a0 += sc[k] * wvv; a1 += sc[D + k] * wvv; a2 += sc[2 * D + k] * wvv; a3 += sc[3 * D + k] * wvv; a4 += sc[4 * D + k] * wvv; }
    red[(wv * 5 + 0) * 64 + lane] = a0; red[(wv * 5 + 1) * 64 + lane] = a1; red[(wv * 5 + 2) * 64 + lane] = a2; red[(wv * 5 + 3) * 64 + lane] = a3; red[(wv * 5 + 4) * 64 + lane] = a4;
    __syncthreads();
    if (wv < 5) { float t = p.b_mod[l * 6 * D + n];
#pragma unroll
      for (int q = 0; q < 8; ++q) t += red[(q * 5 + wv) * 64 + lane];
      p.mod[((size_t)l * 5 + wv) * 6 * D + n] = t; }
    __syncthreads();
  }
}

__device__ __forceinline__ void row_modulate_store(const float (&xv)[16], const float* g, const float* sh, const float* sc, bf16_t* dst, int lane, float (&hv)[16]) {
  float ss = 0.f;
#pragma unroll
  for (int i = 0; i < 16; ++i) ss += xv[i] * xv[i];
  ss = wave_sum(ss);
  float rstd = rsqrtf(ss * (1.f / D) + 1e-6f);
#pragma unroll
  for (int i = 0; i < 4; ++i) {
    int k = i * 256 + lane * 4;
    float4 gv = *(const float4*)(g + k), shv = *(const float4*)(sh + k), scv = *(const float4*)(sc + k);
    hv[i * 4 + 0] = xv[i * 4 + 0] * rstd * gv.x * (1.f + scv.x) + shv.x;
    hv[i * 4 + 1] = xv[i * 4 + 1] * rstd * gv.y * (1.f + scv.y) + shv.y;
    hv[i * 4 + 2] = xv[i * 4 + 2] * rstd * gv.z * (1.f + scv.z) + shv.z;
    hv[i * 4 + 3] = xv[i * 4 + 3] * rstd * gv.w * (1.f + scv.w) + shv.w;
    uint2 pk; pk.x = (unsigned)f2bf(hv[i * 4 + 0]) | ((unsigned)f2bf(hv[i * 4 + 1]) << 16); pk.y = (unsigned)f2bf(hv[i * 4 + 2]) | ((unsigned)f2bf(hv[i * 4 + 3]) << 16);
    *(uint2*)(dst + k) = pk;
  }
}
__device__ __forceinline__ void phase_prenorm0(CParams& p, int bid, int nb, int tid_) {
  const int lane = tid_ & 63, wv = tid_ >> 6;
  for (int row0 = (bid * NW + wv) * 2; row0 < TT; row0 += nb * NW * 2) {
    float xv[2][16], hv[16];
#pragma unroll
    for (int r = 0; r < 2; ++r) { const int row = row0 + r; const float* src = row < TL ? p.x + (size_t)row * D : p.ctx + (size_t)(row - TL) * D;
#pragma unroll
      for (int i = 0; i < 4; ++i) { float4 v = *(const float4*)(src + i * 256 + lane * 4); xv[r][i * 4] = v.x; xv[r][i * 4 + 1] = v.y; xv[r][i * 4 + 2] = v.z; xv[r][i * 4 + 3] = v.w; } }
#pragma unroll
    for (int r = 0; r < 2; ++r) { const int row = row0 + r; const float* m = p.mod + (size_t)(0 * 5 + mod_idx(row)) * 6 * D;
      row_modulate_store(xv[r], p.norm_g + 0 * 4 * D + 0 * D, m + 0 * D, m + 1 * D, p.hb + (size_t)row * D, lane, hv); }
  }
}

#define LAS __attribute__((address_space(3)))
namespace g8 {
typedef unsigned u32x4 __attribute__((ext_vector_type(4)));
constexpr int BM = 256, BK = 64, HALF = 128, HTB = HALF * BK * 2, KD = 1024;
__device__ __forceinline__ int lds_byte(int r, int c) { const int st = (r >> 4) * 2 + (c >> 5), rr = r & 15, cc = c & 31, ob = rr * 64 + cc * 2; return st * 1024 + (ob ^ (((ob >> 9) & 1) << 5)); }
__device__ __forceinline__ void stage_rc(int b, int& R, int& C) { const int st = b / 1024, sb = b % 1024, swz = sb ^ (((sb >> 9) & 1) << 5); R = (st >> 1) * 16 + swz / 64; C = (st & 1) * 32 + (swz % 64) / 2; }
__device__ __forceinline__ int perm32(int rho) { const int n = rho >> 4, i = rho & 15; return 8 * (i >> 2) + 4 * n + (i & 3); }
__device__ __forceinline__ unsigned cvt_pk_bf16(float lo, float hi) { unsigned r; asm volatile("v_cvt_pk_bf16_f32 %0, %1, %2" : "=v"(r) : "v"(lo), "v"(hi)); return r; }
struct Unit { int ar0, br0, pn, e; };
struct SchedPlain {
  int nM, nN, nwg, G, c;
  __device__ __forceinline__ bool next(int i, Unit& u) const {
    const long Lx = (long)i * G + c; if (Lx >= nwg) return false;
    int wgid = (int)Lx; { const int q = nwg / 8, r = nwg % 8, xcd = wgid % 8, off = wgid / 8; wgid = (xcd < r ? xcd * (q + 1) : r * (q + 1) + (xcd - r) * q) + off; }
    const int nig = 8 * nN, gid = wgid / nig, fm = gid * 8, gsz = (nM - fm) < 8 ? (nM - fm) : 8;
    const int pm = fm + ((wgid % nig) % gsz), pn = (wgid % nig) / gsz;
    u.ar0 = pm * BM; u.br0 = pn * BM; u.pn = pn; u.e = 0; return true;
  }
};
struct SchedMoe {
  int mt_e, nN, G, c;
  __device__ __forceinline__ bool next(int i, Unit& u) const {
    const long Lx = (long)i * G + c; if (Lx >= (long)NE * mt_e * nN) return false;
    const int e = (int)Lx / (mt_e * nN), r = (int)Lx % (mt_e * nN);
    const int gid = r / (8 * nN), fm = gid * 8, gsz = (mt_e - fm) < 8 ? (mt_e - fm) : 8, rr = r - gid * 8 * nN, pm = fm + rr % gsz, pn = rr / gsz;
    u.ar0 = e * SLOTS_E + pm * BM; u.br0 = (e * nN + pn) * BM; u.pn = pn; u.e = e; return true;
  }
};
template <bool GATHER, class Epi, class Sched>
__device__ __forceinline__ void gemm8(LAS unsigned char* lds, const bf16_t* A, const int* aidx, const bf16_t* Bt, const Sched& S, const Epi& E, int tid) {
  const int wid = __builtin_amdgcn_readfirstlane(tid >> 6), lane = tid & 63, wr = wid >> 2, wc = wid & 3, fr = lane & 15, fq = lane >> 4;
  constexpr int K = KD, nt = K / BK;
  int Rr[2], Cc[2]; unsigned voffB[2];
#pragma unroll
  for (int i = 0; i < 2; ++i) { stage_rc(tid * 16 + i * 8192, Rr[i], Cc[i]); const int Rb = Epi::PERM ? ((Rr[i] & ~31) + perm32(Rr[i] & 31)) : Rr[i]; voffB[i] = (unsigned)(Rb * K + Cc[i]) * 2u; }
  const size_t kstep = (size_t)(BK * 2), hstep = (size_t)HALF * K * 2;
  const unsigned ldsw = (unsigned)wid * 1024u;
  const int aoff = lds_byte(wr * 64 + fr, fq * 8), boff = lds_byte(wc * 32 + fr, fq * 8);
#define G8_SA(b, h) (((b) * 2 + (h)) * HTB)
#define G8_SB(b, h) ((4 + (b) * 2 + (h)) * HTB)
#define G8_STAGE(bufoff, gbase, voff) do { _Pragma("unroll") for (int _i = 0; _i < 2; ++_i) \
    __builtin_amdgcn_global_load_lds((const unsigned*)((const char*)(gbase) + (voff)[_i]), (LAS unsigned*)(lds + (bufoff) + ldsw + _i * 8192), 16, 0, 0); } while (0)
#define G8_LDA(dst, b, h) do { _Pragma("unroll") for (int m = 0; m < 4; ++m) _Pragma("unroll") for (int k = 0; k < 2; ++k) dst[m][k] = *(const LAS bf16x8*)(lds + G8_SA(b, h) + aoff + m * 2048 + k * 1024); } while (0)
#define G8_LDB(dst, b, h) do { _Pragma("unroll") for (int n = 0; n < 2; ++n) _Pragma("unroll") for (int k = 0; k < 2; ++k) dst[n][k] = *(const LAS bf16x8*)(lds + G8_SB(b, h) + boff + n * 2048 + k * 1024); } while (0)
#define G8_MMA(ai, bj, At, Btf) do { __builtin_amdgcn_s_setprio(1); _Pragma("unroll") for (int m = 0; m < 4; ++m) _Pragma("unroll") for (int n = 0; n < 2; ++n) _Pragma("unroll") for (int k = 0; k < 2; ++k) \
    acc[ai][bj][m][n] = __builtin_amdgcn_mfma_f32_16x16x32_bf16(Btf[n][k], At[m][k], acc[ai][bj][m][n], 0, 0, 0); __builtin_amdgcn_s_setprio(0); } while (0)
#define G8_WAIT_V(n) asm volatile("s_waitcnt vmcnt(" #n ")" ::: "memory")
#define G8_WAIT_L(n) asm volatile("s_waitcnt lgkmcnt(" #n ")" ::: "memory")
#define G8_BAR __builtin_amdgcn_s_barrier()
#define G8_SCHED __builtin_amdgcn_sched_barrier(0)
#define G8_AOFF(dst, un) do { _Pragma("unroll") for (int h = 0; h < 2; ++h) _Pragma("unroll") for (int i = 0; i < 2; ++i) { const int r_ = (un).ar0 + h * HALF + Rr[i]; \
    const int g_ = GATHER ? aidx[r_] : r_; dst[h][i] = (unsigned)(g_ * K + Cc[i]) * 2u; } } while (0)
  Unit cur, nxt; int ui = 0;
  if (!S.next(0, cur)) return;
  f32x4 acc[2][2][4][2];
#pragma unroll
  for (int a = 0; a < 2; ++a)
#pragma unroll
    for (int b = 0; b < 2; ++b)
#pragma unroll
      for (int m = 0; m < 4; ++m)
#pragma unroll
        for (int n = 0; n < 2; ++n) acc[a][b][m][n] = (f32x4){0.f, 0.f, 0.f, 0.f};
  bf16x8 At[4][2], B0[2][2], B1[2][2];
  unsigned vA[2][2], vAn[2][2];
  G8_AOFF(vA, cur);
  const char* cA = (const char*)A; const char* cB = (const char*)Bt + (size_t)cur.br0 * K * 2;
  G8_STAGE(G8_SB(0, 0), cB, voffB); G8_STAGE(G8_SA(0, 0), cA, vA[0]); G8_STAGE(G8_SB(0, 1), cB + hstep, voffB); G8_STAGE(G8_SA(0, 1), cA, vA[1]);
  if (wr == 1) G8_BAR;
  G8_WAIT_V(4); G8_BAR;
  G8_STAGE(G8_SB(1, 0), cB + kstep, voffB); G8_STAGE(G8_SA(1, 0), cA + kstep, vA[0]); G8_STAGE(G8_SB(1, 1), cB + hstep + kstep, voffB);
  G8_WAIT_V(6); G8_BAR;
  for (;;) {
    const bool has_next = S.next(ui + 1, nxt);
    if (has_next) { G8_AOFF(vAn, nxt); } else {
#pragma unroll
      for (int h = 0; h < 2; ++h)
#pragma unroll
        for (int i = 0; i < 2; ++i) vAn[h][i] = vA[h][i]; }
    const char* nB = has_next ? (const char*)Bt + (size_t)nxt.br0 * K * 2 : cB;
    for (int t = 0; t < nt; t += 2) {
      const bool last = (t == nt - 2);
      const char* a1 = cA + (size_t)(t + 1) * kstep;
      const char* a2 = last ? cA : cA + (size_t)(t + 2) * kstep; const char* b2 = last ? nB : cB + (size_t)(t + 2) * kstep;
      const char* a3 = a2 + kstep; const char* b3 = b2 + kstep;
      unsigned v2[2][2];
#pragma unroll
      for (int h = 0; h < 2; ++h)
#pragma unroll
        for (int i = 0; i < 2; ++i) v2[h][i] = last ? vAn[h][i] : vA[h][i];
      G8_LDB(B0, 0, 0); G8_SCHED; G8_LDA(At, 0, 0); G8_STAGE(G8_SA(1, 1), a1, vA[1]);
      G8_WAIT_L(8); G8_BAR; G8_WAIT_L(0); G8_MMA(0, 0, At, B0); G8_BAR; G8_SCHED;
      G8_LDB(B1, 0, 1); G8_STAGE(G8_SB(0, 0), b2, voffB);
      G8_BAR; G8_WAIT_L(0); G8_MMA(0, 1, At, B1); G8_BAR;
      G8_LDA(At, 0, 1); G8_STAGE(G8_SA(0, 0), a2, v2[0]);
      G8_BAR; G8_WAIT_L(0); G8_MMA(1, 0, At, B0); G8_BAR; G8_SCHED;
      G8_STAGE(G8_SB(0, 1), b2 + hstep, voffB);
      G8_WAIT_V(6); G8_BAR; G8_MMA(1, 1, At, B1); G8_BAR;
      G8_LDB(B0, 1, 0); G8_SCHED; G8_LDA(At, 1, 0); G8_STAGE(G8_SA(0, 1), a2, v2[1]);
      G8_WAIT_L(8); G8_BAR; G8_WAIT_L(0); G8_MMA(0, 0, At, B0); G8_BAR; G8_SCHED;
      G8_LDB(B1, 1, 1); G8_STAGE(G8_SB(1, 0), b3, voffB);
      G8_BAR; G8_WAIT_L(0); G8_MMA(0, 1, At, B1); G8_BAR;
      G8_LDA(At, 1, 1); G8_STAGE(G8_SA(1, 0), a3, v2[0]);
      G8_BAR; G8_WAIT_L(0); G8_MMA(1, 0, At, B0); G8_BAR; G8_SCHED;
      G8_STAGE(G8_SB(1, 1), b3 + hstep, voffB);
      G8_WAIT_V(6); G8_BAR; G8_MMA(1, 1, At, B1); G8_BAR;
    }
    E(acc, cur, wr, wc, fr, fq);
    if (!has_next) break;
#pragma unroll
    for (int a = 0; a < 2; ++a)
#pragma unroll
      for (int b = 0; b < 2; ++b)
#pragma unroll
        for (int m = 0; m < 4; ++m)
#pragma unroll
          for (int n = 0; n < 2; ++n) acc[a][b][m][n] = (f32x4){0.f, 0.f, 0.f, 0.f};
    cur = nxt; cB = nB; ++ui;
#pragma unroll
    for (int h = 0; h < 2; ++h)
#pragma unroll
      for (int i = 0; i < 2; ++i) vA[h][i] = vAn[h][i];
  }
  G8_WAIT_V(0);
  if (wr == 0) G8_BAR;
  G8_BAR;
#undef G8_SA
#undef G8_SB
#undef G8_STAGE
#undef G8_LDA
#undef G8_LDB
#undef G8_MMA
#undef G8_WAIT_V
#undef G8_WAIT_L
#undef G8_BAR
#undef G8_SCHED
#undef G8_AOFF
}
struct EpiU {
  static constexpr bool PERM = true; bf16_t* u;
  __device__ __forceinline__ void operator()(const f32x4 (&acc)[2][2][4][2], const Unit& un, int wr, int wc, int fr, int fq) const {
#pragma unroll
    for (int ai = 0; ai < 2; ++ai)
#pragma unroll
      for (int m = 0; m < 4; ++m) { bf16_t* rowp = u + (size_t)(un.ar0 + ai * HALF + wr * 64 + m * 16 + fr) * NU;
#pragma unroll
        for (int bj = 0; bj < 2; ++bj) { const int c0 = un.pn * BM + bj * HALF + wc * 32 + 8 * fq;
          { u32x4 w; w.x = cvt_pk_bf16(acc[ai][bj][m][0][0], acc[ai][bj][m][0][1]); w.y = cvt_pk_bf16(acc[ai][bj][m][0][2], acc[ai][bj][m][0][3]);
            w.z = cvt_pk_bf16(acc[ai][bj][m][1][0], acc[ai][bj][m][1][1]); w.w = cvt_pk_bf16(acc[ai][bj][m][1][2], acc[ai][bj][m][1][3]); *(u32x4*)(rowp + c0) = w; } } }
  }
};
struct EpiYo {
  static constexpr bool PERM = true; bf16_t* yo;
  __device__ __forceinline__ void operator()(const f32x4 (&acc)[2][2][4][2], const Unit& un, int wr, int wc, int fr, int fq) const {
#pragma unroll
    for (int ai = 0; ai < 2; ++ai)
#pragma unroll
      for (int m = 0; m < 4; ++m) { bf16_t* rowp = yo + (size_t)(un.ar0 + ai * HALF + wr * 64 + m * 16 + fr) * D + un.pn * BM + wc * 32 + 8 * fq;
#pragma unroll
        for (int bj = 0; bj < 2; ++bj) { u32x4 w; w.x = cvt_pk_bf16(acc[ai][bj][m][0][0], acc[ai][bj][m][0][1]); w.y = cvt_pk_bf16(acc[ai][bj][m][0][2], acc[ai][bj][m][0][3]);
          w.z = cvt_pk_bf16(acc[ai][bj][m][1][0], acc[ai][bj][m][1][1]); w.w = cvt_pk_bf16(acc[ai][bj][m][1][2], acc[ai][bj][m][1][3]); *(u32x4*)(rowp + bj * HALF) = w; } }
  }
};
struct EpiAct {
  static constexpr bool PERM = true; bf16_t* act;
  __device__ __forceinline__ void operator()(const f32x4 (&acc)[2][2][4][2], const Unit& un, int wr, int wc, int fr, int fq) const {
#pragma unroll
    for (int ai = 0; ai < 2; ++ai)
#pragma unroll
      for (int m = 0; m < 4; ++m) { bf16_t* dst = act + (size_t)(un.ar0 + ai * HALF + wr * 64 + m * 16 + fr) * D + un.pn * HALF + wc * 32 + 8 * fq; float v[8];
#pragma unroll
        for (int n = 0; n < 2; ++n)
#pragma unroll
          for (int j = 0; j < 4; ++j) { const float g = acc[ai][0][m][n][j]; v[n * 4 + j] = g * __builtin_amdgcn_rcpf(1.f + __expf(-g)) * acc[ai][1][m][n][j]; }
        u32x4 w; w.x = cvt_pk_bf16(v[0], v[1]); w.y = cvt_pk_bf16(v[2], v[3]); w.z = cvt_pk_bf16(v[4], v[5]); w.w = cvt_pk_bf16(v[6], v[7]); *(u32x4*)dst = w; }
  }
};
struct EpiYm {
  static constexpr bool PERM = true; bf16_t* ym; const float* sw;
  __device__ __forceinline__ void operator()(const f32x4 (&acc)[2][2][4][2], const Unit& un, int wr, int wc, int fr, int fq) const {
#pragma unroll
    for (int ai = 0; ai < 2; ++ai)
#pragma unroll
      for (int m = 0; m < 4; ++m) { const int row = un.ar0 + ai * HALF + wr * 64 + m * 16 + fr; const float w8 = sw[row]; bf16_t* rowp = ym + (size_t)row * D + un.pn * BM + wc * 32 + 8 * fq;
#pragma unroll
        for (int bj = 0; bj < 2; ++bj) { u32x4 w; w.x = cvt_pk_bf16(acc[ai][bj][m][0][0] * w8, acc[ai][bj][m][0][1] * w8); w.y = cvt_pk_bf16(acc[ai][bj][m][0][2] * w8, acc[ai][bj][m][0][3] * w8);
          w.z = cvt_pk_bf16(acc[ai][bj][m][1][0] * w8, acc[ai][bj][m][1][1] * w8); w.w = cvt_pk_bf16(acc[ai][bj][m][1][2] * w8, acc[ai][bj][m][1][3] * w8); *(u32x4*)(rowp + bj * HALF) = w; } }
  }
};
}

__device__ __forceinline__ void phase_gemm_in(CParams& p, int layer, int bid, int nb, int tid_, char* smem) {
  g8::SchedPlain S; S.nM = TT / 256; S.nN = NUP / 256; S.nwg = S.nM * S.nN; S.G = nb; S.c = bid;
  g8::EpiU E; E.u = p.u;
  g8::gemm8<false>((LAS unsigned char*)smem, p.hb, nullptr, p.win_t + (size_t)layer * NUP * D, S, E, tid_);
}
__device__ __forceinline__ void phase_gemm_out(CParams& p, int layer, int bid, int nb, int tid_, char* smem) {
  g8::SchedPlain S; S.nM = (layer == 0 ? TT : TL) / 256; S.nN = D / 256; S.nwg = S.nM * S.nN; S.G = nb; S.c = bid;
  g8::EpiYo E; E.yo = p.yo;
  g8::gemm8<false>((LAS unsigned char*)smem, p.y, nullptr, p.wout_t + (size_t)layer * D * D, S, E, tid_);
}
__device__ __forceinline__ void phase_gemm_moe1(CParams& p, int layer, int bid, int nb, int tid_, char* smem) {
  g8::SchedMoe S; S.mt_e = layer == 0 ? 17 : 16; S.nN = 8; S.G = nb; S.c = bid;
  g8::EpiAct E; E.act = p.act;
  g8::gemm8<true>((LAS unsigned char*)smem, p.hb, p.slot_tok, p.wgu_t, S, E, tid_);
}
__device__ __forceinline__ void phase_gemm_moe2(CParams& p, int layer, int bid, int nb, int tid_, char* smem) {
  g8::SchedMoe S; S.mt_e = layer == 0 ? 17 : 16; S.nN = 4; S.G = nb; S.c = bid;
  g8::EpiYm E; E.ym = p.ymoe; E.sw = p.slot_w;
  g8::gemm8<false>((LAS unsigned char*)smem, p.act, nullptr, p.wdn_t, S, E, tid_);
}

template <int MT, int NTL, int KS, int LDA, int LDB>
__device__ __forceinline__ void wmm(f32x4 (&acc)[MT][NTL], const bf16_t* A, const bf16_t* B, int fr, int fq) {
#pragma unroll
  for (int ks = 0; ks < KS; ++ks) {
    bf16x8 a[MT], b[NTL];
#pragma unroll
    for (int m = 0; m < MT; ++m) a[m] = *(const bf16x8*)(A + (m * 16 + fr) * LDA + ks * 32 + fq * 8);
#pragma unroll
    for (int n = 0; n < NTL; ++n) b[n] = *(const bf16x8*)(B + (n * 16 + fr) * LDB + ks * 32 + fq * 8);
#pragma unroll
    for (int m = 0; m < MT; ++m)
#pragma unroll
      for (int n = 0; n < NTL; ++n) acc[m][n] = __builtin_amdgcn_mfma_f32_16x16x32_bf16(a[m], b[n], acc[m][n], 0, 0, 0);
  }
}
__device__ __forceinline__ unsigned pack2(float a, float b) { return (unsigned)f2bf(a) | ((unsigned)f2bf(b) << 16); }
constexpr int NCH = 132;
__device__ __forceinline__ int chunk_row0(int b, int cpos) { return cpos < 4 ? TL + b * CTX + cpos * 64 : b * SEQ + (cpos - 4) * 64; }
__device__ __forceinline__ int scan_idx(int cpos, int dir) { return dir == 0 ? cpos : (cpos < 4 ? 3 - cpos : 135 - cpos); }

struct GlaLds {
  bf16_t rq[64][32], rk[64][32], rv[64][64], rog[64][64], rlr[64][32];
  float w2s[2][16][32]; float gbs[2][32]; float g[2][64][36]; float gt[2][32];
  bf16_t qg[2][64][40]; bf16_t kg[2][64][40];
  bf16_t vt[64][72]; bf16_t at[2][64][72]; float ox[64][65];
};
template <int PASS>
__device__ __forceinline__ void phase_gla_chunk(CParams& p, int layer, int bid, int nb, int tid_, char* smem) {
  GlaLds& L = *(GlaLds*)smem;
  const int c_lo = (PASS == 1 && layer == DEPTH - 1) ? 4 : 0, ncp = NCH - c_lo;
  uint4 r0 = make_uint4(0u, 0u, 0u, 0u), r1 = r0, r2 = r0, r3 = r0; float w2a = 0.f, w2b = 0.f, gbv = 0.f;
  auto gfetch = [&](int task_, int tid) { const int h_ = task_ & 3, cpos_ = c_lo + (task_ >> 2) % ncp, b_ = (task_ >> 2) / ncp; const bf16_t* U0_ = p.u + (size_t)chunk_row0(b_, cpos_) * NU;
    auto gsrc = [&](int i) -> const bf16_t* { const int f = i / 28, c = i % 28;
      const int col = c < 4 ? h_ * 32 + c * 8 : (c < 8 ? 128 + h_ * 32 + (c - 4) * 8 : (c < 16 ? 256 + h_ * 64 + (c - 8) * 8 : (c < 24 ? 512 + h_ * 64 + (c - 16) * 8 : 768 + (c - 24) * 8)));
      return U0_ + (size_t)f * NU + col; };
    r0 = *(const uint4*)gsrc(tid); r1 = *(const uint4*)gsrc(tid + NT); r2 = *(const uint4*)gsrc(tid + 2 * NT);
    if (tid < 64 * 28 - 3 * NT) r3 = *(const uint4*)gsrc(tid + 3 * NT);
    const int i0 = tid, i1 = tid + NT;
    w2a = p.gla_w2[((size_t)(layer * 2 + (i0 >> 9)) * 16 + ((i0 >> 5) & 15)) * 128 + h_ * 32 + (i0 & 31)]; w2b = p.gla_w2[((size_t)(layer * 2 + (i1 >> 9)) * 16 + ((i1 >> 5) & 15)) * 128 + h_ * 32 + (i1 & 31)];
    if (tid < 64) gbv = p.gla_b[(layer * 2 + (tid >> 5)) * 128 + h_ * 32 + (tid & 31)]; };
  if (bid < NB * ncp * 4) gfetch(bid, tid_);
  for (int task = bid; task < NB * ncp * 4; task += nb) {
    int tid = tid_; asm volatile("" : "+v"(tid));
    const int lane = tid & 63, wv = tid >> 6, fr = lane & 15, fq = lane >> 4, dirw = wv >> 2, s4 = wv & 3;
    const int h = task & 3, cpos = c_lo + (task >> 2) % ncp, b = (task >> 2) / ncp;
    const int row0 = chunk_row0(b, cpos);
    const bf16_t* U0 = p.u + (size_t)row0 * NU;
    const int seq = (b * 4 + h) * 2 + dirw, nsc = scan_idx(cpos, dirw);
    bf16x8 sfrag[4];
    if (PASS == 1) { const bf16_t* sb = p.gla_l + ((size_t)seq * NCH + nsc) * 2048;
#pragma unroll
      for (int n = 0; n < 4; ++n) sfrag[n] = *(const bf16x8*)(sb + (n * 16 + fr) * 32 + fq * 8); }
    { auto ldst = [&](int i) -> bf16_t* { const int f = i / 28, c = i % 28;
        return c < 4 ? &L.rq[f][c * 8] : (c < 8 ? &L.rk[f][(c - 4) * 8] : (c < 16 ? &L.rv[f][(c - 8) * 8] : (c < 24 ? &L.rog[f][(c - 16) * 8] : &L.rlr[f][(c - 24) * 8]))); };
      *(uint4*)ldst(tid) = r0; *(uint4*)ldst(tid + NT) = r1; *(uint4*)ldst(tid + 2 * NT) = r2;
      if (tid < 64 * 28 - 3 * NT) *(uint4*)ldst(tid + 3 * NT) = r3;
      (&L.w2s[0][0][0])[tid] = w2a; (&L.w2s[0][0][0])[tid + NT] = w2b;
      if (tid < 64) L.gbs[tid >> 5][tid & 31] = gbv; }
    if (task + nb < NB * ncp * 4) gfetch(task + nb, tid);
    __syncthreads();
    { const int dir = tid >> 8, f = (tid >> 2) & 63, d0 = (tid & 3) * 8;
      float z[8];
#pragma unroll
      for (int e = 0; e < 8; ++e) z[e] = L.gbs[dir][d0 + e];
      const uint4 l0 = *(const uint4*)&L.rlr[f][dir * 16], l1 = *(const uint4*)&L.rlr[f][dir * 16 + 8];
      const unsigned lw[8] = {l0.x, l0.y, l0.z, l0.w, l1.x, l1.y, l1.z, l1.w};
#pragma unroll
      for (int r = 0; r < 16; ++r) { const float lv = (r & 1) ? __uint_as_float(lw[r >> 1] & 0xffff0000u) : __uint_as_float(lw[r >> 1] << 16);
        const float4 wa = *(const float4*)&L.w2s[dir][r][d0], wb = *(const float4*)&L.w2s[dir][r][d0 + 4];
        z[0] += lv * wa.x; z[1] += lv * wa.y; z[2] += lv * wa.z; z[3] += lv * wa.w; z[4] += lv * wb.x; z[5] += lv * wb.y; z[6] += lv * wb.z; z[7] += lv * wb.w; }
#pragma unroll
      for (int e = 0; e < 8; ++e) z[e] = logsigmoidf_(z[e]) * (1.f / 16.f);
      *(float4*)&L.g[dir][f][d0] = make_float4(z[0], z[1], z[2], z[3]); *(float4*)&L.g[dir][f][d0 + 4] = make_float4(z[4], z[5], z[6], z[7]); }
    __syncthreads();
#pragma unroll
    for (int cc = 0; cc < 8; ++cc) { const int col = wv * 8 + cc, dir = col >> 5, d = col & 31, f = dir ? 63 - lane : lane;
      float v = L.g[dir][f][d];
#pragma unroll
      for (int o = 1; o < 64; o <<= 1) { const float t = __shfl_up(v, o); if (lane >= o) v += t; }
      L.g[dir][f][d] = v; if (lane == 63) L.gt[dir][d] = v; }
    __syncthreads();
    if (PASS == 1) {
      for (int i = tid; i < 2 * 64 * 16; i += NT) { int dir = i >> 10, f = (i >> 4) & 63, dp = i & 15;
        const unsigned qq = *(const unsigned*)&L.rq[f][2 * dp], kk = *(const unsigned*)&L.rk[f][2 * dp];
        const float2 cc = *(const float2*)&L.g[dir][f][2 * dp];
        const float e0 = __expf(cc.x), e1 = __expf(cc.y);
        *(unsigned*)&L.qg[dir][f][2 * dp] = pack2(__uint_as_float(qq << 16) * e0 * 0.17677669529663687f, __uint_as_float(qq & 0xffff0000u) * e1 * 0.17677669529663687f);
        *(unsigned*)&L.kg[dir][f][2 * dp] = pack2(__uint_as_float(kk << 16) / e0, __uint_as_float(kk & 0xffff0000u) / e1); }
    } else {
      bf16_t (*ket)[32][72] = (bf16_t (*)[32][72])&L.kg[0][0][0];
      for (int i = tid; i < 2 * 32 * 16; i += NT) { int d = i & 31, f4 = (i >> 5) & 15, dir = i >> 9, f0 = f4 * 4; float v[4];
#pragma unroll
        for (int q = 0; q < 4; ++q) v[q] = bf2f(L.rk[f0 + q][d]) * __expf(L.gt[dir][d] - L.g[dir][f0 + q][d]);
        uint2 pk; pk.x = pack2(v[0], v[1]); pk.y = pack2(v[2], v[3]); *(uint2*)&ket[dir][d][f0] = pk; }
    }
    for (int i = tid; i < 64 * 16; i += NT) { int c = i & 63, f0 = (i >> 6) * 4;
      uint2 pk; pk.x = (unsigned)L.rv[f0][c] | ((unsigned)L.rv[f0 + 1][c] << 16); pk.y = (unsigned)L.rv[f0 + 2][c] | ((unsigned)L.rv[f0 + 3][c] << 16); *(uint2*)&L.vt[c][f0] = pk; }
    __syncthreads();
    if (PASS == 0) {
      const bf16_t (*ket)[32][72] = (const bf16_t (*)[32][72])&L.kg[0][0][0];
      f32x4 acc[2][1] = {{{0.f, 0.f, 0.f, 0.f}}, {{0.f, 0.f, 0.f, 0.f}}};
      wmm<2, 1, 2, 72, 72>(acc, &ket[dirw][0][0], &L.vt[s4 * 16][0], fr, fq);
      bf16_t* dst = p.gla_l + ((size_t)seq * NCH + nsc) * 2048 + (s4 * 16 + fr) * 32;
#pragma unroll
      for (int m = 0; m < 2; ++m) { uint2 pk; pk.x = pack2(acc[m][0][0], acc[m][0][1]); pk.y = pack2(acc[m][0][2], acc[m][0][3]); *(uint2*)(dst + m * 16 + fq * 4) = pk; }
      if (tid < 64) { int dir = tid >> 5, d = tid & 31; p.gla_dec[((size_t)((b * 4 + h) * 2 + dir) * NCH + scan_idx(cpos, dir)) * 32 + d] = __expf(L.gt[dir][d]); }
    } else {
      { f32x4 acc[4][1];
#pragma unroll
        for (int m = 0; m < 4; ++m) acc[m][0] = (f32x4){0.f, 0.f, 0.f, 0.f};
        wmm<4, 1, 1, 40, 40>(acc, &L.kg[dirw][0][0], &L.qg[dirw][s4 * 16][0], fr, fq);
        const int i = s4 * 16 + fr;
#pragma unroll
        for (int m = 0; m < 4; ++m) { float v[4];
#pragma unroll
          for (int q = 0; q < 4; ++q) { int j = m * 16 + fq * 4 + q; bool keep = dirw == 0 ? (j <= i) : (j >= i); v[q] = keep ? acc[m][0][q] : 0.f; }
          uint2 pk; pk.x = pack2(v[0], v[1]); pk.y = pack2(v[2], v[3]); *(uint2*)&L.at[dirw][i][m * 16 + fq * 4] = pk; } }
      f32x4 ao[1][4];
#pragma unroll
      for (int n = 0; n < 4; ++n) ao[0][n] = (f32x4){0.f, 0.f, 0.f, 0.f};
      wmm<1, 4, 2, 72, 72>(ao, &L.at[dirw][s4 * 16][0], &L.vt[0][0], fr, fq);
      { bf16x8 a = *(const bf16x8*)&L.qg[dirw][s4 * 16 + fr][fq * 8];
#pragma unroll
        for (int n = 0; n < 4; ++n) ao[0][n] = __builtin_amdgcn_mfma_f32_16x16x32_bf16(a, sfrag[n], ao[0][n], 0, 0, 0); }
      if (dirw == 1) {
#pragma unroll
        for (int n = 0; n < 4; ++n)
#pragma unroll
          for (int q = 0; q < 4; ++q) L.ox[s4 * 16 + fq * 4 + q][n * 16 + fr] = ao[0][n][q]; }
      __syncthreads();
      if (dirw == 0) {
        float ss[4] = {0.f, 0.f, 0.f, 0.f};
#pragma unroll
        for (int n = 0; n < 4; ++n)
#pragma unroll
          for (int q = 0; q < 4; ++q) { ao[0][n][q] += L.ox[s4 * 16 + fq * 4 + q][n * 16 + fr]; ss[q] += ao[0][n][q] * ao[0][n][q]; }
#pragma unroll
        for (int q = 0; q < 4; ++q) {
#pragma unroll
          for (int o = 1; o < 16; o <<= 1) ss[q] += __shfl_xor(ss[q], o);
          ss[q] = rsqrtf(ss[q] * (1.f / 64.f) + 1e-6f); }
#pragma unroll
        for (int n = 0; n < 4; ++n) { const int c = n * 16 + fr; const float nw = p.gla_norm[layer * 256 + h * 64 + c];
#pragma unroll
          for (int q = 0; q < 4; ++q) { const int f = s4 * 16 + fq * 4 + q; float og = bf2f(L.rog[f][c]);
            p.y[(size_t)(row0 + f) * D + h * 64 + c] = f2bf(ao[0][n][q] * ss[q] * nw * siluf(og)); } }
      }
    }
    __syncthreads();
  }
}
__device__ __forceinline__ void phase_gla_state(CParams& p, int bid, int nb, int tid_) {
  for (int i = bid * NT + tid_; i < 32 * 1024; i += nb * NT) {
    const int seq = i >> 10, e2 = (i & 1023) * 2;
    unsigned* lp = (unsigned*)(p.gla_l + (size_t)seq * NCH * 2048 + e2);
    const float* dp = p.gla_dec + (size_t)seq * NCH * 32 + (e2 & 31);
    float s0 = 0.f, s1 = 0.f;
    for (int n = 0; n < NCH; n += 12) {
      unsigned lv[12]; float2 dc[12];
#pragma unroll
      for (int q = 0; q < 12; ++q) { lv[q] = lp[(size_t)(n + q) * 1024]; dc[q] = *(const float2*)(dp + (n + q) * 32); }
#pragma unroll
      for (int q = 0; q < 12; ++q) { lp[(size_t)(n + q) * 1024] = pack2(s0, s1); s0 = s0 * dc[q].x + bf2f((bf16_t)(lv[q] & 0xffff)); s1 = s1 * dc[q].y + bf2f((bf16_t)(lv[q] >> 16)); }
    }
  }
}

__device__ __forceinline__ void phase_hy_prep(CParams& p, int layer, int bid, int nb, int tid_) {
  if (layer != 0) return;
  for (long i = (long)bid * NT + tid_; i < (long)TC * 768; i += (long)nb * NT) {
    int row = TL + (int)(i / 768), c = (int)(i % 768);
    int rm = seq_nb(row, -1, false), rp = seq_nb(row, 1, false);
    const float* w = p.hy_conv_w + (size_t)layer * 3 * 768;
    float a = p.hy_conv_b[layer * 768 + c] + w[768 + c] * bf2f(p.u[(size_t)row * NU + U_HY + c]);
    if (rm >= 0) a += w[c] * bf2f(p.u[(size_t)rm * NU + U_HY + c]);
    if (rp >= 0) a += w[2 * 768 + c] * bf2f(p.u[(size_t)rp * NU + U_HY + c]);
    p.prep[(size_t)row * 768 + c] = f2bf(a);
  }
}
template <bool TR>
__device__ __forceinline__ void phase_hy_filt(CParams& p, int layer, int L, float* filt, int bid, int nb, int tid_, char* smem) {
  constexpr int PP = 16;
  float* feats = (float*)smem;
  float* h1 = feats + PP * 36;
  float* h2 = h1 + PP * 64;
  float* h3 = h2 + PP * 64;
  float* w1s = h3 + PP * 64;
  float* w2s = w1s + 33 * 64; float* w3s = w2s + 64 * 64; float* bfs = w3s + 64 * 64;
  const int t = tid_;
  const float* w4 = p.hy_w4 + (size_t)layer * 64 * 1024;
  for (int i = t; i < 33 * 64; i += NT) w1s[i] = p.hy_w1[(size_t)layer * 33 * 64 + i];
  for (int i = t; i < 64 * 64; i += NT) { w2s[i] = p.hy_w2[(size_t)layer * 64 * 64 + i]; w3s[i] = p.hy_w3[(size_t)layer * 64 * 64 + i]; }
  if (t < 64) { bfs[t] = p.hy_b1[layer * 64 + t]; bfs[64 + t] = p.hy_b2[layer * 64 + t]; bfs[128 + t] = p.hy_b3[layer * 64 + t]; }
  if (t < 192) bfs[192 + t] = p.hy_freq[layer * 192 + t];
  __syncthreads();
  for (int blk = bid; blk < L / PP; blk += nb) {
    const int pos0 = blk * PP;
    for (int i = t; i < PP * 33; i += NT) {
      int pp = i / 33, f = i % 33; float pos = (float)(pos0 + pp); float v;
      if (f == 0) v = pos / (float)(L - 1);
      else { int j = (f - 1) & 15; float band = 1e-4f + (float)j * ((15.f - 1e-4f) / 15.f); float ang = (6.283185307179586f / (float)L) * pos * band; v = f <= 16 ? cosf(ang) : -sinf(ang); }
      feats[pp * 36 + f] = v;
    }
    __syncthreads();
    for (int i = t; i < PP * 64; i += NT) { int pp = i >> 6, j = i & 63; float a = bfs[j];
#pragma unroll
      for (int k = 0; k < 33; ++k) a += feats[pp * 36 + k] * w1s[k * 64 + j];
      h1[i] = sinf(bfs[192 + j] * a); }
    __syncthreads();
    for (int i = t; i < PP * 64; i += NT) { int pp = i >> 6, j = i & 63; float a = bfs[64 + j];
#pragma unroll 16
      for (int k = 0; k < 64; ++k) a += h1[pp * 64 + k] * w2s[k * 64 + j];
      h2[i] = sinf(bfs[256 + j] * a); }
    __syncthreads();
    for (int i = t; i < PP * 64; i += NT) { int pp = i >> 6, j = i & 63; float a = bfs[128 + j];
#pragma unroll 16
      for (int k = 0; k < 64; ++k) a += h2[pp * 64 + k] * w3s[k * 64 + j];
      h3[i] = sinf(bfs[320 + j] * a); }
    __syncthreads();
#pragma unroll 1
    for (int cc = 0; cc < 1024 / NT; ++cc) {
      int col = cc * NT + t, c = col & 255;
      float acc[PP];
#pragma unroll
      for (int pp = 0; pp < PP; ++pp) acc[pp] = 0.f;
#pragma unroll 1
      for (int k0 = 0; k0 < 64; k0 += 16) { float wv[16];
#pragma unroll
        for (int k = 0; k < 16; ++k) wv[k] = w4[(k0 + k) * 1024 + col];
#pragma unroll
        for (int k = 0; k < 16; ++k)
#pragma unroll
          for (int pp = 0; pp < PP; ++pp) acc[pp] += h3[pp * 64 + k0 + k] * wv[k]; }
      const float mind = -3.0701134573253945f, maxd = -15.350567286626973f;
      float delta = fabsf(mind + (float)c * ((maxd - mind) / 255.f));
#pragma unroll
      for (int pp = 0; pp < PP; ++pp) { float tn = (float)(pos0 + pp) / (float)(L - 1); float fv = acc[pp] * __expf(-tn * delta); if (TR) filt[(size_t)col * L + pos0 + pp] = fv; else filt[(size_t)(pos0 + pp) * 1024 + col] = fv; }
    }
    __syncthreads();
  }
}
__device__ __forceinline__ void phase_hy_conv(CParams& p, int layer, int stage, bool ctx, int bid, int nb, int tid_) {
  const int L = ctx ? CTX : SEQ, rbase = ctx ? TL : 0;
  const float* filt = ctx ? p.filtc : p.filt;
  const int ntt = L / 16;
  const int total = NB * ntt * 256;
  for (int i = bid * NT + tid_; i < total; i += nb * NT) {
    const int c = i & 255, tt = (i >> 8) % ntt, b = (i >> 8) / ntt, t0 = tt * 16;
    const float* ff = filt + stage * 512 + c;
    float acc[16], win[16];
#pragma unroll
    for (int k = 0; k < 16; ++k) acc[k] = 0.f;
#pragma unroll
    for (int k = 0; k < 16; ++k) win[k] = ff[(size_t)(t0 + k) * 1024];
    for (int s0 = 0; s0 < L; s0 += 16) {
#pragma unroll
      for (int ss = 0; ss < 16; ++ss) {
        const int s = s0 + ss; const int row = rbase + b * L + s;
        float uv = stage == 0 ? bf2f(p.prep[(size_t)row * 768 + c]) : p.zbuf[(size_t)row * 256 + c];
#pragma unroll
        for (int k = 0; k < 16; ++k) acc[k] += win[(k + 16 - ss) & 15] * uv;
        int dl = t0 - (s + 1);
        float nv = 0.f;
        if (s + 1 < L) nv = dl >= 0 ? ff[(size_t)dl * 1024] : ff[(size_t)(-dl) * 1024 + 256];
        win[(15 + 16 - ss) & 15] = nv;
      }
    }
    const float dsk = p.hy_d[(layer * 2 + stage) * 256 + c];
#pragma unroll
    for (int k = 0; k < 16; ++k) {
      const int row = rbase + b * L + t0 + k;
      if (stage == 0) { float vv = bf2f(p.prep[(size_t)row * 768 + c]); float x1 = bf2f(p.prep[(size_t)row * 768 + 256 + c]); p.zbuf[(size_t)row * 256 + c] = x1 * (acc[k] + dsk * vv); }
      else { float zz = p.zbuf[(size_t)row * 256 + c]; float x2 = bf2f(p.prep[(size_t)row * 768 + 512 + c]); p.y[(size_t)row * D + 256 + c] = f2bf(x2 * (acc[k] + dsk * zz)); }
    }
  }
}

__device__ __forceinline__ void phase_hy_prep_t(CParams& p, int layer, int bid, int nb, int tid_, char* smem) {
  bf16_t (*tl)[72] = (bf16_t (*)[72])smem;
  const float* w = p.hy_conv_w + (size_t)layer * 3 * 768; const float* bs = p.hy_conv_b + layer * 768;
  for (int task = bid; task < NB * (SEQ / 64); task += nb) {
    int tid = tid_; asm volatile("" : "+v"(tid));
    const int b = task / (SEQ / 64), t0 = (task % (SEQ / 64)) * 64;
#pragma unroll 4
    for (int i = tid; i < 64 * 96; i += NT) { const int ck = (i & 7) + 8 * ((i >> 6) % 12), tl_ = ((i >> 3) & 7) + 8 * (i / 768), t = t0 + tl_; const int row = b * SEQ + t;
      float o[8]; conv8(p.u, U_HY, row, t > 0 ? row - 1 : -1, t < SEQ - 1 ? row + 1 : -1, w, bs, ck * 8, o);
#pragma unroll
      for (int e = 0; e < 8; ++e) tl[ck * 8 + e][tl_] = f2bf(o[e]); }
    __syncthreads();
    for (int i = tid; i < 768 * 8; i += NT) { const int c = i >> 3, ch = i & 7; *(uint4*)(p.prep + ((size_t)(b * 768 + c)) * SEQ + t0 + ch * 8) = *(const uint4*)&tl[c][ch * 8]; }
    __syncthreads();
  }
}
#define FPAD(i) ((i) + (((i) >> 5) << 1))
struct FftLds { float2 x[16384 + 1024]; float2 t1[128]; float2 t0[128]; };
__device__ __forceinline__ float2 cmulf(float2 a, float2 b) { return make_float2(a.x * b.x - a.y * b.y, a.x * b.y + a.y * b.x); }
__device__ __forceinline__ float2 cmulcf(float2 a, float2 w) { return make_float2(a.x * w.x + a.y * w.y, a.y * w.x - a.x * w.y); }
__device__ __forceinline__ float2 caddf(float2 a, float2 b) { return make_float2(a.x + b.x, a.y + b.y); }
__device__ __forceinline__ float2 csubf(float2 a, float2 b) { return make_float2(a.x - b.x, a.y - b.y); }
template <bool INV> __device__ __forceinline__ void r4bf(float2& a0, float2& a1, float2& a2, float2& a3) {
  const float2 s0 = caddf(a0, a2), s1 = csubf(a0, a2), s2 = caddf(a1, a3), d = csubf(a1, a3);
  const float2 s3 = INV ? make_float2(-d.y, d.x) : make_float2(d.y, -d.x);
  a0 = caddf(s0, s2); a1 = caddf(s1, s3); a2 = csubf(s0, s2); a3 = csubf(s1, s3);
}
__device__ __forceinline__ float2 w16c(int k) {
  constexpr float C1 = 0.92387953251128674f, S1 = 0.38268343236508977f, R2 = 0.70710678118654752f;
  return k == 1 ? make_float2(C1, -S1) : k == 2 ? make_float2(R2, -R2) : k == 3 ? make_float2(S1, -C1) : k == 4 ? make_float2(0.f, -1.f) : k == 6 ? make_float2(-R2, -R2) :   make_float2(-C1, S1);
}
template <bool INV, int LQ, bool HALF = false>
__device__ __forceinline__ void fft_pass16(FftLds& L, int tid) {
  constexpr int Q = 1 << LQ;
#pragma unroll
  for (int i = 0; i < 2; ++i) {
    const int bf = tid + 512 * i, j = bf & (Q - 1), base = ((bf >> LQ) << (LQ + 4)) + j, k = j << (10 - LQ);
    const int pb = FPAD(base);
#define FSLOT(s2_) (pb + ((Q >= 32) ? (s2_) * (Q + (Q >> 4)) : (s2_) * Q + (((s2_) * Q) >> 5) * 2))
    float2 v[16];
#pragma unroll
    for (int s2 = 0; s2 < 16; ++s2) v[s2] = (HALF && !INV && s2 >= 8) ? make_float2(0.f, 0.f) : L.x[FSLOT(s2)];
    const float2 w1 = cmulf(L.t1[k >> 7], L.t0[k & 127]), w2 = cmulf(w1, w1), w3 = cmulf(w2, w1), w4 = cmulf(w2, w2), w8 = cmulf(w4, w4), w12 = cmulf(w8, w4);
    const float2 wm[4] = {make_float2(1.f, 0.f), w1, w2, w3}, wn[4] = {make_float2(1.f, 0.f), w4, w8, w12};
    if (!INV) {
#pragma unroll
      for (int q = 0; q < 4; ++q) {
        if (HALF) { const float2 a0 = v[q], a1 = v[q + 4];
          v[q] = caddf(a0, a1); v[q + 4] = make_float2(a0.x + a1.y, a0.y - a1.x); v[q + 8] = csubf(a0, a1); v[q + 12] = make_float2(a0.x - a1.y, a0.y + a1.x); }
        else r4bf<false>(v[q], v[q + 4], v[q + 8], v[q + 12]); }
#pragma unroll
      for (int m = 1; m < 4; ++m)
#pragma unroll
        for (int q = 0; q < 4; ++q) { float2 t = v[q + 4 * m]; if (q > 0) t = cmulf(t, w16c(q * m)); v[q + 4 * m] = cmulf(t, wm[m]); }
#pragma unroll
      for (int m = 0; m < 4; ++m) { r4bf<false>(v[4 * m], v[4 * m + 1], v[4 * m + 2], v[4 * m + 3]);
#pragma unroll
        for (int n = 1; n < 4; ++n) v[4 * m + n] = cmulf(v[4 * m + n], wn[n]); }
    } else {
#pragma unroll
      for (int m = 0; m < 4; ++m) {
#pragma unroll
        for (int n = 1; n < 4; ++n) v[4 * m + n] = cmulcf(v[4 * m + n], wn[n]);
        r4bf<true>(v[4 * m], v[4 * m + 1], v[4 * m + 2], v[4 * m + 3]); }
#pragma unroll
      for (int m = 1; m < 4; ++m)
#pragma unroll
        for (int q = 0; q < 4; ++q) { float2 t = cmulcf(v[q + 4 * m], wm[m]); if (q > 0) t = cmulcf(t, w16c(q * m)); v[q + 4 * m] = t; }
#pragma unroll
      for (int q = 0; q < 4; ++q) {
        if (HALF) { const float2 c0 = v[q], c1 = v[q + 4], c2 = v[q + 8], c3 = v[q + 12]; const float2 s0 = caddf(c0, c2), s1 = csubf(c0, c2), s2 = caddf(c1, c3), d = csubf(c1, c3);
          v[q] = caddf(s0, s2); v[q + 4] = make_float2(s1.x - d.y, s1.y + d.x); }
        else r4bf<true>(v[q], v[q + 4], v[q + 8], v[q + 12]); }
    }
#pragma unroll
    for (int s2 = 0; s2 < ((HALF && INV) ? 8 : 16); ++s2) L.x[FSLOT(s2)] = v[s2];
#undef FSLOT
  }
  __syncthreads();
}
template <bool INV> __device__ __forceinline__ void fft_pass4_last(FftLds& L, int tid) {
#pragma unroll 2
  for (int i = 0; i < 8; ++i) { const int p0 = FPAD(4 * (tid + 512 * i));
    float4 u0 = *(const float4*)&L.x[p0], u1 = *(const float4*)&L.x[p0 + 2];
    float2 a0 = make_float2(u0.x, u0.y), a1 = make_float2(u0.z, u0.w), a2 = make_float2(u1.x, u1.y), a3 = make_float2(u1.z, u1.w);
    r4bf<INV>(a0, a1, a2, a3);
    *(float4*)&L.x[p0] = make_float4(a0.x, a0.y, a1.x, a1.y); *(float4*)&L.x[p0 + 2] = make_float4(a2.x, a2.y, a3.x, a3.y); }
  __syncthreads();
}
template <bool INV, bool HALF = false>
__device__ __forceinline__ void fft16k(FftLds& L, int tid) {
  if (!INV) { fft_pass16<false, 10, HALF>(L, tid); fft_pass16<false, 6>(L, tid); fft_pass16<false, 2>(L, tid); fft_pass4_last<false>(L, tid); }
  else { fft_pass4_last<true>(L, tid); fft_pass16<true, 2>(L, tid); fft_pass16<true, 6>(L, tid); fft_pass16<true, 10, HALF>(L, tid); }
}
__device__ __forceinline__ void phase_hy_fft(CParams& p, int layer, int bid, int nb, int tid_, char* smem) {
  FftLds& L = *(FftLds*)smem;
  for (int c = bid; c < 256; c += nb) {
    int tid = tid_; asm volatile("" : "+v"(tid));
    if (tid < 128) { float sn, cs; sincospif(-(float)tid / 64.f, &sn, &cs); L.t1[tid] = make_float2(cs, sn);
      sincospif(-(float)tid / 8192.f, &sn, &cs); L.t0[tid] = make_float2(cs, sn); }
#pragma unroll 1
    for (int o = 0; o < 2; ++o) {
      asm volatile("" : "+v"(tid));
      const float* hf = p.filt + (size_t)(o * 512 + c) * SEQ; const float* hb = p.filt + (size_t)(o * 512 + 256 + c) * SEQ;
      __syncthreads();
#pragma unroll 16
      for (int n = tid; n < 16384; n += NT) { float v = n < SEQ ? hf[n] : (n == SEQ ? 0.f : hb[16384 - n]); L.x[FPAD(n)] = make_float2(v, 0.f); }
      __syncthreads();
      fft16k<false>(L, tid);
      float2* specg = p.specg + (size_t)c * 16384;
#pragma unroll
      for (int k = 0; k < 32; ++k) { float2 v = L.x[FPAD(tid + 512 * k)]; specg[tid + 512 * k] = make_float2(v.x * (1.f / 16384.f), v.y * (1.f / 16384.f)); }
      const float dsk = p.hy_d[(layer * 2 + o) * 256 + c];
#pragma unroll 1
      for (int pr = 0; pr < 2; ++pr) {
        const int b0 = pr * 2, b1 = pr * 2 + 1;
        asm volatile("" : "+v"(tid));
        __syncthreads();
        if (o == 0) {
          const bf16_t* u0 = p.prep + ((size_t)(b0 * 768 + c)) * SEQ; const bf16_t* u1 = p.prep + ((size_t)(b1 * 768 + c)) * SEQ;
#pragma unroll 8
          for (int n2 = tid; n2 < SEQ / 2; n2 += NT) { unsigned x0 = *(const unsigned*)(u0 + 2 * n2), x1 = *(const unsigned*)(u1 + 2 * n2);
            *(float4*)&L.x[FPAD(2 * n2)] = make_float4(bf2f((bf16_t)(x0 & 0xffff)), bf2f((bf16_t)(x1 & 0xffff)), bf2f((bf16_t)(x0 >> 16)), bf2f((bf16_t)(x1 >> 16))); }
        } else {
          const float* u0 = p.zbuf + ((size_t)(b0 * 256 + c)) * SEQ; const float* u1 = p.zbuf + ((size_t)(b1 * 256 + c)) * SEQ;
#pragma unroll 8
          for (int n2 = tid; n2 < SEQ / 2; n2 += NT) { float2 x0 = *(const float2*)(u0 + 2 * n2), x1 = *(const float2*)(u1 + 2 * n2); *(float4*)&L.x[FPAD(2 * n2)] = make_float4(x0.x, x1.x, x0.y, x1.y); }
        }
        __syncthreads();
        fft16k<false, true>(L, tid);
#pragma unroll
        for (int k = 0; k < 32; ++k) { float2 v = L.x[FPAD(tid + 512 * k)]; L.x[FPAD(tid + 512 * k)] = cmulf(v, specg[tid + 512 * k]); }
        __syncthreads();
        fft16k<true, true>(L, tid);
        if (o == 0) {
          const bf16_t* v0 = p.prep + ((size_t)(b0 * 768 + c)) * SEQ; const bf16_t* v1 = p.prep + ((size_t)(b1 * 768 + c)) * SEQ;
          const bf16_t* g0 = p.prep + ((size_t)(b0 * 768 + 256 + c)) * SEQ; const bf16_t* g1 = p.prep + ((size_t)(b1 * 768 + 256 + c)) * SEQ;
          float* z0 = p.zbuf + ((size_t)(b0 * 256 + c)) * SEQ; float* z1 = p.zbuf + ((size_t)(b1 * 256 + c)) * SEQ;
#pragma unroll 8
          for (int n = tid; n < SEQ; n += NT) { float2 y = L.x[FPAD(n)]; z0[n] = bf2f(g0[n]) * (y.x + dsk * bf2f(v0[n])); z1[n] = bf2f(g1[n]) * (y.y + dsk * bf2f(v1[n])); }
        } else {
          const float* z0 = p.zbuf + ((size_t)(b0 * 256 + c)) * SEQ; const float* z1 = p.zbuf + ((size_t)(b1 * 256 + c)) * SEQ;
          float* y0 = p.yt + ((size_t)(b0 * 256 + c)) * SEQ; float* y1 = p.yt + ((size_t)(b1 * 256 + c)) * SEQ;
#pragma unroll 8
          for (int n = tid; n < SEQ; n += NT) { float2 y = L.x[FPAD(n)]; y0[n] = y.x + dsk * z0[n]; y1[n] = y.y + dsk * z1[n]; }
        }
      }
      __threadfence();
    }
    __syncthreads();
  }
}
__device__ __forceinline__ void phase_hy_fin(CParams& p, int bid, int nb, int tid_, char* smem) {
  bf16_t (*tl)[264] = (bf16_t (*)[264])smem;
  for (int task = bid; task < NB * (SEQ / 64); task += nb) {
    int tid = tid_; asm volatile("" : "+v"(tid));
    const int b = task / (SEQ / 64), t0 = (task % (SEQ / 64)) * 64;
#pragma unroll 8
    for (int i = tid; i < 256 * 64; i += NT) { const int t = i & 63, c = i >> 6;
      float v = bf2f(p.prep[((size_t)(b * 768 + 512 + c)) * SEQ + t0 + t]) * p.yt[((size_t)(b * 256 + c)) * SEQ + t0 + t];
      tl[t][c] = f2bf(v); }
    __syncthreads();
    for (int i = tid; i < 64 * 32; i += NT) { const int t = i >> 5, ch = i & 31; *(uint4*)(p.y + ((size_t)b * SEQ + t0 + t) * D + 256 + ch * 8) = *(const uint4*)&tl[t][ch * 8]; }
    __syncthreads();
  }
}

__device__ __forceinline__ void phase_mb_prep(CParams& p, int layer, int bid, int nb, int tid_) {
  const int lane = tid_ & 63, wv = tid_ >> 6;
  const float* w = p.mb_conv_w + (size_t)layer * 3 * 768; const float* bs = p.mb_conv_b + layer * 768;
  for (int row0 = (bid * NW + wv) * 4; row0 < TT; row0 += nb * NW * 4) {
    float o[4][2][8];
#pragma unroll
    for (int r = 0; r < 4; ++r) { const int row = row0 + r; const int rm = seq_nb(row, -1, true), rp = seq_nb(row, 1, true);
#pragma unroll
      for (int j = 0; j < 2; ++j) { const int ck = lane + 64 * j; if (ck < 96) conv8(p.u, U_MB + 256, row, rm, rp, w, bs, ck * 8, o[r][j]); } }
#pragma unroll
    for (int r = 0; r < 4; ++r) { const int row = row0 + r;
#pragma unroll
      for (int j = 0; j < 2; ++j) { const int ck = lane + 64 * j; if (ck < 96) {
#pragma unroll
          for (int e = 0; e < 8; ++e) o[r][j][e] = siluf(o[r][j][e]);
          uint4 pk; pk.x = pack2(o[r][j][0], o[r][j][1]); pk.y = pack2(o[r][j][2], o[r][j][3]); pk.z = pack2(o[r][j][4], o[r][j][5]); pk.w = pack2(o[r][j][6], o[r][j][7]); *(uint4*)(p.prep + (size_t)row * 768 + ck * 8) = pk; } }
      if (lane < 8) p.dt[(size_t)row * 8 + lane] = softplusf_(bf2f(p.u[(size_t)row * NU + U_MB + 1024 + lane]) + p.mb_dt_bias[layer * 8 + lane]); }
  }
}
__device__ __forceinline__ int mb_row(int b, int cpos, int i) {
  if (cpos < 4) return TL + b * CTX + cpos * 64 + i;
  const int n = cpos - 4; return b * SEQ + ((n & 1) * 64 + i) * 64 + (n >> 1);
}
struct MbLds {
  bf16_t bimg[64][136]; bf16_t cimg[64][136];
  bf16_t bt[128][72];
  bf16_t xt[2][64][72];
  bf16_t pm[2][64][72];
  float ox[64][65];
  float dtv[2][64], cum[2][64], tot[2]; int rows[64];
};
template <int PASS>
__device__ __forceinline__ void phase_mb_chunk(CParams& p, int layer, int bid, int nb, int tid_, char* smem) {
  MbLds& L = *(MbLds*)smem;
  const int c_lo = (PASS == 1 && layer == DEPTH - 1) ? 4 : 0, ncp = NCH - c_lo;
  uint4 pbc[4]; float pdt = 0.f;
#pragma unroll
  for (int q = 0; q < 4; ++q) pbc[q] = make_uint4(0u, 0u, 0u, 0u);
  auto mfetch = [&](int task_, int tid) { const int h_ = task_ & 3, cpos_ = c_lo + (task_ >> 2) % ncp, b_ = (task_ >> 2) / ncp, g_ = h_ >> 1;
#pragma unroll
    for (int q = 0; q < 4; ++q) { const int i = tid + q * NT, which = i >> 10, t = (i >> 4) & 63, ch = i & 15;
      pbc[q] = *(const uint4*)(p.prep + (size_t)mb_row(b_, cpos_, t) * 768 + 256 + which * 256 + g_ * 128 + ch * 8); }
    if (tid < 128) pdt = p.dt[(size_t)mb_row(b_, cpos_, tid & 63) * 8 + (tid >> 6) * 4 + h_]; };
  if (bid < NB * ncp * 4) mfetch(bid, tid_);
  for (int task = bid; task < NB * ncp * 4; task += nb) {
    int tid = tid_; asm volatile("" : "+v"(tid));
    const int lane = tid & 63, wv = tid >> 6, fr = lane & 15, fq = lane >> 4, dirw = wv >> 2, s4 = wv & 3;
    const int h = task & 3, cpos = c_lo + (task >> 2) % ncp, b = (task >> 2) / ncp, g = h >> 1;
    bf16x8 sfo[4][4]; float xsv[4][4], zzv[4][4];
    if (PASS == 1) { const bf16_t* sb0 = p.mb_l + ((size_t)((b * 4 + h) * 2 + dirw) * NCH + scan_idx(cpos, dirw)) * 8192;
#pragma unroll
      for (int ks = 0; ks < 4; ++ks)
#pragma unroll
        for (int n = 0; n < 4; ++n) sfo[ks][n] = *(const bf16x8*)(sb0 + (n * 16 + fr) * 128 + ks * 32 + fq * 8);
      if (dirw == 0) {
#pragma unroll
        for (int n = 0; n < 4; ++n)
#pragma unroll
          for (int q = 0; q < 4; ++q) { const int row = mb_row(b, cpos, s4 * 16 + fq * 4 + q), pc = n * 16 + fr;
            xsv[n][q] = bf2f(p.prep[(size_t)row * 768 + h * 64 + pc]); zzv[n][q] = bf2f(p.u[(size_t)row * NU + U_MB + h * 64 + pc]); } } }
    if (tid < 64) L.rows[tid] = mb_row(b, cpos, tid);
    if (tid < 128) L.dtv[tid >> 6][tid & 63] = pdt;
#pragma unroll
    for (int q = 0; q < 4; ++q) { const int i = tid + q * NT, which = i >> 10, t = (i >> 4) & 63, ch = i & 15; *(uint4*)(which ? &L.cimg[t][ch * 8] : &L.bimg[t][ch * 8]) = pbc[q]; }
    if (task + nb < NB * ncp * 4) mfetch(task + nb, tid);
    __syncthreads();
    if (wv < 2) { const int dir = wv, i = dir ? 63 - lane : lane; const float a = -__expf(p.mb_a_log[layer * 8 + dir * 4 + h]);
      float v = L.dtv[dir][i] * a;
#pragma unroll
      for (int o = 1; o < 64; o <<= 1) { const float t = __shfl_up(v, o); if (lane >= o) v += t; }
      L.cum[dir][i] = v; if (lane == 63) L.tot[dir] = v; }
    __syncthreads();
    if (PASS == 0) {
      for (int i = tid; i < 128 * 16; i += NT) { int n = i & 127, f0 = (i >> 7) * 4; uint2 pk;
        pk.x = (unsigned)L.bimg[f0][n] | ((unsigned)L.bimg[f0 + 1][n] << 16); pk.y = (unsigned)L.bimg[f0 + 2][n] | ((unsigned)L.bimg[f0 + 3][n] << 16);
        *(uint2*)&L.bt[n][f0] = pk; }
#pragma unroll
      for (int i = tid; i < 2 * 64 * 16; i += NT) { int pc = i & 63, f0 = ((i >> 6) & 15) * 4, dir = i >> 10; float v[4];
#pragma unroll
        for (int q = 0; q < 4; ++q) v[q] = bf2f(p.prep[(size_t)L.rows[f0 + q] * 768 + h * 64 + pc]) * L.dtv[dir][f0 + q] * __expf(L.tot[dir] - L.cum[dir][f0 + q]);
        uint2 pk; pk.x = pack2(v[0], v[1]); pk.y = pack2(v[2], v[3]); *(uint2*)&L.xt[dir][pc][f0] = pk; }
      __syncthreads();
      const int seq = (b * 4 + h) * 2 + dirw, nsc = scan_idx(cpos, dirw);
      f32x4 acc[2][4];
#pragma unroll
      for (int m = 0; m < 2; ++m)
#pragma unroll
        for (int n = 0; n < 4; ++n) acc[m][n] = (f32x4){0.f, 0.f, 0.f, 0.f};
      wmm<2, 4, 2, 72, 72>(acc, &L.bt[s4 * 32][0], &L.xt[dirw][0][0], fr, fq);
      bf16_t* dst = p.mb_l + ((size_t)seq * NCH + nsc) * 8192;
#pragma unroll
      for (int m = 0; m < 2; ++m)
#pragma unroll
        for (int n = 0; n < 4; ++n) { uint2 pk; pk.x = pack2(acc[m][n][0], acc[m][n][1]); pk.y = pack2(acc[m][n][2], acc[m][n][3]);
          *(uint2*)(dst + (n * 16 + fr) * 128 + s4 * 32 + m * 16 + fq * 4) = pk; }
      if (tid < 2) p.mb_dec[(size_t)((b * 4 + h) * 2 + tid) * NCH + scan_idx(cpos, tid)] = __expf(L.tot[tid]);
    } else {
#pragma unroll
      for (int i = tid; i < 64 * 16; i += NT) { int pc = i & 63, f0 = (i >> 6) * 4; uint2 pk; unsigned short v[4];
#pragma unroll
        for (int q = 0; q < 4; ++q) v[q] = p.prep[(size_t)L.rows[f0 + q] * 768 + h * 64 + pc];
        pk.x = (unsigned)v[0] | ((unsigned)v[1] << 16); pk.y = (unsigned)v[2] | ((unsigned)v[3] << 16); *(uint2*)&L.xt[0][pc][f0] = pk; }
      { f32x4 acc[4][1];
#pragma unroll
        for (int m = 0; m < 4; ++m) acc[m][0] = (f32x4){0.f, 0.f, 0.f, 0.f};
        wmm<4, 1, 4, 136, 136>(acc, &L.bimg[0][0], &L.cimg[s4 * 16][0], fr, fq);
        const int i = s4 * 16 + fr; const float ci = L.cum[dirw][i];
#pragma unroll
        for (int m = 0; m < 4; ++m) { float v[4];
#pragma unroll
          for (int q = 0; q < 4; ++q) { int j = m * 16 + fq * 4 + q; bool keep = dirw == 0 ? (j <= i) : (j >= i);
            v[q] = keep ? acc[m][0][q] * __expf(ci - L.cum[dirw][j]) * L.dtv[dirw][j] : 0.f; }
          uint2 pk; pk.x = pack2(v[0], v[1]); pk.y = pack2(v[2], v[3]); *(uint2*)&L.pm[dirw][i][m * 16 + fq * 4] = pk; } }
      __syncthreads();
      f32x4 ao[1][4];
#pragma unroll
      for (int n = 0; n < 4; ++n) ao[0][n] = (f32x4){0.f, 0.f, 0.f, 0.f};
      {
#pragma unroll
        for (int ks = 0; ks < 4; ++ks) { bf16x8 a = *(const bf16x8*)&L.cimg[s4 * 16 + fr][ks * 32 + fq * 8];
#pragma unroll
          for (int n = 0; n < 4; ++n) ao[0][n] = __builtin_amdgcn_mfma_f32_16x16x32_bf16(a, sfo[ks][n], ao[0][n], 0, 0, 0); } }
#pragma unroll
      for (int q = 0; q < 4; ++q) { const float e = __expf(L.cum[dirw][s4 * 16 + fq * 4 + q]);
#pragma unroll
        for (int n = 0; n < 4; ++n) ao[0][n][q] *= e; }
      wmm<1, 4, 2, 72, 72>(ao, &L.pm[dirw][s4 * 16][0], &L.xt[0][0][0], fr, fq);
      if (dirw == 1) {
#pragma unroll
        for (int n = 0; n < 4; ++n)
#pragma unroll
          for (int q = 0; q < 4; ++q) L.ox[s4 * 16 + fq * 4 + q][n * 16 + fr] = ao[0][n][q]; }
      __syncthreads();
      if (dirw == 0) {
        const float dsk = p.mb_d[layer * 4 + h];
        float ss[4] = {0.f, 0.f, 0.f, 0.f};
#pragma unroll
        for (int n = 0; n < 4; ++n)
#pragma unroll
          for (int q = 0; q < 4; ++q) { const int i = s4 * 16 + fq * 4 + q, pc = n * 16 + fr;
            float v = (ao[0][n][q] + L.ox[i][pc] + xsv[n][q] * dsk) * siluf(zzv[n][q]); ao[0][n][q] = v; ss[q] += v * v; }
#pragma unroll
        for (int q = 0; q < 4; ++q) {
#pragma unroll
          for (int o = 1; o < 16; o <<= 1) ss[q] += __shfl_xor(ss[q], o);
          ss[q] = rsqrtf(ss[q] * (1.f / 64.f) + 1e-6f); }
#pragma unroll
        for (int n = 0; n < 4; ++n) { const int c = h * 64 + n * 16 + fr; const float nw = p.mb_norm[layer * 256 + c];
#pragma unroll
          for (int q = 0; q < 4; ++q) p.y[(size_t)L.rows[s4 * 16 + fq * 4 + q] * D + 512 + c] = f2bf(ao[0][n][q] * ss[q] * nw); }
      }
    }
    __syncthreads();
  }
}
__device__ __forceinline__ void phase_mb_state(CParams& p, int bid, int nb, int tid_) {
  for (int i = bid * NT + tid_; i < 32 * 4096; i += nb * NT) {
    const int seq = i >> 12, e2 = (i & 4095) * 2;
    unsigned* lp = (unsigned*)(p.mb_l + (size_t)seq * NCH * 8192 + e2);
    const float* dp = p.mb_dec + (size_t)seq * NCH;
    float s0 = 0.f, s1 = 0.f;
    for (int n = 0; n < NCH; n += 12) {
      unsigned lv[12]; float dc[12];
#pragma unroll
      for (int q = 0; q < 12; ++q) { lv[q] = lp[(size_t)(n + q) * 4096]; dc[q] = dp[n + q]; }
#pragma unroll
      for (int q = 0; q < 12; ++q) { lp[(size_t)(n + q) * 4096] = pack2(s0, s1); s0 = s0 * dc[q] + bf2f((bf16_t)(lv[q] & 0xffff)); s1 = s1 * dc[q] + bf2f((bf16_t)(lv[q] >> 16)); }
    }
  }
}

__device__ __forceinline__ void phase_dn_prep(CParams& p, int layer, int bid, int nb, int tid_) {
  const int lane = tid_ & 63, wv = tid_ >> 6;
  const float* w = p.dn_conv_w + (size_t)layer * 3 * 768;
  for (int row0 = (bid * NW + wv) * 4; row0 < TT; row0 += nb * NW * 4) {
   float oo[4][2][8];
#pragma unroll
   for (int r = 0; r < 4; ++r) { const int row = row0 + r; const int rm = seq_nb(row, -1, false), rp = seq_nb(row, 1, false);
#pragma unroll
     for (int j = 0; j < 2; ++j) { const int ck = lane + 64 * j; if (ck < 96) conv8(p.u, U_DN, row, rm, rp, w, nullptr, ck * 8, oo[r][j]); } }
#pragma unroll
   for (int r = 0; r < 4; ++r) { const int row = row0 + r;
#pragma unroll
    for (int j = 0; j < 2; ++j) { const int ck = lane + 64 * j;
      if (ck < 96) { float (&o)[8] = oo[r][j];
        float ss = 0.f;
#pragma unroll
        for (int e = 0; e < 8; ++e) { o[e] = siluf(o[e]); ss += o[e] * o[e]; }
        if (j == 0) { ss += __shfl_xor(ss, 1); ss += __shfl_xor(ss, 2); ss += __shfl_xor(ss, 4); const float r = rsqrtf(ss + 1e-6f) * (ck < 32 ? 0.125f : 1.f);
#pragma unroll
          for (int e = 0; e < 8; ++e) o[e] *= r; }
        uint4 pk; pk.x = pack2(o[0], o[1]); pk.y = pack2(o[2], o[3]); pk.z = pack2(o[4], o[5]); pk.w = pack2(o[6], o[7]); *(uint4*)(p.prep + (size_t)row * 768 + ck * 8) = pk; } }
    if (lane < 8) {
      float beta = sigmoidf_(bf2f(p.u[(size_t)row * NU + U_DN + 1024 + lane]));
      float g = -__expf(p.dn_a_log[layer * 8 + lane]) * softplusf_(bf2f(p.u[(size_t)row * NU + U_DN + 1032 + lane]) + p.dn_dt_bias[layer * 8 + lane]);
      p.bg[(size_t)row * 16 + lane * 2] = beta; p.bg[(size_t)row * 16 + lane * 2 + 1] = g;
    }
   }
  }
}
struct DnLds {
  bf16_t q[64][72], k[64][72], v[64][72];
  float md[2][4][16][17];
  bf16_t msb[2][64][72];
  bf16_t td[2][4][16][40];
  bf16_t tmp[8][32][40];
  bf16_t a1[2][64][72];
  bf16_t wq[2][64][72];
  bf16_t ut[2][64][72];
  float ox[64][65];
  float beta[2][64], gl[2][64], cum[2][64], tot[2];
};
template <int PASS>
__device__ __forceinline__ void phase_dn_chunk(CParams& p, int layer, int bid, int nb, int tid_, char* smem) {
  DnLds& L = *(DnLds*)smem;
  const int c_lo = (PASS == 1 && layer == DEPTH - 1) ? 4 : 0, ncp = NCH - c_lo;
  uint4 pq = make_uint4(0u, 0u, 0u, 0u), pk_ = pq, pv = pq; float2 pbg = make_float2(0.f, 0.f);
  auto fetch = [&](int task_, int tid) { const int h_ = task_ & 3, cpos_ = c_lo + (task_ >> 2) % ncp, b_ = (task_ >> 2) / ncp; const int r0_ = chunk_row0(b_, cpos_);
    if (tid < 128) pbg = *(const float2*)(p.bg + (size_t)(r0_ + (tid & 63)) * 16 + ((tid >> 6) * 4 + h_) * 2);
    const bf16_t* src = p.prep + (size_t)(r0_ + (tid >> 3)) * 768 + h_ * 64 + (tid & 7) * 8;
    if (PASS == 1) pq = *(const uint4*)src;
    pk_ = *(const uint4*)(src + 256); pv = *(const uint4*)(src + 512); };
  if (bid < NB * ncp * 4) fetch(bid, tid_);
  for (int task = bid; task < NB * ncp * 4; task += nb) {
    int tid = tid_; asm volatile("" : "+v"(tid));
    const int lane = tid & 63, wv = tid >> 6, fr = lane & 15, fq = lane >> 4, dirw = wv >> 2, s4 = wv & 3;
    const int h = task & 3, cpos = c_lo + (task >> 2) % ncp, b = (task >> 2) / ncp;
    const int row0 = chunk_row0(b, cpos);
    bf16x8 sfr[2], sfo[2][4]; float ogv[4][4];
    if (PASS == 1) { const bf16_t* sb0 = p.dn_l + ((size_t)((b * 4 + h) * 2 + dirw) * NCH + scan_idx(cpos, dirw)) * 4096;
#pragma unroll
      for (int ks = 0; ks < 2; ++ks) { sfr[ks] = *(const bf16x8*)(sb0 + (s4 * 16 + fr) * 64 + ks * 32 + fq * 8);
#pragma unroll
        for (int n = 0; n < 4; ++n) sfo[ks][n] = *(const bf16x8*)(sb0 + (n * 16 + fr) * 64 + ks * 32 + fq * 8); }
#pragma unroll
      for (int n = 0; n < 4; ++n)
#pragma unroll
        for (int qq = 0; qq < 4; ++qq) ogv[n][qq] = bf2f(p.u[(size_t)(row0 + s4 * 16 + fq * 4 + qq) * NU + U_DN + 768 + h * 64 + n * 16 + fr]); }
    if (tid < 128) { L.beta[tid >> 6][tid & 63] = pbg.x; L.gl[tid >> 6][tid & 63] = pbg.y; }
    { const int t = tid >> 3, ch = tid & 7;
      if (PASS == 1) *(uint4*)&L.q[t][ch * 8] = pq;
      *(uint4*)&L.k[t][ch * 8] = pk_; *(uint4*)&L.v[t][ch * 8] = pv; }
    if (task + nb < NB * ncp * 4) fetch(task + nb, tid);
    for (int i = tid; i < (int)(sizeof(L.td) / 16); i += NT) ((uint4*)&L.td[0][0][0][0])[i] = make_uint4(0u, 0u, 0u, 0u);
    for (int i = tid; i < (int)(sizeof(L.tmp) / 16); i += NT) ((uint4*)&L.tmp[0][0][0])[i] = make_uint4(0u, 0u, 0u, 0u);
    for (int i = tid; i < (int)(sizeof(L.ut) / 16); i += NT) { ((uint4*)&L.ut[0][0][0])[i] = make_uint4(0u, 0u, 0u, 0u); ((uint4*)&L.wq[0][0][0])[i] = make_uint4(0u, 0u, 0u, 0u); }
    __syncthreads();
    if (wv < 2) { const int dir = wv, f = dir ? 63 - lane : lane;
      float v = L.gl[dir][f];
#pragma unroll
      for (int o = 1; o < 64; o <<= 1) { const float t = __shfl_up(v, o); if (lane >= o) v += t; }
      L.cum[dir][f] = v; if (lane == 63) L.tot[dir] = v; }
    __syncthreads();
    { f32x4 acc[4][1];
#pragma unroll
      for (int m = 0; m < 4; ++m) acc[m][0] = (f32x4){0.f, 0.f, 0.f, 0.f};
      wmm<4, 1, 2, 72, 72>(acc, &L.k[0][0], &L.k[s4 * 16][0], fr, fq);
      const int j = s4 * 16 + fr; const float cj = L.cum[dirw][j]; const int sj = dirw ? 63 - j : j;
#pragma unroll
      for (int m = 0; m < 4; ++m)
#pragma unroll
        for (int qq = 0; qq < 4; ++qq) { const int i = m * 16 + fq * 4 + qq, si = dirw ? 63 - i : i; const bool keep = sj < si;
          const float v = keep ? L.beta[dirw][i] * acc[m][0][qq] * __expf(L.cum[dirw][i] - cj) : 0.f;
          L.msb[dirw][si][sj] = f2bf(v);
          if ((si >> 4) == (sj >> 4)) L.md[dirw][si >> 4][sj & 15][si & 15] = v; } }
    __syncthreads();
    if (wv < 2) { const int dir = wv, d = lane >> 4, c = lane & 15;
      float x[16];
#pragma unroll
      for (int s = 0; s < 16; ++s) x[s] = s == c ? 1.f : 0.f;
#pragma unroll
      for (int t = 0; t < 15; ++t) { const float xt = x[t];
#pragma unroll
        for (int s = t + 1; s < 16; ++s) x[s] -= L.md[dir][d][t][s] * xt; }
#pragma unroll
      for (int s = 0; s < 16; ++s) L.td[dir][d][s][c] = f2bf(x[s]); }
    __syncthreads();
    { bf16_t* xb = s4 < 2 ? &L.ut[dirw][s4 * 32][0] : &L.wq[dirw][(s4 - 2) * 32][0];
      const bf16_t (*src)[72] = s4 < 2 ? L.v : L.k; const int cb = (s4 & 1) * 32;
#pragma unroll
      for (int I = 0; I < 4; ++I) {
        f32x4 acc[1][2];
#pragma unroll
        for (int nt = 0; nt < 2; ++nt)
#pragma unroll
          for (int qq = 0; qq < 4; ++qq) { const int s = I * 16 + fq * 4 + qq, f = dirw ? 63 - s : s; const float sc = s4 < 2 ? L.beta[dirw][f] : L.beta[dirw][f] * __expf(L.cum[dirw][f]);
            acc[0][nt][qq] = sc * bf2f(src[f][cb + nt * 16 + fr]); }
        if (I > 0) { f32x4 pr[1][2] = {{{0.f, 0.f, 0.f, 0.f}, {0.f, 0.f, 0.f, 0.f}}};
          wmm<1, 2, 2, 72, 72>(pr, &L.msb[dirw][I * 16][0], xb, fr, fq);
#pragma unroll
          for (int nt = 0; nt < 2; ++nt) acc[0][nt] -= pr[0][nt]; }
#pragma unroll
        for (int nt = 0; nt < 2; ++nt) { uint2 pk; pk.x = pack2(acc[0][nt][0], acc[0][nt][1]); pk.y = pack2(acc[0][nt][2], acc[0][nt][3]); *(uint2*)&L.tmp[wv][nt * 16 + fr][fq * 4] = pk; }
        asm volatile("" ::: "memory");
        f32x4 xs[1][2] = {{{0.f, 0.f, 0.f, 0.f}, {0.f, 0.f, 0.f, 0.f}}};
        wmm<1, 2, 1, 40, 40>(xs, &L.td[dirw][I][0][0], &L.tmp[wv][0][0], fr, fq);
#pragma unroll
        for (int nt = 0; nt < 2; ++nt) { uint2 pk; pk.x = pack2(xs[0][nt][0], xs[0][nt][1]); pk.y = pack2(xs[0][nt][2], xs[0][nt][3]); *(uint2*)(xb + (nt * 16 + fr) * 72 + I * 16 + fq * 4) = pk; }
        asm volatile("" ::: "memory");
      } }
    if (PASS == 0) {
      for (int i = tid; i < 2 * 64 * 16; i += NT) { int d = i & 63, f0 = ((i >> 6) & 15) * 4, dir = i >> 10; float v[4];
#pragma unroll
        for (int qq = 0; qq < 4; ++qq) v[qq] = bf2f(L.k[f0 + qq][d]) * __expf(L.tot[dir] - L.cum[dir][f0 + qq]);
        uint2 pk;
        if (dir == 0) { pk.x = pack2(v[0], v[1]); pk.y = pack2(v[2], v[3]); *(uint2*)&L.a1[0][d][f0] = pk; }
        else { pk.x = pack2(v[3], v[2]); pk.y = pack2(v[1], v[0]); *(uint2*)&L.a1[1][d][60 - f0] = pk; } }
      __syncthreads();
      const int seq = (b * 4 + h) * 2 + dirw, nsc = scan_idx(cpos, dirw); const float dec = __expf(L.tot[dirw]);
      { f32x4 acc[4][1];
#pragma unroll
        for (int m = 0; m < 4; ++m) acc[m][0] = (f32x4){0.f, 0.f, 0.f, 0.f};
        wmm<4, 1, 2, 72, 72>(acc, &L.wq[dirw][0][0], &L.a1[dirw][s4 * 16][0], fr, fq);
        const int d = s4 * 16 + fr; bf16_t* dst = p.dn_m + ((size_t)seq * NCH + nsc) * 4096 + d * 64;
#pragma unroll
        for (int m = 0; m < 4; ++m) { float v[4];
#pragma unroll
          for (int qq = 0; qq < 4; ++qq) { int d2 = m * 16 + fq * 4 + qq; v[qq] = (d2 == d ? dec : 0.f) - acc[m][0][qq]; }
          uint2 pk; pk.x = pack2(v[0], v[1]); pk.y = pack2(v[2], v[3]); *(uint2*)(dst + m * 16 + fq * 4) = pk; } }
      { f32x4 acc[4][1];
#pragma unroll
        for (int m = 0; m < 4; ++m) acc[m][0] = (f32x4){0.f, 0.f, 0.f, 0.f};
        wmm<4, 1, 2, 72, 72>(acc, &L.a1[dirw][0][0], &L.ut[dirw][s4 * 16][0], fr, fq);
        bf16_t* dst = p.dn_l + ((size_t)seq * NCH + nsc) * 4096 + (s4 * 16 + fr) * 64;
#pragma unroll
        for (int m = 0; m < 4; ++m) { uint2 pk; pk.x = pack2(acc[m][0][0], acc[m][0][1]); pk.y = pack2(acc[m][0][2], acc[m][0][3]); *(uint2*)(dst + m * 16 + fq * 4) = pk; } }
    } else {
      __syncthreads();
      for (int i = tid; i < 2 * 64 * 16; i += NT) { int d = i & 63, s0 = ((i >> 6) & 15) * 4, dir = i >> 10; const uint2 wv2 = *(const uint2*)&L.wq[dir][d][s0];
        L.a1[dir][s0][d] = (bf16_t)(wv2.x & 0xffff); L.a1[dir][s0 + 1][d] = (bf16_t)(wv2.x >> 16); L.a1[dir][s0 + 2][d] = (bf16_t)(wv2.y & 0xffff); L.a1[dir][s0 + 3][d] = (bf16_t)(wv2.y >> 16); }
      __syncthreads();
      { f32x4 acc[4][1];
#pragma unroll
        for (int m = 0; m < 4; ++m) acc[m][0] = (f32x4){0.f, 0.f, 0.f, 0.f};
#pragma unroll
        for (int ks = 0; ks < 2; ++ks)
#pragma unroll
          for (int m = 0; m < 4; ++m) { bf16x8 a = *(const bf16x8*)&L.a1[dirw][m * 16 + fr][ks * 32 + fq * 8]; acc[m][0] = __builtin_amdgcn_mfma_f32_16x16x32_bf16(a, sfr[ks], acc[m][0], 0, 0, 0); }
        const int c = s4 * 16 + fr;
#pragma unroll
        for (int m = 0; m < 4; ++m) { uint2 uu = *(const uint2*)&L.ut[dirw][c][m * 16 + fq * 4];
          float v0 = bf2f((bf16_t)(uu.x & 0xffff)) - acc[m][0][0], v1 = bf2f((bf16_t)(uu.x >> 16)) - acc[m][0][1], v2 = bf2f((bf16_t)(uu.y & 0xffff)) - acc[m][0][2], v3 = bf2f((bf16_t)(uu.y >> 16)) - acc[m][0][3];
          uint2 pk; pk.x = pack2(v0, v1); pk.y = pack2(v2, v3); *(uint2*)&L.ut[dirw][c][m * 16 + fq * 4] = pk; } }
      { f32x4 acc[4][1];
#pragma unroll
        for (int m = 0; m < 4; ++m) acc[m][0] = (f32x4){0.f, 0.f, 0.f, 0.f};
        wmm<4, 1, 2, 72, 72>(acc, &L.k[0][0], &L.q[s4 * 16][0], fr, fq);
        const int i = s4 * 16 + fr; const float ci = L.cum[dirw][i];
#pragma unroll
        for (int m = 0; m < 4; ++m) { float v[4];
#pragma unroll
          for (int qq = 0; qq < 4; ++qq) { int j = m * 16 + fq * 4 + qq; bool keep = dirw == 0 ? (j <= i) : (j >= i); v[qq] = keep ? acc[m][0][qq] * __expf(ci - L.cum[dirw][j]) : 0.f; }
          uint2 pk;
          if (dirw == 0) { pk.x = pack2(v[0], v[1]); pk.y = pack2(v[2], v[3]); *(uint2*)&L.wq[0][i][m * 16 + fq * 4] = pk; }
          else { pk.x = pack2(v[3], v[2]); pk.y = pack2(v[1], v[0]); *(uint2*)&L.wq[1][i][60 - m * 16 - fq * 4] = pk; } } }
      __syncthreads();
      f32x4 ao[1][4];
#pragma unroll
      for (int n = 0; n < 4; ++n) ao[0][n] = (f32x4){0.f, 0.f, 0.f, 0.f};
#pragma unroll
      for (int ks = 0; ks < 2; ++ks) { bf16x8 a = *(const bf16x8*)&L.q[s4 * 16 + fr][ks * 32 + fq * 8];
#pragma unroll
        for (int n = 0; n < 4; ++n) ao[0][n] = __builtin_amdgcn_mfma_f32_16x16x32_bf16(a, sfo[ks][n], ao[0][n], 0, 0, 0); }
#pragma unroll
      for (int qq = 0; qq < 4; ++qq) { const float e = __expf(L.cum[dirw][s4 * 16 + fq * 4 + qq]);
#pragma unroll
        for (int n = 0; n < 4; ++n) ao[0][n][qq] *= e; }
      wmm<1, 4, 2, 72, 72>(ao, &L.wq[dirw][s4 * 16][0], &L.ut[dirw][0][0], fr, fq);
      if (dirw == 1) {
#pragma unroll
        for (int n = 0; n < 4; ++n)
#pragma unroll
          for (int qq = 0; qq < 4; ++qq) L.ox[s4 * 16 + fq * 4 + qq][n * 16 + fr] = ao[0][n][qq]; }
      __syncthreads();
      if (dirw == 0) {
        float ss[4] = {0.f, 0.f, 0.f, 0.f};
#pragma unroll
        for (int n = 0; n < 4; ++n)
#pragma unroll
          for (int qq = 0; qq < 4; ++qq) { ao[0][n][qq] += L.ox[s4 * 16 + fq * 4 + qq][n * 16 + fr]; ss[qq] += ao[0][n][qq] * ao[0][n][qq]; }
#pragma unroll
        for (int qq = 0; qq < 4; ++qq) {
#pragma unroll
          for (int o = 1; o < 16; o <<= 1) ss[qq] += __shfl_xor(ss[qq], o);
          ss[qq] = rsqrtf(ss[qq] * (1.f / 64.f) + 1e-6f); }
#pragma unroll
        for (int n = 0; n < 4; ++n) { const int c = h * 64 + n * 16 + fr; const float nw = p.dn_norm[layer * 256 + c];
#pragma unroll
          for (int qq = 0; qq < 4; ++qq) { const int f = s4 * 16 + fq * 4 + qq;
            p.y[(size_t)(row0 + f) * D + 768 + c] = f2bf(ao[0][n][qq] * ss[qq] * nw * siluf(ogv[n][qq])); } }
      }
    }
    __syncthreads();
  }
}
struct DnBLds { bf16_t sh[2][64][72]; bf16_t sl[2][64][72]; };
__device__ __forceinline__ void phase_dn_state(CParams& p, int bid, int nb, int tid_, char* smem) {
  DnBLds& L = *(DnBLds*)smem;
  const int tid = tid_, lane = tid & 63, wv = tid >> 6, fr = lane & 15, fq = lane >> 4, mt = wv >> 1, ntb = (wv & 1) * 2;
  for (int seq = bid; seq < 32; seq += nb) {
    for (int i = tid; i < 64 * 72 / 2; i += NT) { ((unsigned*)&L.sh[0][0][0])[i] = 0u; ((unsigned*)&L.sl[0][0][0])[i] = 0u; }
    __syncthreads();
    f32x4 S[2] = {{0.f, 0.f, 0.f, 0.f}, {0.f, 0.f, 0.f, 0.f}};
    const bf16_t* mb = p.dn_m + (size_t)seq * NCH * 4096 + (mt * 16 + fr) * 64 + fq * 8;
    bf16x8 a[2]; a[0] = *(const bf16x8*)mb; a[1] = *(const bf16x8*)(mb + 32);
    uint2* lbase[2]; uint2 lvn[2];
#pragma unroll
    for (int t = 0; t < 2; ++t) { lbase[t] = (uint2*)(p.dn_l + (size_t)seq * NCH * 4096 + ((ntb + t) * 16 + fr) * 64 + mt * 16 + fq * 4); lvn[t] = *lbase[t]; }
    for (int n = 0; n < NCH; ++n) {
      const int cur = n & 1;
      f32x4 acc[2];
#pragma unroll
      for (int t = 0; t < 2; ++t) { uint2* lp = lbase[t] + (size_t)n * 1024;
        const uint2 lv = lvn[t]; uint2 sv; sv.x = pack2(S[t][0], S[t][1]); sv.y = pack2(S[t][2], S[t][3]); *lp = sv;
        acc[t] = (f32x4){bf2f((bf16_t)(lv.x & 0xffff)), bf2f((bf16_t)(lv.x >> 16)), bf2f((bf16_t)(lv.y & 0xffff)), bf2f((bf16_t)(lv.y >> 16))}; }
      bf16x8 an[2] = {a[0], a[1]};
      if (n + 1 < NCH) { an[0] = *(const bf16x8*)(mb + (size_t)(n + 1) * 4096); an[1] = *(const bf16x8*)(mb + (size_t)(n + 1) * 4096 + 32);
#pragma unroll
        for (int t = 0; t < 2; ++t) lvn[t] = *(lbase[t] + (size_t)(n + 1) * 1024); }
#pragma unroll
      for (int ks = 0; ks < 2; ++ks)
#pragma unroll
        for (int t = 0; t < 2; ++t) { bf16x8 bh = *(const bf16x8*)&L.sh[cur][(ntb + t) * 16 + fr][ks * 32 + fq * 8], bl = *(const bf16x8*)&L.sl[cur][(ntb + t) * 16 + fr][ks * 32 + fq * 8];
          acc[t] = __builtin_amdgcn_mfma_f32_16x16x32_bf16(a[ks], bh, acc[t], 0, 0, 0); acc[t] = __builtin_amdgcn_mfma_f32_16x16x32_bf16(a[ks], bl, acc[t], 0, 0, 0); }
#pragma unroll
      for (int t = 0; t < 2; ++t) { S[t] = acc[t]; float hi[4], lo[4];
#pragma unroll
        for (int q = 0; q < 4; ++q) { hi[q] = bf2f(f2bf(acc[t][q])); lo[q] = acc[t][q] - hi[q]; }
        uint2 ph, pl; ph.x = pack2(hi[0], hi[1]); ph.y = pack2(hi[2], hi[3]); pl.x = pack2(lo[0], lo[1]); pl.y = pack2(lo[2], lo[3]);
        *(uint2*)&L.sh[cur ^ 1][(ntb + t) * 16 + fr][mt * 16 + fq * 4] = ph; *(uint2*)&L.sl[cur ^ 1][(ntb + t) * 16 + fr][mt * 16 + fq * 4] = pl; }
      a[0] = an[0]; a[1] = an[1];
      asm volatile("s_waitcnt lgkmcnt(0)" ::: "memory"); __builtin_amdgcn_s_barrier();
    }
    __syncthreads();
  }
}

__device__ __forceinline__ void row_router(CParams& p, const float4* rts, const float (&hv)[16], int lane, int row) {
  float lg[16];
#pragma unroll
  for (int e = 0; e < 16; ++e) lg[e] = 0.f;
#pragma unroll
  for (int i = 0; i < 4; ++i)
#pragma unroll
    for (int j = 0; j < 4; ++j) { float hvv = hv[i * 4 + j];
#pragma unroll
      for (int q = 0; q < 4; ++q) { float4 r4 = rts[((i * 4 + j) * 4 + q) * 64 + lane]; lg[q * 4] += hvv * r4.x; lg[q * 4 + 1] += hvv * r4.y; lg[q * 4 + 2] += hvv * r4.z; lg[q * 4 + 3] += hvv * r4.w; }
      if (j & 1) asm volatile("" ::: "memory"); }
  float mx = -1e30f;
#pragma unroll
  for (int e = 0; e < 16; ++e) { lg[e] = wave_sum(lg[e]); mx = fmaxf(mx, lg[e]); }
  float den = 0.f;
#pragma unroll
  for (int e = 0; e < 16; ++e) { lg[e] = expf(lg[e] - mx); den += lg[e]; }
  float inv = 1.f / den;
  if (lane < 16) { float v = 0.f;
#pragma unroll
    for (int e = 0; e < 16; ++e) v = lane == e ? lg[e] * inv : v;
    p.aff[(size_t)row * 16 + lane] = v; }
}
__device__ __forceinline__ void phase_postmix(CParams& p, int layer, int bid, int nb, int tid_, char* smem) {
  const int lane = tid_ & 63, wv = tid_ >> 6;
  float4* rts = (float4*)smem;
  for (int x = tid_; x < D * 4; x += NT) { const int ln = x & 63, q = (x >> 6) & 3, ij = x >> 8, k = (ij >> 2) * 256 + ln * 4 + (ij & 3); rts[x] = *(const float4*)(p.moe_router + ((size_t)layer * D + k) * 16 + q * 4); }
  __syncthreads();
  const int nrows = layer == 0 ? TT : TL, stride = nb * NW;
  const float* ng1 = p.norm_g + (size_t)layer * 4 * D + 1 * D;
  for (int row0 = bid * NW + wv; row0 < nrows; row0 += 2 * stride) {
    int rows[2] = {row0, row0 + stride}; const bool val1 = rows[1] < nrows; if (!val1) rows[1] = row0;
    uint2 yr[2][4]; float4 xr[2][4];
#pragma unroll
    for (int r = 0; r < 2; ++r) { const int row = rows[r];
      const float* xsrc = layer == 0 ? (row < TL ? p.x + (size_t)row * D : p.ctx + (size_t)(row - TL) * D) : xrow_ptr(p, row);
#pragma unroll
      for (int i = 0; i < 4; ++i) { yr[r][i] = *(const uint2*)(p.yo + (size_t)row * D + i * 256 + lane * 4); xr[r][i] = *(const float4*)(xsrc + i * 256 + lane * 4); } }
#pragma unroll
    for (int r = 0; r < 2; ++r) { if (r == 1 && !val1) break;
      const int row = rows[r]; float* xs = xrow_ptr(p, row);
      const float* m = p.mod + (size_t)(layer * 5 + mod_idx(row)) * 6 * D;
      float yv[16], xv[16], hv[16]; float ss = 0.f;
#pragma unroll
      for (int i = 0; i < 4; ++i) { const uint2 v = yr[r][i]; yv[i * 4] = __uint_as_float(v.x << 16); yv[i * 4 + 1] = __uint_as_float(v.x & 0xffff0000u); yv[i * 4 + 2] = __uint_as_float(v.y << 16); yv[i * 4 + 3] = __uint_as_float(v.y & 0xffff0000u); }
#pragma unroll
      for (int i = 0; i < 16; ++i) ss += yv[i] * yv[i];
      ss = wave_sum(ss);
      const float rstd = rsqrtf(ss * (1.f / D) + 1e-6f);
#pragma unroll
      for (int i = 0; i < 4; ++i) { const int k = i * 256 + lane * 4; const float4 xo = xr[r][i]; const float4 gg = *(const float4*)(ng1 + k); const float4 g1 = *(const float4*)(m + 2 * D + k);
        xv[i * 4] = xo.x + g1.x * yv[i * 4] * rstd * gg.x; xv[i * 4 + 1] = xo.y + g1.y * yv[i * 4 + 1] * rstd * gg.y; xv[i * 4 + 2] = xo.z + g1.z * yv[i * 4 + 2] * rstd * gg.z; xv[i * 4 + 3] = xo.w + g1.w * yv[i * 4 + 3] * rstd * gg.w;
        *(float4*)(xs + k) = make_float4(xv[i * 4], xv[i * 4 + 1], xv[i * 4 + 2], xv[i * 4 + 3]); }
      row_modulate_store(xv, p.norm_g + (size_t)layer * 4 * D + 2 * D, m + 3 * D, m + 4 * D, p.hb + (size_t)row * D, lane, hv);
      row_router(p, rts, hv, lane, row);
    }
  }
}
struct TkLds { unsigned key[SEQ]; unsigned hist[NW][256]; unsigned part[NT]; unsigned sh[4]; };
__device__ __forceinline__ void phase_topk(CParams& p, int layer, int bid, int nb, int tid_, char* smem) {
  TkLds& L = *(TkLds*)smem;
  if (layer == 0) for (int i = bid * NT + tid_; i < NE * 128; i += nb * NT) { const int sl = (i >> 7) * SLOTS_E + NB * CAP_L + NB * CAP_C + (i & 127); p.slot_tok[sl] = 0; p.slot_w[sl] = 0.f; }
  const int nlat = NB * NE, nctx = layer == 0 ? NB * NE : 0;
  for (int task = bid; task < nlat + nctx; task += nb) {
    int tid = tid_; asm volatile("" : "+v"(tid));
    int b, e, n, cap, rbase, sbase;
    if (task < nlat) { b = task / NE; e = task % NE; n = SEQ; cap = CAP_L; rbase = b * SEQ; sbase = e * SLOTS_E + b * CAP_L; }
    else { int j = task - nlat; b = j / NE; e = j % NE; n = CTX; cap = CAP_C; rbase = TL + b * CTX; sbase = e * SLOTS_E + NB * CAP_L + b * CAP_C; }
    __syncthreads();
#pragma unroll 16
    for (int s2 = tid; s2 < n; s2 += NT) L.key[s2] = __float_as_uint(p.aff[(size_t)(rbase + s2) * 16 + e]);
    unsigned prefix = 0u, remaining = (unsigned)cap;
#pragma unroll 1
    for (int pass = 0; pass < 4; ++pass) {
      const int shift = 24 - 8 * pass;
      for (int i = tid; i < NW * 256; i += NT) (&L.hist[0][0])[i] = 0u;
      __syncthreads();
      for (int s2 = tid; s2 < n; s2 += NT) { const unsigned k = L.key[s2]; if (pass == 0 || (k >> (shift + 8)) == (prefix >> (shift + 8))) atomicAdd(&L.hist[tid >> 6][(k >> shift) & 255u], 1u); }
      __syncthreads();
      if (tid < 256) { unsigned t = 0u;
#pragma unroll
        for (int w = 0; w < NW; ++w) t += L.hist[w][tid];
        L.hist[0][tid] = t; }
      __syncthreads();
      if (tid < 64) {
        unsigned c4[4]; unsigned loc = 0u;
#pragma unroll
        for (int e = 0; e < 4; ++e) { c4[e] = L.hist[0][255 - 4 * tid - e]; loc += c4[e]; }
        unsigned inc = loc;
#pragma unroll
        for (int o = 1; o < 64; o <<= 1) { const unsigned t = __shfl_up(inc, o); if (tid >= o) inc += t; }
        unsigned cum = inc - loc;
        const bool hit = inc >= remaining;
        const unsigned long long mk = __ballot(hit);
        const int first = mk ? __builtin_ctzll(mk) : 63;
        if (tid == first) { int e = 0;
#pragma unroll
          for (; e < 3; ++e) { if (cum + c4[e] >= remaining) break; cum += c4[e]; }
          const int d = 255 - 4 * tid - e; L.sh[0] = prefix | ((unsigned)d << shift); L.sh[1] = remaining - cum; } }
      __syncthreads();
      prefix = L.sh[0]; remaining = L.sh[1];
    }
    const int per = n / NT > 0 ? n / NT : 1, t0 = tid * per;
    unsigned cg = 0u, ce = 0u;
    if (t0 < n) for (int q = 0; q < per; ++q) { const unsigned k = L.key[t0 + q]; cg += k > prefix ? 1u : 0u; ce += k == prefix ? 1u : 0u; }
    L.part[tid] = cg | (ce << 16);
    __syncthreads();
    unsigned og = 0u, oe = 0u;
    for (int j = 0; j < NT; ++j) { const unsigned v = L.part[j]; if (j < tid) { og += v & 0xffffu; oe += v >> 16; } }
    if (t0 < n) for (int q = 0; q < per; ++q) {
      const unsigned k = L.key[t0 + q]; const int row = rbase + t0 + q;
      const bool sel = k > prefix || (k == prefix && oe < remaining);
      if (sel) { const int slot = sbase + (int)(og + (oe < remaining ? oe : remaining)); p.slot_tok[slot] = row; p.slot_w[slot] = __uint_as_float(k); p.tok_slot[(size_t)row * 16 + e] = slot; }
      else p.tok_slot[(size_t)row * 16 + e] = -1;
      og += k > prefix ? 1u : 0u; oe += k == prefix ? 1u : 0u;
    }
    __syncthreads();
  }
}
__device__ __forceinline__ void phase_combine(CParams& p, int layer, int bid, int nb, int tid_) {
  const int lane = tid_ & 63, wv = tid_ >> 6;
  const int nrows = layer == 0 ? TT : TL, stride = nb * NW;
  const float* ng3 = p.norm_g + (size_t)layer * 4 * D + 3 * D;
  for (int row0 = bid * NW + wv; row0 < nrows; row0 += 2 * stride) {
    int rows[2] = {row0, row0 + stride}; const bool val1 = rows[1] < nrows; if (!val1) rows[1] = row0;
    int sk[2][4]; unsigned long long rest[2]; int slotv[2];
#pragma unroll
    for (int r = 0; r < 2; ++r) { slotv[r] = lane < 16 ? p.tok_slot[(size_t)rows[r] * 16 + lane] : -1; }
#pragma unroll
    for (int r = 0; r < 2; ++r) { unsigned long long mk = __ballot(slotv[r] >= 0);
#pragma unroll
      for (int k = 0; k < 4; ++k) { if (mk) { const int bit = __builtin_ctzll(mk); sk[r][k] = __builtin_amdgcn_readlane(slotv[r], bit); mk &= mk - 1; } else sk[r][k] = -1; }
      rest[r] = mk; }
    uint2 pk[2][4][4]; float4 xr[2][4];
#pragma unroll
    for (int r = 0; r < 2; ++r) { const float* xs = xrow_ptr(p, rows[r]);
#pragma unroll
      for (int i = 0; i < 4; ++i) xr[r][i] = *(const float4*)(xs + i * 256 + lane * 4);
#pragma unroll
      for (int k = 0; k < 4; ++k) { const int sl = sk[r][k] >= 0 ? sk[r][k] : 0;
#pragma unroll
        for (int i = 0; i < 4; ++i) pk[r][k][i] = *(const uint2*)(p.ymoe + (size_t)sl * D + i * 256 + lane * 4); } }
#pragma unroll
    for (int r = 0; r < 2; ++r) { if (r == 1 && !val1) break;
      const int row = rows[r]; float* xs = xrow_ptr(p, row);
      float mv[16];
#pragma unroll
      for (int i = 0; i < 16; ++i) mv[i] = 0.f;
#pragma unroll
      for (int k = 0; k < 4; ++k) { const float wk = sk[r][k] >= 0 ? 1.f : 0.f;
#pragma unroll
        for (int i = 0; i < 4; ++i) { const uint2 q = pk[r][k][i];
          mv[i * 4] += wk * __uint_as_float(q.x << 16); mv[i * 4 + 1] += wk * __uint_as_float(q.x & 0xffff0000u); mv[i * 4 + 2] += wk * __uint_as_float(q.y << 16); mv[i * 4 + 3] += wk * __uint_as_float(q.y & 0xffff0000u); } }
      for (unsigned long long mk = rest[r]; mk; mk &= mk - 1) { const int slot = __builtin_amdgcn_readlane(slotv[r], __builtin_ctzll(mk));
#pragma unroll
        for (int i = 0; i < 4; ++i) { const uint2 q = *(const uint2*)(p.ymoe + (size_t)slot * D + i * 256 + lane * 4);
          mv[i * 4] += __uint_as_float(q.x << 16); mv[i * 4 + 1] += __uint_as_float(q.x & 0xffff0000u); mv[i * 4 + 2] += __uint_as_float(q.y << 16); mv[i * 4 + 3] += __uint_as_float(q.y & 0xffff0000u); } }
      float ss = 0.f;
#pragma unroll
      for (int i = 0; i < 16; ++i) ss += mv[i] * mv[i];
      ss = wave_sum(ss);
      const float rstd = rsqrtf(ss * (1.f / D) + 1e-6f);
      const float* m = p.mod + (size_t)(layer * 5 + mod_idx(row)) * 6 * D;
      float xv[16], hv[16];
#pragma unroll
      for (int i = 0; i < 4; ++i) { const int k = i * 256 + lane * 4; const float4 xo = xr[r][i]; const float4 gg = *(const float4*)(ng3 + k); const float4 g2 = *(const float4*)(m + 5 * D + k);
        xv[i * 4] = xo.x + g2.x * mv[i * 4] * rstd * gg.x; xv[i * 4 + 1] = xo.y + g2.y * mv[i * 4 + 1] * rstd * gg.y; xv[i * 4 + 2] = xo.z + g2.z * mv[i * 4 + 2] * rstd * gg.z; xv[i * 4 + 3] = xo.w + g2.w * mv[i * 4 + 3] * rstd * gg.w;
        *(float4*)(xs + k) = make_float4(xv[i * 4], xv[i * 4 + 1], xv[i * 4 + 2], xv[i * 4 + 3]); }
      if (layer + 1 < DEPTH) {
        const float* m2 = p.mod + (size_t)((layer + 1) * 5 + mod_idx(row)) * 6 * D;
        row_modulate_store(xv, p.norm_g + (size_t)(layer + 1) * 4 * D, m2, m2 + D, p.hb + (size_t)row * D, lane, hv);
      }
    }
  }
}

#define XB_TMO      128
#define XB_XCNT(j)  (256  + 64 * (j))
#define XB_XSUB(j)  (1280 + 64 * (j))
#define XB_XGEN(j)  (2304 + 64 * (j))
#define XB_TOP      3328
#define XB_TOPGEN   3392
#define XCD_BAR_WORDS 3456
#define XB_SPIN_CAP (1u << 22)
__device__ __forceinline__ unsigned xb_ld(unsigned* q)              { return __hip_atomic_load(q, __ATOMIC_RELAXED, __HIP_MEMORY_SCOPE_AGENT); }
__device__ __forceinline__ unsigned xb_add(unsigned* q, unsigned v) { return __hip_atomic_fetch_add(q, v, __ATOMIC_RELAXED, __HIP_MEMORY_SCOPE_AGENT); }
__device__ __forceinline__ unsigned xb_xcc_id() { return (unsigned)__builtin_amdgcn_s_getreg((3 << 11) | 20) & 0xFu; }
#define XB_SPIN(cond, bar) do { unsigned _sp = 0; while (cond) { __builtin_amdgcn_s_sleep(1); \
    if ((++_sp & 255u) == 0u) { if (xb_ld(&(bar)[XB_TMO])) break; if (_sp > XB_SPIN_CAP) { atomicAdd(&(bar)[XB_TMO], 1u); break; } } } } while (0)
struct XcdBarrier { unsigned* bar; unsigned x; volatile LAS unsigned* st; };
__device__ __forceinline__ XcdBarrier xcd_barrier_post(unsigned* bar, volatile LAS unsigned* st) {
  XcdBarrier b; b.bar = bar; b.x = xb_xcc_id(); b.st = st;
  if (threadIdx.x == 0) (void)xb_add(&bar[XB_XCNT(b.x)], 1u);
  return b;
}
__device__ __forceinline__ void xcd_barrier_complete(unsigned* bar, unsigned x, unsigned& nloc, unsigned& nx) {
  const unsigned G = gridDim.x * gridDim.y * gridDim.z;
  unsigned sum, cnt, mine, sp = 0u;
  for (;;) {
    sum = 0u; cnt = 0u; mine = 0u;
#pragma unroll
    for (unsigned j = 0; j < 16; ++j) { const unsigned c = xb_ld(&bar[XB_XCNT(j)]); sum += c; cnt += (c > 0u) ? 1u : 0u; mine = (j == x) ? c : mine; }
    if (sum == G) break;
    __builtin_amdgcn_s_sleep(1);
    if ((++sp & 255u) == 0u) { if (xb_ld(&bar[XB_TMO])) break; if (sp > XB_SPIN_CAP) { atomicAdd(&bar[XB_TMO], 1u); break; } }
  }
  nloc = mine > 0u ? mine : 1u; nx = cnt > 0u ? cnt : 1u;
}
__device__ __forceinline__ void xcd_barrier(const XcdBarrier& b) {
  asm volatile("s_waitcnt vmcnt(0)" ::: "memory");
  __syncthreads();
  if (threadIdx.x == 0) {
    unsigned* bar = b.bar;
    __builtin_amdgcn_s_waitcnt(0);
    unsigned nloc = b.st[0], nx = b.st[1];
    if (nloc == 0u) { xcd_barrier_complete(bar, b.x, nloc, nx); b.st[0] = nloc; b.st[1] = nx; }
    const unsigned old = xb_add(&bar[XB_XSUB(b.x)], 1u);
    const unsigned gen = old / nloc;
    if (old + 1u == (gen + 1u) * nloc) {
      __builtin_amdgcn_fence(__ATOMIC_RELEASE, "agent");
      asm volatile("s_waitcnt vmcnt(0)" ::: "memory");
      const unsigned og = xb_add(&bar[XB_TOP], 1u);
      const unsigned tg = og / nx;
      if (og + 1u == (tg + 1u) * nx) xb_add(&bar[XB_TOPGEN], 1u);
      else XB_SPIN(xb_ld(&bar[XB_TOPGEN]) == tg, bar);
      __builtin_amdgcn_fence(__ATOMIC_ACQUIRE, "agent");
      xb_add(&bar[XB_XGEN(b.x)], 1u);
      asm volatile("s_waitcnt vmcnt(0)" ::: "memory");
    } else {
      XB_SPIN(xb_ld(&bar[XB_XGEN(b.x)]) == gen, bar);
      __builtin_amdgcn_fence(__ATOMIC_ACQUIRE, "agent");
      asm volatile("s_waitcnt vmcnt(0)" ::: "memory");
    }
  }
  __syncthreads();
}

namespace cg = cooperative_groups;
constexpr int LDS_BYTES = 163840 - 16;
static_assert(sizeof(GlaLds) <= LDS_BYTES && sizeof(MbLds) <= LDS_BYTES && sizeof(DnLds) <= LDS_BYTES && sizeof(FftLds) <= LDS_BYTES, "lds");
__global__ void __launch_bounds__(NT) mega(Params p_unused) {
  extern __shared__ __attribute__((aligned(16))) char smem[];
  cg::grid_group grid = cg::this_grid();
  int bid_s = blockIdx.x, nb_s = gridDim.x, tid_v = threadIdx.x;
  const __attribute__((address_space(4))) char* kb = (const __attribute__((address_space(4))) char*)__builtin_amdgcn_kernarg_segment_ptr();
#define p (*(CParams*)({ asm volatile("" : "+s"(kb)); kb; }))
#define BID ({ asm volatile("" : "+s"(bid_s)); bid_s; })
#define NBK ({ asm volatile("" : "+s"(nb_s)); nb_s; })
#define TID ({ asm volatile("" : "+v"(tid_v)); tid_v; })
#define LAYER ({ int l_ = l; asm volatile("" : "+s"(l_)); l_; })
#define GSYNC() do { XcdBarrier xb_; xb_.bar = p.bar; xb_.x = xb_xcc_id(); xb_.st = (volatile LAS unsigned*)(smem + LDS_BYTES); xcd_barrier(xb_); } while (0)
  volatile LAS unsigned* xst = (volatile LAS unsigned*)(smem + LDS_BYTES);
  if (threadIdx.x < 4) xst[threadIdx.x] = 0u;
  __syncthreads();
  (void)xcd_barrier_post(p.bar, xst);
  phase_conv_small(p, BID, NBK, TID, smem);
  phase_mod(p, BID, NBK, TID, smem);
  grid.sync();
  phase_prenorm0(p, BID, NBK, TID);
  GSYNC();
  for (int l = 0; l < DEPTH; ++l) {
    phase_gemm_in(p, LAYER, BID, NBK, TID, smem); GSYNC();
    phase_hy_prep(p, LAYER, BID, NBK, TID);
    phase_hy_prep_t(p, LAYER, BID, NBK, TID, smem);
    phase_hy_filt<true>(p, LAYER, SEQ, p.filt, BID, NBK, TID, smem);
    if (l == 0) phase_hy_filt<false>(p, LAYER, CTX, p.filtc, BID, NBK, TID, smem);
    GSYNC();
    phase_hy_fft(p, LAYER, BID, NBK, TID, smem);
    if (l == 0) phase_hy_conv(p, LAYER, 0, true, BID, NBK, TID);
    GSYNC();
    phase_hy_fin(p, BID, NBK, TID, smem);
    if (l == 0) phase_hy_conv(p, LAYER, 1, true, BID, NBK, TID);
    GSYNC();
    phase_mb_prep(p, LAYER, BID, NBK, TID); GSYNC();
    phase_mb_chunk<0>(p, LAYER, BID, NBK, TID, smem); GSYNC();
    phase_mb_state(p, BID, NBK, TID); GSYNC();
    phase_mb_chunk<1>(p, LAYER, BID, NBK, TID, smem); GSYNC();
    phase_dn_prep(p, LAYER, BID, NBK, TID);
    phase_gla_chunk<0>(p, LAYER, BID, NBK, TID, smem); GSYNC();
    phase_dn_chunk<0>(p, LAYER, BID, NBK, TID, smem);
    phase_gla_state(p, BID, NBK, TID); GSYNC();
    { const int b_ = BID, n_ = NBK;
      if (b_ < 32) phase_dn_state(p, b_, 32, TID, smem); else phase_gla_chunk<1>(p, LAYER, b_ - 32, n_ - 32, TID, smem); }
    GSYNC();
    phase_dn_chunk<1>(p, LAYER, BID, NBK, TID, smem); GSYNC();
    phase_gemm_out(p, LAYER, BID, NBK, TID, smem); GSYNC();
    phase_postmix(p, LAYER, BID, NBK, TID, smem); GSYNC();
    phase_topk(p, LAYER, BID, NBK, TID, smem);
    phase_conv_moe(p, LAYER, BID, NBK, TID, smem);
    GSYNC();
    phase_gemm_moe1(p, LAYER, BID, NBK, TID, smem); GSYNC();
    phase_gemm_moe2(p, LAYER, BID, NBK, TID, smem); GSYNC();
    phase_combine(p, LAYER, BID, NBK, TID);
    if (l + 1 < DEPTH) GSYNC();
  }
#undef p
}

extern "C" void kernel_launch(void* const* d_in, const int* in_sizes, int n_in, void* d_out, int out_size, void* d_ws, size_t ws_size, hipStream_t stream) {
  Params p{};
  const float** fp = (const float**)&p;
  for (int i = 0; i < 37; ++i) fp[i] = (const float*)d_in[i];
  p.out = (float*)d_out;
  char* ws = (char*)d_ws; size_t off = 0;
  auto alloc = [&](size_t bytes) { size_t o = off; off += (bytes + 255) & ~(size_t)255; return ws + o; };
  p.win_t = (bf16_t*)alloc((size_t)DEPTH * NUP * D * 2);
  p.wout_t = (bf16_t*)alloc((size_t)DEPTH * D * D * 2);
  p.mod = (float*)alloc((size_t)DEPTH * 5 * 6 * D * 4);
  p.xc = (float*)alloc((size_t)TC * D * 4);
  p.aff = (float*)alloc((size_t)TT * 16 * 4);
  p.slot_tok = (int*)alloc((size_t)NSLOT * 4);
  p.slot_w = (float*)alloc((size_t)NSLOT * 4);
  p.tok_slot = (int*)alloc((size_t)TT * 16 * 4);
  p.dt = (float*)alloc((size_t)TT * 8 * 4);
  p.bg = (float*)alloc((size_t)TT * 16 * 4);
  p.filt = (float*)alloc((size_t)SEQ * 1024 * 4);
  p.filtc = (float*)alloc((size_t)CTX * 1024 * 4);
  p.hb = (bf16_t*)alloc((size_t)TT * D * 2);
  p.prep = p.hb;
  char* R = alloc((size_t)NSLOT * D * 2 * 2);
  p.u = (bf16_t*)R; p.yo = (bf16_t*)R; p.act = (bf16_t*)R; p.ymoe = (bf16_t*)(R + (size_t)NSLOT * D * 2);
  p.y = (bf16_t*)alloc((size_t)TT * D * 2);
  char* W2 = alloc((size_t)NE * 3 * D * D * 2);
  p.wgu_t = (bf16_t*)W2; p.wdn_t = (bf16_t*)(W2 + (size_t)NE * 2 * D * D * 2);
  p.obuf = (float*)W2; p.zbuf = (float*)W2; p.yt = (float*)(W2 + (size_t)36 * 1024 * 1024);
  p.gla_l = (bf16_t*)(W2 + (size_t)72 * 1024 * 1024);
  p.gla_dec = (float*)alloc((size_t)32 * NCH * 32 * 4);
  p.bar = (unsigned*)alloc((size_t)XCD_BAR_WORDS * 4);
  p.specg = (float2*)alloc((size_t)256 * 16384 * 8);
  p.mb_l = (bf16_t*)W2;
  p.mb_dec = (float*)alloc((size_t)32 * NCH * 4);
  p.dn_m = (bf16_t*)W2; p.dn_l = (bf16_t*)(W2 + (size_t)32 * NCH * 4096 * 2);
  if (off > ws_size) { fprintf(stderr, "workspace too small: need %zu have %zu\n", off, ws_size); return; }

  static int grid_blocks = 0;
  if (!grid_blocks) {
    int dev = 0, cus = 0, per_cu = 0;
    hipGetDevice(&dev);
    hipDeviceGetAttribute(&cus, hipDeviceAttributeMultiprocessorCount, dev);
    hipFuncSetAttribute((const void*)mega, hipFuncAttributeMaxDynamicSharedMemorySize, LDS_BYTES + 16);
    hipOccupancyMaxActiveBlocksPerMultiprocessor(&per_cu, mega, NT, LDS_BYTES + 16);
    if (per_cu > 1) per_cu = 1;
    grid_blocks = cus * per_cu;
  }
  hipMemsetAsync(p.bar, 0, (size_t)XCD_BAR_WORDS * 4, stream);
  void* args[] = {&p};
  hipError_t e = hipLaunchCooperativeKernel((void*)mega, dim3(grid_blocks), dim3(NT), args, LDS_BYTES + 16, stream);
  if (e != hipSuccess) fprintf(stderr, "cooperative launch failed: %s (grid %d)\n", hipGetErrorString(e), grid_blocks);
}
```

```cpp
#include <hip/hip_runtime.h>
#include <hip/hip_cooperative_groups.h>
#include <stdint.h>
#include <stdio.h>

typedef unsigned short bf16_t;
using bf16x8 = __attribute__((ext_vector_type(8))) short;
using f32x4 = __attribute__((ext_vector_type(4))) float;

constexpr int D = 1024, NB = 4, SEQ = 8192, CTX = 256, DEPTH = 2;
constexpr int TL = NB * SEQ, TC = NB * CTX, TT = TL + TC;
constexpr int NUS = 3640, NU = 3840, NUP = 3840;
constexpr int NE = 16, CAP_L = 1024, CAP_C = 32, SLOTS_E = NB * CAP_L + 256, NSLOT = NE * SLOTS_E;
constexpr int NT = 512, NW = NT / 64;
constexpr int U_GLA = 0, U_HY = 800, U_MB = 1568, U_DN = 2600;

struct Params {
  const float *x, *c, *ctx, *c_ctx, *w_mod, *b_mod, *norm_g, *w_in, *w_out, *gla_w2, *gla_b, *gla_norm,
      *hy_conv_w, *hy_conv_b, *hy_w1, *hy_b1, *hy_w2, *hy_b2, *hy_w3, *hy_b3, *hy_w4, *hy_freq, *hy_d,
      *mb_conv_w, *mb_conv_b, *mb_a_log, *mb_dt_bias, *mb_d, *mb_norm, *dn_conv_w, *dn_a_log, *dn_dt_bias, *dn_norm,
      *moe_router, *moe_w_gate, *moe_w_up, *moe_w_down;
  float* out;
  bf16_t *win_t, *wout_t, *wgu_t, *wdn_t, *hb, *prep, *u, *y, *act, *ymoe;
  float *mod, *xc, *aff, *slot_w, *dt, *bg, *filt, *filtc, *obuf, *zbuf; bf16_t* yo;
  int *slot_tok, *tok_slot;
  bf16_t* gla_l; float* gla_dec;
  bf16_t* mb_l; float* mb_dec;
  bf16_t *dn_m, *dn_l;
  float* yt;
  unsigned* bar;
  float2* specg;
};

typedef const __attribute__((address_space(4))) Params CParams;

__device__ __forceinline__ bf16_t f2bf(float f) { unsigned u = __float_as_uint(f); u += 0x7fffu + ((u >> 16) & 1u); return (bf16_t)(u >> 16); }
__device__ __forceinline__ float bf2f(bf16_t h) { return __uint_as_float(((unsigned)h) << 16); }
__device__ __forceinline__ float siluf(float v) { return v * __builtin_amdgcn_rcpf(1.f + __expf(-v)); }
__device__ __forceinline__ float sigmoidf_(float v) { return __builtin_amdgcn_rcpf(1.f + __expf(-v)); }
__device__ __forceinline__ float softplusf_(float v) { const float e = __expf(v); return v > 15.f ? v : (v < -8.f ? e : __logf(1.f + e)); }
__device__ __forceinline__ float logsigmoidf_(float z) { return -softplusf_(-z); }
__device__ __forceinline__ float wave_sum(float v) {
#pragma unroll
  for (int o = 32; o > 0; o >>= 1) v += __shfl_xor(v, o);
  return v;
}
__device__ __forceinline__ float rdlane(float v, int l) { return __int_as_float(__builtin_amdgcn_readlane(__float_as_int(v), l)); }
__device__ __forceinline__ float* xrow_ptr(CParams& p, int row) { return row < TL ? p.out + (size_t)row * D : p.xc + (size_t)(row - TL) * D; }
__device__ __forceinline__ int mod_idx(int row) { return row < TL ? row / SEQ : 4; }

__device__ __forceinline__ int seq_nb(int row, int delta, bool mamba) {
  if (row < TL) {
    int b = row / SEQ, t = row % SEQ;
    if (mamba) { int pos = (t & 63) * 128 + (t >> 6) + delta; if (pos < 0 || pos >= SEQ) return -1; return b * SEQ + (pos & 127) * 64 + (pos >> 7); }
    int t2 = t + delta; if (t2 < 0 || t2 >= SEQ) return -1; return b * SEQ + t2;
  }
  int r = row - TL, b = r / CTX, t = r % CTX + delta; if (t < 0 || t >= CTX) return -1; return TL + b * CTX + t;
}

__device__ __forceinline__ void conv8(const bf16_t* u, int ucol, int row, int rm, int rp, const float* w, const float* bias, int c, float (&o)[8]) {
  const uint4 x1 = *(const uint4*)(u + (size_t)row * NU + ucol + c);
  uint4 x0 = make_uint4(0u, 0u, 0u, 0u), x2 = make_uint4(0u, 0u, 0u, 0u);
  if (rm >= 0) x0 = *(const uint4*)(u + (size_t)rm * NU + ucol + c);
  if (rp >= 0) x2 = *(const uint4*)(u + (size_t)rp * NU + ucol + c);
  const unsigned a0[4] = {x0.x, x0.y, x0.z, x0.w}, a1[4] = {x1.x, x1.y, x1.z, x1.w}, a2[4] = {x2.x, x2.y, x2.z, x2.w};
#pragma unroll
  for (int h = 0; h < 2; ++h) {
    const float4 w0 = *(const float4*)(w + c + h * 4), w1 = *(const float4*)(w + 768 + c + h * 4), w2 = *(const float4*)(w + 1536 + c + h * 4);
    const float4 bb = bias ? *(const float4*)(bias + c + h * 4) : make_float4(0.f, 0.f, 0.f, 0.f);
    const float ww0[4] = {w0.x, w0.y, w0.z, w0.w}, ww1[4] = {w1.x, w1.y, w1.z, w1.w}, ww2[4] = {w2.x, w2.y, w2.z, w2.w}, bv[4] = {bb.x, bb.y, bb.z, bb.w};
#pragma unroll
    for (int e = 0; e < 4; ++e) { const int wd = h * 2 + (e >> 1); const bool hi = e & 1;
      const float v0 = hi ? __uint_as_float(a0[wd] & 0xffff0000u) : __uint_as_float(a0[wd] << 16), v1 = hi ? __uint_as_float(a1[wd] & 0xffff0000u) : __uint_as_float(a1[wd] << 16), v2 = hi ? __uint_as_float(a2[wd] & 0xffff0000u) : __uint_as_float(a2[wd] << 16);
      o[h * 4 + e] = bv[e] + ww0[e] * v0 + ww1[e] * v1 + ww2[e] * v2; }
  }
}

template <int MAP>
__device__ __forceinline__ void conv_tile4(const float* src0, const float* src1, int ldsrc, int ncols, bf16_t* dst, int K, int k0, int n0, float* tile, int tid_) {
  const int t = tid_;
  {
    const int nn = t & 63, kk = t >> 6;
    float v[4][8];
#pragma unroll
    for (int q = 0; q < 4; ++q) { const int R = n0 + q * 64 + nn; const float* sp; int col;
      if (MAP == 0) { sp = src0; col = R < ncols ? R : -1; }
      else { int j = R >> 8, rem = R & 255; col = j * 128 + (rem & 127); sp = (rem >> 7) ? src1 : src0; }
#pragma unroll
      for (int i = 0; i < 8; ++i) { int k = i * 8 + kk; v[q][i] = col >= 0 ? sp[(size_t)(k0 + k) * ldsrc + col] : 0.f; } }
#pragma unroll
    for (int q = 0; q < 4; ++q)
#pragma unroll
      for (int i = 0; i < 8; ++i) tile[q * 64 * 65 + (i * 8 + kk) * 65 + nn] = v[q][i];
  }
  __syncthreads();
  {
    const int k2 = (t & 31) * 2, nn = t >> 5;
#pragma unroll
    for (int q = 0; q < 4; ++q)
#pragma unroll
      for (int i = 0; i < 4; ++i) { int n = i * 16 + nn; unsigned v = (unsigned)f2bf(tile[q * 64 * 65 + k2 * 65 + n]) | ((unsigned)f2bf(tile[q * 64 * 65 + (k2 + 1) * 65 + n]) << 16);
        *(unsigned*)(dst + (size_t)(n0 + q * 64 + n) * K + k0 + k2) = v; }
  }
  __syncthreads();
}
__device__ __forceinline__ void phase_conv_small(CParams& p, int bid, int nb, int tid_, char* smem) {
  float* tile = (float*)smem;
  const int n_in = 16 * (NUP / 256), n_out = 16 * 4;
  for (int i = bid; i < DEPTH * (n_in + n_out); i += nb) {
    int l = i / (n_in + n_out), r = i % (n_in + n_out);
    if (r < n_in) { int kt = r % 16, nt = r / 16; conv_tile4<0>(p.w_in + (size_t)l * D * NUS, nullptr, NUS, NUS, p.win_t + (size_t)l * NUP * D, D, kt * 64, nt * 256, tile, tid_); }
    else { r -= n_in; int kt = r % 16, nt = r / 16; conv_tile4<0>(p.w_out + (size_t)l * D * D, nullptr, D, D, p.wout_t + (size_t)l * D * D, D, kt * 64, nt * 256, tile, tid_); }
  }
}
__device__ __forceinline__ void phase_conv_moe(CParams& p, int layer, int bid, int nb, int tid_, char* smem) {
  float* tile = (float*)smem;
  const int n_gu = 16 * 8, n_dn = 16 * 4;
  for (int i = bid; i < NE * (n_gu + n_dn); i += nb) {
    int e = i / (n_gu + n_dn), r = i % (n_gu + n_dn);
    size_t wo = ((size_t)layer * NE + e) * D * D;
    if (r < n_gu) { int kt = r % 16, nt = r / 16; conv_tile4<1>(p.moe_w_gate + wo, p.moe_w_up + wo, D, D, p.wgu_t + (size_t)e * 2048 * D, D, kt * 64, nt * 256, tile, tid_); }
    else { r -= n_gu; int kt = r % 16, nt = r / 16; conv_tile4<0>(p.moe_w_down + wo, nullptr, D, D, p.wdn_t + (size_t)e * D * D, D, kt * 64, nt * 256, tile, tid_); }
  }
}

__device__ __forceinline__ void phase_mod(CParams& p, int bid, int nb, int tid_, char* smem) {
  float* sc = (float*)smem;
  float* red = sc + 5 * D;
  const int lane = tid_ & 63, wv = tid_ >> 6;
  for (int i = tid_; i < 5 * D; i += NT) { int r = i / D, k = i % D; float v = r < 4 ? p.c[r * D + k] : p.c_ctx[k]; sc[i] = siluf(v); }
  __syncthreads();
  for (int blk = bid; blk < DEPTH * 6 * D / 64; blk += nb) {
    const int g = blk * 64 + lane, l = g / (6 * D), n = g % (6 * D);
    const float* w = p.w_mod + (size_t)l * D * 6 * D + n;
    float a0 = 0, a1 = 0, a2 = 0, a3 = 0, a4 = 0;
#pragma unroll 8
    for (int k = wv * 128; k < wv * 128 + 128; ++k) { float wvv = w[(size_t)k * 6 * D]; a0 += sc[k] * wvv; a1 += sc[D + k] * wvv; a2 += sc[2 * D + k] * wvv; a3 += sc[3 * D + k] * wvv; a4 += sc[4 * D + k] * wvv; }
    red[(wv * 5 + 0) * 64 + lane] = a0; red[(wv * 5 + 1) * 64 + lane] = a1; red[(wv * 5 + 2) * 64 + lane] = a2; red[(wv * 5 + 3) * 64 + lane] = a3; red[(wv * 5 + 4) * 64 + lane] = a4;
    __syncthreads();
    if (wv < 5) { float t = p.b_mod[l * 6 * D + n];
#pragma unroll
      for (int q = 0; q < 8; ++q) t += red[(q * 5 + wv) * 64 + lane];
      p.mod[((size_t)l * 5 + wv) * 6 * D + n] = t; }
    __syncthreads();
  }
}

__device__ __forceinline__ void row_modulate_store(const float (&xv)[16], const float* g, const float* sh, const float* sc, bf16_t* dst, int lane, float (&hv)[16]) {
  float ss = 0.f;
#pragma unroll
  for (int i = 0; i < 16; ++i) ss += xv[i] * xv[i];
  ss = wave_sum(ss);
  float rstd = rsqrtf(ss * (1.f / D) + 1e-6f);
#pragma unroll
  for (int i = 0; i < 4; ++i) {
    int k = i * 256 + lane * 4;
    float4 gv = *(const float4*)(g + k), shv = *(const float4*)(sh + k), scv = *(const float4*)(sc + k);
    hv[i * 4 + 0] = xv[i * 4 + 0] * rstd * gv.x * (1.f + scv.x) + shv.x;
    hv[i * 4 + 1] = xv[i * 4 + 1] * rstd * gv.y * (1.f + scv.y) + shv.y;
    hv[i * 4 + 2] = xv[i * 4 + 2] * rstd * gv.z * (1.f + scv.z) + shv.z;
    hv[i * 4 + 3] = xv[i * 4 + 3] * rstd * gv.w * (1.f + scv.w) + shv.w;
    uint2 pk; pk.x = (unsigned)f2bf(hv[i * 4 + 0]) | ((unsigned)f2bf(hv[i * 4 + 1]) << 16); pk.y = (unsigned)f2bf(hv[i * 4 + 2]) | ((unsigned)f2bf(hv[i * 4 + 3]) << 16);
    *(uint2*)(dst + k) = pk;
  }
}
__device__ __forceinline__ void phase_prenorm0(CParams& p, int bid, int nb, int tid_) {
  const int lane = tid_ & 63, wv = tid_ >> 6;
  for (int row0 = (bid * NW + wv) * 2; row0 < TT; row0 += nb * NW * 2) {
    float xv[2][16], hv[16];
#pragma unroll
    for (int r = 0; r < 2; ++r) { const int row = row0 + r; const float* src = row < TL ? p.x + (size_t)row * D : p.ctx + (size_t)(row - TL) * D;
#pragma unroll
      for (int i = 0; i < 4; ++i) { float4 v = *(const float4*)(src + i * 256 + lane * 4); xv[r][i * 4] = v.x; xv[r][i * 4 + 1] = v.y; xv[r][i * 4 + 2] = v.z; xv[r][i * 4 + 3] = v.w; } }
#pragma unroll
    for (int r = 0; r < 2; ++r) { const int row = row0 + r; const float* m = p.mod + (size_t)(0 * 5 + mod_idx(row)) * 6 * D;
      row_modulate_store(xv[r], p.norm_g + 0 * 4 * D + 0 * D, m + 0 * D, m + 1 * D, p.hb + (size_t)row * D, lane, hv); }
  }
}

#define LAS __attribute__((address_space(3)))
namespace g8 {
typedef unsigned u32x4 __attribute__((ext_vector_type(4)));
constexpr int BM = 256, BK = 64, HALF = 128, HTB = HALF * BK * 2, KD = 1024;
__device__ __forceinline__ int lds_byte(int r, int c) { const int st = (r >> 4) * 2 + (c >> 5), rr = r & 15, cc = c & 31, ob = rr * 64 + cc * 2; return st * 1024 + (ob ^ (((ob >> 9) & 1) << 5)); }
__device__ __forceinline__ void stage_rc(int b, int& R, int& C) { const int st = b / 1024, sb = b % 1024, swz = sb ^ (((sb >> 9) & 1) << 5); R = (st >> 1) * 16 + swz / 64; C = (st & 1) * 32 + (swz % 64) / 2; }
__device__ __forceinline__ int perm32(int rho) { const int n = rho >> 4, i = rho & 15; return 8 * (i >> 2) + 4 * n + (i & 3); }
__device__ __forceinline__ unsigned cvt_pk_bf16(float lo, float hi) { unsigned r; asm volatile("v_cvt_pk_bf16_f32 %0, %1, %2" : "=v"(r) : "v"(lo), "v"(hi)); return r; }
struct Unit { int ar0, br0, pn, e; };
struct SchedPlain {
  int nM, nN, nwg, G, c;
  __device__ __forceinline__ bool next(int i, Unit& u) const {
    const long Lx = (long)i * G + c; if (Lx >= nwg) return false;
    int wgid = (int)Lx; { const int q = nwg / 8, r = nwg % 8, xcd = wgid % 8, off = wgid / 8; wgid = (xcd < r ? xcd * (q + 1) : r * (q + 1) + (xcd - r) * q) + off; }
    const int nig = 8 * nN, gid = wgid / nig, fm = gid * 8, gsz = (nM - fm) < 8 ? (nM - fm) : 8;
    const int pm = fm + ((wgid % nig) % gsz), pn = (wgid % nig) / gsz;
    u.ar0 = pm * BM; u.br0 = pn * BM; u.pn = pn; u.e = 0; return true;
  }
};
struct SchedMoe {
  int mt_e, nN, G, c;
  __device__ __forceinline__ bool next(int i, Unit& u) const {
    const long Lx = (long)i * G + c; if (Lx >= (long)NE * mt_e * nN) return false;
    const int e = (int)Lx / (mt_e * nN), r = (int)Lx % (mt_e * nN);
    const int gid = r / (8 * nN), fm = gid * 8, gsz = (mt_e - fm) < 8 ? (mt_e - fm) : 8, rr = r - gid * 8 * nN, pm = fm + rr % gsz, pn = rr / gsz;
    u.ar0 = e * SLOTS_E + pm * BM; u.br0 = (e * nN + pn) * BM; u.pn = pn; u.e = e; return true;
  }
};
template <bool GATHER, class Epi, class Sched>
__device__ __forceinline__ void gemm8(LAS unsigned char* lds, const bf16_t* A, const int* aidx, const bf16_t* Bt, const Sched& S, const Epi& E, int tid) {
  const int wid = __builtin_amdgcn_readfirstlane(tid >> 6), lane = tid & 63, wr = wid >> 2, wc = wid & 3, fr = lane & 15, fq = lane >> 4;
  constexpr int K = KD, nt = K / BK;
  int Rr[2], Cc[2]; unsigned voffB[2];
#pragma unroll
  for (int i = 0; i < 2; ++i) { stage_rc(tid * 16 + i * 8192, Rr[i], Cc[i]); const int Rb = Epi::PERM ? ((Rr[i] & ~31) + perm32(Rr[i] & 31)) : Rr[i]; voffB[i] = (unsigned)(Rb * K + Cc[i]) * 2u; }
  const size_t kstep = (size_t)(BK * 2), hstep = (size_t)HALF * K * 2;
  const unsigned ldsw = (unsigned)wid * 1024u;
  const int aoff = lds_byte(wr * 64 + fr, fq * 8), boff = lds_byte(wc * 32 + fr, fq * 8);
#define G8_SA(b, h) (((b) * 2 + (h)) * HTB)
#define G8_SB(b, h) ((4 + (b) * 2 + (h)) * HTB)
#define G8_STAGE(bufoff, gbase, voff) do { _Pragma("unroll") for (int _i = 0; _i < 2; ++_i) \
    __builtin_amdgcn_global_load_lds((const unsigned*)((const char*)(gbase) + (voff)[_i]), (LAS unsigned*)(lds + (bufoff) + ldsw + _i * 8192), 16, 0, 0); } while (0)
#define G8_LDA(dst, b, h) do { _Pragma("unroll") for (int m = 0; m < 4; ++m) _Pragma("unroll") for (int k = 0; k < 2; ++k) dst[m][k] = *(const LAS bf16x8*)(lds + G8_SA(b, h) + aoff + m * 2048 + k * 1024); } while (0)
#define G8_LDB(dst, b, h) do { _Pragma("unroll") for (int n = 0; n < 2; ++n) _Pragma("unroll") for (int k = 0; k < 2; ++k) dst[n][k] = *(const LAS bf16x8*)(lds + G8_SB(b, h) + boff + n * 2048 + k * 1024); } while (0)
#define G8_MMA(ai, bj, At, Btf) do { __builtin_amdgcn_s_setprio(1); _Pragma("unroll") for (int m = 0; m < 4; ++m) _Pragma("unroll") for (int n = 0; n < 2; ++n) _Pragma("unroll") for (int k = 0; k < 2; ++k) \
    acc[ai][bj][m][n] = __builtin_amdgcn_mfma_f32_16x16x32_bf16(Btf[n][k], At[m][k], acc[ai][bj][m][n], 0, 0, 0); __builtin_amdgcn_s_setprio(0); } while (0)
#define G8_WAIT_V(n) asm volatile("s_waitcnt vmcnt(" #n ")" ::: "memory")
#define G8_WAIT_L(n) asm volatile("s_waitcnt lgkmcnt(" #n ")" ::: "memory")
#define G8_BAR __builtin_amdgcn_s_barrier()
#define G8_SCHED __builtin_amdgcn_sched_barrier(0)
#define G8_AOFF(dst, un) do { _Pragma("unroll") for (int h = 0; h < 2; ++h) _Pragma("unroll") for (int i = 0; i < 2; ++i) { const int r_ = (un).ar0 + h * HALF + Rr[i]; \
    const int g_ = GATHER ? aidx[r_] : r_; dst[h][i] = (unsigned)(g_ * K + Cc[i]) * 2u; } } while (0)
  Unit cur, nxt; int ui = 0;
  if (!S.next(0, cur)) return;
  f32x4 acc[2][2][4][2];
#pragma unroll
  for (int a = 0; a < 2; ++a)
#pragma unroll
    for (int b = 0; b < 2; ++b)
#pragma unroll
      for (int m = 0; m < 4; ++m)
#pragma unroll
        for (int n = 0; n < 2; ++n) acc[a][b][m][n] = (f32x4){0.f, 0.f, 0.f, 0.f};
  bf16x8 At[4][2], B0[2][2], B1[2][2];
  unsigned vA[2][2], vAn[2][2];
  G8_AOFF(vA, cur);
  const char* cA = (const char*)A; const char* cB = (const char*)Bt + (size_t)cur.br0 * K * 2;
  G8_STAGE(G8_SB(0, 0), cB, voffB); G8_STAGE(G8_SA(0, 0), cA, vA[0]); G8_STAGE(G8_SB(0, 1), cB + hstep, voffB); G8_STAGE(G8_SA(0, 1), cA, vA[1]);
  if (wr == 1) G8_BAR;
  G8_WAIT_V(4); G8_BAR;
  G8_STAGE(G8_SB(1, 0), cB + kstep, voffB); G8_STAGE(G8_SA(1, 0), cA + kstep, vA[0]); G8_STAGE(G8_SB(1, 1), cB + hstep + kstep, voffB);
  G8_WAIT_V(6); G8_BAR;
  for (;;) {
    const bool has_next = S.next(ui + 1, nxt);
    if (has_next) { G8_AOFF(vAn, nxt); } else {
#pragma unroll
      for (int h = 0; h < 2; ++h)
#pragma unroll
        for (int i = 0; i < 2; ++i) vAn[h][i] = vA[h][i]; }
    const char* nB = has_next ? (const char*)Bt + (size_t)nxt.br0 * K * 2 : cB;
    for (int t = 0; t < nt; t += 2) {
      const bool last = (t == nt - 2);
      const char* a1 = cA + (size_t)(t + 1) * kstep;
      const char* a2 = last ? cA : cA + (size_t)(t + 2) * kstep; const char* b2 = last ? nB : cB + (size_t)(t + 2) * kstep;
      const char* a3 = a2 + kstep; const char* b3 = b2 + kstep;
      unsigned v2[2][2];
#pragma unroll
      for (int h = 0; h < 2; ++h)
#pragma unroll
        for (int i = 0; i < 2; ++i) v2[h][i] = last ? vAn[h][i] : vA[h][i];
      G8_LDB(B0, 0, 0); G8_SCHED; G8_LDA(At, 0, 0); G8_STAGE(G8_SA(1, 1), a1, vA[1]);
      G8_WAIT_L(8); G8_BAR; G8_WAIT_L(0); G8_MMA(0, 0, At, B0); G8_BAR; G8_SCHED;
      G8_LDB(B1, 0, 1); G8_STAGE(G8_SB(0, 0), b2, voffB);
      G8_BAR; G8_WAIT_L(0); G8_MMA(0, 1, At, B1); G8_BAR;
      G8_LDA(At, 0, 1); G8_STAGE(G8_SA(0, 0), a2, v2[0]);
      G8_BAR; G8_WAIT_L(0); G8_MMA(1, 0, At, B0); G8_BAR; G8_SCHED;
      G8_STAGE(G8_SB(0, 1), b2 + hstep, voffB);
      G8_WAIT_V(6); G8_BAR; G8_MMA(1, 1, At, B1); G8_BAR;
      G8_LDB(B0, 1, 0); G8_SCHED; G8_LDA(At, 1, 0); G8_STAGE(G8_SA(0, 1), a2, v2[1]);
      G8_WAIT_L(8); G8_BAR; G8_WAIT_L(0); G8_MMA(0, 0, At, B0); G8_BAR; G8_SCHED;
      G8_LDB(B1, 1, 1); G8_STAGE(G8_SB(1, 0), b3, voffB);
      G8_BAR; G8_WAIT_L(0); G8_MMA(0, 1, At, B1); G8_BAR;
      G8_LDA(At, 1, 1); G8_STAGE(G8_SA(1, 0), a3, v2[0]);
      G8_BAR; G8_WAIT_L(0); G8_MMA(1, 0, At, B0); G8_BAR; G8_SCHED;
      G8_STAGE(G8_SB(1, 1), b3 + hstep, voffB);
      G8_WAIT_V(6); G8_BAR; G8_MMA(1, 1, At, B1); G8_BAR;
    }
    E(acc, cur, wr, wc, fr, fq);
    if (!has_next) break;
#pragma unroll
    for (int a = 0; a < 2; ++a)
#pragma unroll
      for (int b = 0; b < 2; ++b)
#pragma unroll
        for (int m = 0; m < 4; ++m)
#pragma unroll
          for (int n = 0; n < 2; ++n) acc[a][b][m][n] = (f32x4){0.f, 0.f, 0.f, 0.f};
    cur = nxt; cB = nB; ++ui;
#pragma unroll
    for (int h = 0; h < 2; ++h)
#pragma unroll
      for (int i = 0; i < 2; ++i) vA[h][i] = vAn[h][i];
  }
  G8_WAIT_V(0);
  if (wr == 0) G8_BAR;
  G8_BAR;
#undef G8_SA
#undef G8_SB
#undef G8_STAGE
#undef G8_LDA
#undef G8_LDB
#undef G8_MMA
#undef G8_WAIT_V
#undef G8_WAIT_L
#undef G8_BAR
#undef G8_SCHED
#undef G8_AOFF
}
struct EpiU {
  static constexpr bool PERM = true; bf16_t* u;
  __device__ __forceinline__ void operator()(const f32x4 (&acc)[2][2][4][2], const Unit& un, int wr, int wc, int fr, int fq) const {
#pragma unroll
    for (int ai = 0; ai < 2; ++ai)
#pragma unroll
      for (int m = 0; m < 4; ++m) { bf16_t* rowp = u + (size_t)(un.ar0 + ai * HALF + wr * 64 + m * 16 + fr) * NU;
#pragma unroll
        for (int bj = 0; bj < 2; ++bj) { const int c0 = un.pn * BM + bj * HALF + wc * 32 + 8 * fq;
          { u32x4 w; w.x = cvt_pk_bf16(acc[ai][bj][m][0][0], acc[ai][bj][m][0][1]); w.y = cvt_pk_bf16(acc[ai][bj][m][0][2], acc[ai][bj][m][0][3]);
            w.z = cvt_pk_bf16(acc[ai][bj][m][1][0], acc[ai][bj][m][1][1]); w.w = cvt_pk_bf16(acc[ai][bj][m][1][2], acc[ai][bj][m][1][3]); *(u32x4*)(rowp + c0) = w; } } }
  }
};
struct EpiYo {
  static constexpr bool PERM = true; bf16_t* yo;
  __device__ __forceinline__ void operator()(const f32x4 (&acc)[2][2][4][2], const Unit& un, int wr, int wc, int fr, int fq) const {
#pragma unroll
    for (int ai = 0; ai < 2; ++ai)
#pragma unroll
      for (int m = 0; m < 4; ++m) { bf16_t* rowp = yo + (size_t)(un.ar0 + ai * HALF + wr * 64 + m * 16 + fr) * D + un.pn * BM + wc * 32 + 8 * fq;
#pragma unroll
        for (int bj = 0; bj < 2; ++bj) { u32x4 w; w.x = cvt_pk_bf16(acc[ai][bj][m][0][0], acc[ai][bj][m][0][1]); w.y = cvt_pk_bf16(acc[ai][bj][m][0][2], acc[ai][bj][m][0][3]);
          w.z = cvt_pk_bf16(acc[ai][bj][m][1][0], acc[ai][bj][m][1][1]); w.w = cvt_pk_bf16(acc[ai][bj][m][1][2], acc[ai][bj][m][1][3]); *(u32x4*)(rowp + bj * HALF) = w; } }
  }
};
struct EpiAct {
  static constexpr bool PERM = true; bf16_t* act;
  __device__ __forceinline__ void operator()(const f32x4 (&acc)[2][2][4][2], const Unit& un, int wr, int wc, int fr, int fq) const {
#pragma unroll
    for (int ai = 0; ai < 2; ++ai)
#pragma unroll
      for (int m = 0; m < 4; ++m) { bf16_t* dst = act + (size_t)(un.ar0 + ai * HALF + wr * 64 + m * 16 + fr) * D + un.pn * HALF + wc * 32 + 8 * fq; float v[8];
#pragma unroll
        for (int n = 0; n < 2; ++n)
#pragma unroll
          for (int j = 0; j < 4; ++j) { const float g = acc[ai][0][m][n][j]; v[n * 4 + j] = g * __builtin_amdgcn_rcpf(1.f + __expf(-g)) * acc[ai][1][m][n][j]; }
        u32x4 w; w.x = cvt_pk_bf16(v[0], v[1]); w.y = cvt_pk_bf16(v[2], v[3]); w.z = cvt_pk_bf16(v[4], v[5]); w.w = cvt_pk_bf16(v[6], v[7]); *(u32x4*)dst = w; }
  }
};
struct EpiYm {
  static constexpr bool PERM = true; bf16_t* ym; const float* sw;
  __device__ __forceinline__ void operator()(const f32x4 (&acc)[2][2][4][2], const Unit& un, int wr, int wc, int fr, int fq) const {
#pragma unroll
    for (int ai = 0; ai < 2; ++ai)
#pragma unroll
      for (int m = 0; m < 4; ++m) { const int row = un.ar0 + ai * HALF + wr * 64 + m * 16 + fr; const float w8 = sw[row]; bf16_t* rowp = ym + (size_t)row * D + un.pn * BM + wc * 32 + 8 * fq;
#pragma unroll
        for (int bj = 0; bj < 2; ++bj) { u32x4 w; w.x = cvt_pk_bf16(acc[ai][bj][m][0][0] * w8, acc[ai][bj][m][0][1] * w8); w.y = cvt_pk_bf16(acc[ai][bj][m][0][2] * w8, acc[ai][bj][m][0][3] * w8);
          w.z = cvt_pk_bf16(acc[ai][bj][m][1][0] * w8, acc[ai][bj][m][1][1] * w8); w.w = cvt_pk_bf16(acc[ai][bj][m][1][2] * w8, acc[ai][bj][m][1][3] * w8); *(u32x4*)(rowp + bj * HALF) = w; } }
  }
};
}

__device__ __forceinline__ void phase_gemm_in(CParams& p, int layer, int bid, int nb, int tid_, char* smem) {
  g8::SchedPlain S; S.nM = TT / 256; S.nN = NUP / 256; S.nwg = S.nM * S.nN; S.G = nb; S.c = bid;
  g8::EpiU E; E.u = p.u;
  g8::gemm8<false>((LAS unsigned char*)smem, p.hb, nullptr, p.win_t + (size_t)layer * NUP * D, S, E, tid_);
}
__device__ __forceinline__ void phase_gemm_out(CParams& p, int layer, int bid, int nb, int tid_, char* smem) {
  g8::SchedPlain S; S.nM = (layer == 0 ? TT : TL) / 256; S.nN = D / 256; S.nwg = S.nM * S.nN; S.G = nb; S.c = bid;
  g8::EpiYo E; E.yo = p.yo;
  g8::gemm8<false>((LAS unsigned char*)smem, p.y, nullptr, p.wout_t + (size_t)layer * D * D, S, E, tid_);
}
__device__ __forceinline__ void phase_gemm_moe1(CParams& p, int layer, int bid, int nb, int tid_, char* smem) {
  g8::SchedMoe S; S.mt_e = layer == 0 ? 17 : 16; S.nN = 8; S.G = nb; S.c = bid;
  g8::EpiAct E; E.act = p.act;
  g8::gemm8<true>((LAS unsigned char*)smem, p.hb, p.slot_tok, p.wgu_t, S, E, tid_);
}
__device__ __forceinline__ void phase_gemm_moe2(CParams& p, int layer, int bid, int nb, int tid_, char* smem) {
  g8::SchedMoe S; S.mt_e = layer == 0 ? 17 : 16; S.nN = 4; S.G = nb; S.c = bid;
  g8::EpiYm E; E.ym = p.ymoe; E.sw = p.slot_w;
  g8::gemm8<false>((LAS unsigned char*)smem, p.act, nullptr, p.wdn_t, S, E, tid_);
}

template <int MT, int NTL, int KS, int LDA, int LDB>
__device__ __forceinline__ void wmm(f32x4 (&acc)[MT][NTL], const bf16_t* A, const bf16_t* B, int fr, int fq) {
#pragma unroll
  for (int ks = 0; ks < KS; ++ks) {
    bf16x8 a[MT], b[NTL];
#pragma unroll
    for (int m = 0; m < MT; ++m) a[m] = *(const bf16x8*)(A + (m * 16 + fr) * LDA + ks * 32 + fq * 8);
#pragma unroll
    for (int n = 0; n < NTL; ++n) b[n] = *(const bf16x8*)(B + (n * 16 + fr) * LDB + ks * 32 + fq * 8);
#pragma unroll
    for (int m = 0; m < MT; ++m)
#pragma unroll
      for (int n = 0; n < NTL; ++n) acc[m][n] = __builtin_amdgcn_mfma_f32_16x16x32_bf16(a[m], b[n], acc[m][n], 0, 0, 0);
  }
}
__device__ __forceinline__ unsigned pack2(float a, float b) { return (unsigned)f2bf(a) | ((unsigned)f2bf(b) << 16); }
constexpr int NCH = 132;
__device__ __forceinline__ int chunk_row0(int b, int cpos) { return cpos < 4 ? TL + b * CTX + cpos * 64 : b * SEQ + (cpos - 4) * 64; }
__device__ __forceinline__ int scan_idx(int cpos, int dir) { return dir == 0 ? cpos : (cpos < 4 ? 3 - cpos : 135 - cpos); }

struct GlaLds {
  bf16_t rq[64][32], rk[64][32], rv[64][64], rog[64][64], rlr[64][32];
  float w2s[2][16][32]; float gbs[2][32]; float g[2][64][36]; float gt[2][32];
  bf16_t qg[2][64][40]; bf16_t kg[2][64][40];
  bf16_t vt[64][72]; bf16_t at[2][64][72]; float ox[64][65];
};
template <int PASS>
__device__ __forceinline__ void phase_gla_chunk(CParams& p, int layer, int bid, int nb, int tid_, char* smem) {
  GlaLds& L = *(GlaLds*)smem;
  const int c_lo = (PASS == 1 && layer == DEPTH - 1) ? 4 : 0, ncp = NCH - c_lo;
  uint4 r0 = make_uint4(0u, 0u, 0u, 0u), r1 = r0, r2 = r0, r3 = r0; float w2a = 0.f, w2b = 0.f, gbv = 0.f;
  auto gfetch = [&](int task_, int tid) { const int h_ = task_ & 3, cpos_ = c_lo + (task_ >> 2) % ncp, b_ = (task_ >> 2) / ncp; const bf16_t* U0_ = p.u + (size_t)chunk_row0(b_, cpos_) * NU;
    auto gsrc = [&](int i) -> const bf16_t* { const int f = i / 28, c = i % 28;
      const int col = c < 4 ? h_ * 32 + c * 8 : (c < 8 ? 128 + h_ * 32 + (c - 4) * 8 : (c < 16 ? 256 + h_ * 64 + (c - 8) * 8 : (c < 24 ? 512 + h_ * 64 + (c - 16) * 8 : 768 + (c - 24) * 8)));
      return U0_ + (size_t)f * NU + col; };
    r0 = *(const uint4*)gsrc(tid); r1 = *(const uint4*)gsrc(tid + NT); r2 = *(const uint4*)gsrc(tid + 2 * NT);
    if (tid < 64 * 28 - 3 * NT) r3 = *(const uint4*)gsrc(tid + 3 * NT);
    const int i0 = tid, i1 = tid + NT;
    w2a = p.gla_w2[((size_t)(layer * 2 + (i0 >> 9)) * 16 + ((i0 >> 5) & 15)) * 128 + h_ * 32 + (i0 & 31)]; w2b = p.gla_w2[((size_t)(layer * 2 + (i1 >> 9)) * 16 + ((i1 >> 5) & 15)) * 128 + h_ * 32 + (i1 & 31)];
    if (tid < 64) gbv = p.gla_b[(layer * 2 + (tid >> 5)) * 128 + h_ * 32 + (tid & 31)]; };
  if (bid < NB * ncp * 4) gfetch(bid, tid_);
  for (int task = bid; task < NB * ncp * 4; task += nb) {
    int tid = tid_; asm volatile("" : "+v"(tid));
    const int lane = tid & 63, wv = tid >> 6, fr = lane & 15, fq = lane >> 4, dirw = wv >> 2, s4 = wv & 3;
    const int h = task & 3, cpos = c_lo + (task >> 2) % ncp, b = (task >> 2) / ncp;
    const int row0 = chunk_row0(b, cpos);
    const bf16_t* U0 = p.u + (size_t)row0 * NU;
    const int seq = (b * 4 + h) * 2 + dirw, nsc = scan_idx(cpos, dirw);
    bf16x8 sfrag[4];
    if (PASS == 1) { const bf16_t* sb = p.gla_l + ((size_t)seq * NCH + nsc) * 2048;
#pragma unroll
      for (int n = 0; n < 4; ++n) sfrag[n] = *(const bf16x8*)(sb + (n * 16 + fr) * 32 + fq * 8); }
    { auto ldst = [&](int i) -> bf16_t* { const int f = i / 28, c = i % 28;
        return c < 4 ? &L.rq[f][c * 8] : (c < 8 ? &L.rk[f][(c - 4) * 8] : (c < 16 ? &L.rv[f][(c - 8) * 8] : (c < 24 ? &L.rog[f][(c - 16) * 8] : &L.rlr[f][(c - 24) * 8]))); };
      *(uint4*)ldst(tid) = r0; *(uint4*)ldst(tid + NT) = r1; *(uint4*)ldst(tid + 2 * NT) = r2;
      if (tid < 64 * 28 - 3 * NT) *(uint4*)ldst(tid + 3 * NT) = r3;
      (&L.w2s[0][0][0])[tid] = w2a; (&L.w2s[0][0][0])[tid + NT] = w2b;
      if (tid < 64) L.gbs[tid >> 5][tid & 31] = gbv; }
    if (task + nb < NB * ncp * 4) gfetch(task + nb, tid);
    __syncthreads();
    { const int dir = tid >> 8, f = (tid >> 2) & 63, d0 = (tid & 3) * 8;
      float z[8];
#pragma unroll
      for (int e = 0; e < 8; ++e) z[e] = L.gbs[dir][d0 + e];
      const uint4 l0 = *(const uint4*)&L.rlr[f][dir * 16], l1 = *(const uint4*)&L.rlr[f][dir * 16 + 8];
      const unsigned lw[8] = {l0.x, l0.y, l0.z, l0.w, l1.x, l1.y, l1.z, l1.w};
#pragma unroll
      for (int r = 0; r < 16; ++r) { const float lv = (r & 1) ? __uint_as_float(lw[r >> 1] & 0xffff0000u) : __uint_as_float(lw[r >> 1] << 16);
        const float4 wa = *(const float4*)&L.w2s[dir][r][d0], wb = *(const float4*)&L.w2s[dir][r][d0 + 4];
        z[0] += lv * wa.x; z[1] += lv * wa.y; z[2] += lv * wa.z; z[3] += lv * wa.w; z[4] += lv * wb.x; z[5] += lv * wb.y; z[6] += lv * wb.z; z[7] += lv * wb.w; }
#pragma unroll
      for (int e = 0; e < 8; ++e) z[e] = logsigmoidf_(z[e]) * (1.f / 16.f);
      *(float4*)&L.g[dir][f][d0] = make_float4(z[0], z[1], z[2], z[3]); *(float4*)&L.g[dir][f][d0 + 4] = make_float4(z[4], z[5], z[6], z[7]); }
    __syncthreads();
#pragma unroll
    for (int cc = 0; cc < 8; ++cc) { const int col = wv * 8 + cc, dir = col >> 5, d = col & 31, f = dir ? 63 - lane : lane;
      float v = L.g[dir][f][d];
#pragma unroll
      for (int o = 1; o < 64; o <<= 1) { const float t = __shfl_up(v, o); if (lane >= o) v += t; }
      L.g[dir][f][d] = v; if (lane == 63) L.gt[dir][d] = v; }
    __syncthreads();
    if (PASS == 1) {
      for (int i = tid; i < 2 * 64 * 16; i += NT) { int dir = i >> 10, f = (i >> 4) & 63, dp = i & 15;
        const unsigned qq = *(const unsigned*)&L.rq[f][2 * dp], kk = *(const unsigned*)&L.rk[f][2 * dp];
        const float2 cc = *(const float2*)&L.g[dir][f][2 * dp];
        const float e0 = __expf(cc.x), e1 = __expf(cc.y);
        *(unsigned*)&L.qg[dir][f][2 * dp] = pack2(__uint_as_float(qq << 16) * e0 * 0.17677669529663687f, __uint_as_float(qq & 0xffff0000u) * e1 * 0.17677669529663687f);
        *(unsigned*)&L.kg[dir][f][2 * dp] = pack2(__uint_as_float(kk << 16) * __builtin_amdgcn_rcpf(e0), __uint_as_float(kk & 0xffff0000u) * __builtin_amdgcn_rcpf(e1)); }
    } else {
      bf16_t (*ket)[32][72] = (bf16_t (*)[32][72])&L.kg[0][0][0];
      for (int i = tid; i < 2 * 32 * 16; i += NT) { int d = i & 31, f4 = (i >> 5) & 15, dir = i >> 9, f0 = f4 * 4; float v[4];
#pragma unroll
        for (int q = 0; q < 4; ++q) v[q] = bf2f(L.rk[f0 + q][d]) * __expf(L.gt[dir][d] - L.g[dir][f0 + q][d]);
        uint2 pk; pk.x = pack2(v[0], v[1]); pk.y = pack2(v[2], v[3]); *(uint2*)&ket[dir][d][f0] = pk; }
    }
    for (int i = tid; i < 64 * 16; i += NT) { int c = i & 63, f0 = (i >> 6) * 4;
      uint2 pk; pk.x = (unsigned)L.rv[f0][c] | ((unsigned)L.rv[f0 + 1][c] << 16); pk.y = (unsigned)L.rv[f0 + 2][c] | ((unsigned)L.rv[f0 + 3][c] << 16); *(uint2*)&L.vt[c][f0] = pk; }
    __syncthreads();
    if (PASS == 0) {
      const bf16_t (*ket)[32][72] = (const bf16_t (*)[32][72])&L.kg[0][0][0];
      f32x4 acc[2][1] = {{{0.f, 0.f, 0.f, 0.f}}, {{0.f, 0.f, 0.f, 0.f}}};
      wmm<2, 1, 2, 72, 72>(acc, &ket[dirw][0][0], &L.vt[s4 * 16][0], fr, fq);
      bf16_t* dst = p.gla_l + ((size_t)seq * NCH + nsc) * 2048 + (s4 * 16 + fr) * 32;
#pragma unroll
      for (int m = 0; m < 2; ++m) { uint2 pk; pk.x = pack2(acc[m][0][0], acc[m][0][1]); pk.y = pack2(acc[m][0][2], acc[m][0][3]); *(uint2*)(dst + m * 16 + fq * 4) = pk; }
      if (tid < 64) { int dir = tid >> 5, d = tid & 31; p.gla_dec[((size_t)((b * 4 + h) * 2 + dir) * NCH + scan_idx(cpos, dir)) * 32 + d] = __expf(L.gt[dir][d]); }
    } else {
      { f32x4 acc[4][1];
#pragma unroll
        for (int m = 0; m < 4; ++m) acc[m][0] = (f32x4){0.f, 0.f, 0.f, 0.f};
        wmm<4, 1, 1, 40, 40>(acc, &L.kg[dirw][0][0], &L.qg[dirw][s4 * 16][0], fr, fq);
        const int i = s4 * 16 + fr;
#pragma unroll
        for (int m = 0; m < 4; ++m) { float v[4];
#pragma unroll
          for (int q = 0; q < 4; ++q) { int j = m * 16 + fq * 4 + q; bool keep = dirw == 0 ? (j <= i) : (j >= i); v[q] = keep ? acc[m][0][q] : 0.f; }
          uint2 pk; pk.x = pack2(v[0], v[1]); pk.y = pack2(v[2], v[3]); *(uint2*)&L.at[dirw][i][m * 16 + fq * 4] = pk; } }
      f32x4 ao[1][4];
#pragma unroll
      for (int n = 0; n < 4; ++n) ao[0][n] = (f32x4){0.f, 0.f, 0.f, 0.f};
      wmm<1, 4, 2, 72, 72>(ao, &L.at[dirw][s4 * 16][0], &L.vt[0][0], fr, fq);
      { bf16x8 a = *(const bf16x8*)&L.qg[dirw][s4 * 16 + fr][fq * 8];
#pragma unroll
        for (int n = 0; n < 4; ++n) ao[0][n] = __builtin_amdgcn_mfma_f32_16x16x32_bf16(a, sfrag[n], ao[0][n], 0, 0, 0); }
      if (dirw == 1) {
#pragma unroll
        for (int n = 0; n < 4; ++n)
#pragma unroll
          for (int q = 0; q < 4; ++q) L.ox[s4 * 16 + fq * 4 + q][n * 16 + fr] = ao[0][n][q]; }
      __syncthreads();
      if (dirw == 0) {
        float ss[4] = {0.f, 0.f, 0.f, 0.f};
#pragma unroll
        for (int n = 0; n < 4; ++n)
#pragma unroll
          for (int q = 0; q < 4; ++q) { ao[0][n][q] += L.ox[s4 * 16 + fq * 4 + q][n * 16 + fr]; ss[q] += ao[0][n][q] * ao[0][n][q]; }
#pragma unroll
        for (int q = 0; q < 4; ++q) {
#pragma unroll
          for (int o = 1; o < 16; o <<= 1) ss[q] += __shfl_xor(ss[q], o);
          ss[q] = rsqrtf(ss[q] * (1.f / 64.f) + 1e-6f); }
#pragma unroll
        for (int n = 0; n < 4; ++n) { const int c = n * 16 + fr; const float nw = p.gla_norm[layer * 256 + h * 64 + c];
#pragma unroll
          for (int q = 0; q < 4; ++q) { const int f = s4 * 16 + fq * 4 + q; float og = bf2f(L.rog[f][c]);
            p.y[(size_t)(row0 + f) * D + h * 64 + c] = f2bf(ao[0][n][q] * ss[q] * nw * siluf(og)); } }
      }
    }
    __syncthreads();
  }
}
__device__ __forceinline__ void phase_gla_state(CParams& p, int bid, int nb, int tid_) {
  for (int i = bid * NT + tid_; i < 32 * 1024; i += nb * NT) {
    const int seq = i >> 10, e2 = (i & 1023) * 2;
    unsigned* lp = (unsigned*)(p.gla_l + (size_t)seq * NCH * 2048 + e2);
    const float* dp = p.gla_dec + (size_t)seq * NCH * 32 + (e2 & 31);
    float s0 = 0.f, s1 = 0.f;
    for (int n = 0; n < NCH; n += 12) {
      unsigned lv[12]; float2 dc[12];
#pragma unroll
      for (int q = 0; q < 12; ++q) { lv[q] = lp[(size_t)(n + q) * 1024]; dc[q] = *(const float2*)(dp + (n + q) * 32); }
#pragma unroll
      for (int q = 0; q < 12; ++q) { lp[(size_t)(n + q) * 1024] = pack2(s0, s1); s0 = s0 * dc[q].x + bf2f((bf16_t)(lv[q] & 0xffff)); s1 = s1 * dc[q].y + bf2f((bf16_t)(lv[q] >> 16)); }
    }
  }
}

__device__ __forceinline__ void phase_hy_prep(CParams& p, int layer, int bid, int nb, int tid_) {
  if (layer != 0) return;
  for (long i = (long)bid * NT + tid_; i < (long)TC * 768; i += (long)nb * NT) {
    int row = TL + (int)(i / 768), c = (int)(i % 768);
    int rm = seq_nb(row, -1, false), rp = seq_nb(row, 1, false);
    const float* w = p.hy_conv_w + (size_t)layer * 3 * 768;
    float a = p.hy_conv_b[layer * 768 + c] + w[768 + c] * bf2f(p.u[(size_t)row * NU + U_HY + c]);
    if (rm >= 0) a += w[c] * bf2f(p.u[(size_t)rm * NU + U_HY + c]);
    if (rp >= 0) a += w[2 * 768 + c] * bf2f(p.u[(size_t)rp * NU + U_HY + c]);
    p.prep[(size_t)row * 768 + c] = f2bf(a);
  }
}
template <bool TR>
__device__ __forceinline__ void phase_hy_filt(CParams& p, int layer, int L, float* filt, int bid, int nb, int tid_, char* smem) {
  constexpr int PP = 16;
  float* feats = (float*)smem;
  float* h1 = feats + PP * 36;
  float* h2 = h1 + PP * 64;
  float* h3 = h2 + PP * 64;
  float* w1s = h3 + PP * 64;
  float* w2s = w1s + 33 * 64; float* w3s = w2s + 64 * 64; float* bfs = w3s + 64 * 64;
  const int t = tid_;
  const float* w4 = p.hy_w4 + (size_t)layer * 64 * 1024;
  for (int i = t; i < 33 * 64; i += NT) w1s[i] = p.hy_w1[(size_t)layer * 33 * 64 + i];
  for (int i = t; i < 64 * 64; i += NT) { w2s[i] = p.hy_w2[(size_t)layer * 64 * 64 + i]; w3s[i] = p.hy_w3[(size_t)layer * 64 * 64 + i]; }
  if (t < 64) { bfs[t] = p.hy_b1[layer * 64 + t]; bfs[64 + t] = p.hy_b2[layer * 64 + t]; bfs[128 + t] = p.hy_b3[layer * 64 + t]; }
  if (t < 192) bfs[192 + t] = p.hy_freq[layer * 192 + t];
  __syncthreads();
  for (int blk = bid; blk < L / PP; blk += nb) {
    const int pos0 = blk * PP;
    for (int i = t; i < PP * 33; i += NT) {
      int pp = i / 33, f = i % 33; float pos = (float)(pos0 + pp); float v;
      if (f == 0) v = pos / (float)(L - 1);
      else { int j = (f - 1) & 15; float band = 1e-4f + (float)j * ((15.f - 1e-4f) / 15.f); float ang = (6.283185307179586f / (float)L) * pos * band; v = f <= 16 ? cosf(ang) : -sinf(ang); }
      feats[pp * 36 + f] = v;
    }
    __syncthreads();
    for (int i = t; i < PP * 64; i += NT) { int pp = i >> 6, j = i & 63; float a = bfs[j];
#pragma unroll
      for (int k = 0; k < 33; ++k) a += feats[pp * 36 + k] * w1s[k * 64 + j];
      h1[i] = sinf(bfs[192 + j] * a); }
    __syncthreads();
    for (int i = t; i < PP * 64; i += NT) { int pp = i >> 6, j = i & 63; float a = bfs[64 + j];
#pragma unroll 16
      for (int k = 0; k < 64; ++k) a += h1[pp * 64 + k] * w2s[k * 64 + j];
      h2[i] = sinf(bfs[256 + j] * a); }
    __syncthreads();
    for (int i = t; i < PP * 64; i += NT) { int pp = i >> 6, j = i & 63; float a = bfs[128 + j];
#pragma unroll 16
      for (int k = 0; k < 64; ++k) a += h2[pp * 64 + k] * w3s[k * 64 + j];
      h3[i] = sinf(bfs[320 + j] * a); }
    __syncthreads();
#pragma unroll 1
    for (int cc = 0; cc < 1024 / NT; ++cc) {
      int col = cc * NT + t, c = col & 255;
      float acc[PP];
#pragma unroll
      for (int pp = 0; pp < PP; ++pp) acc[pp] = 0.f;
#pragma unroll 1
      for (int k0 = 0; k0 < 64; k0 += 16) { float wv[16];
#pragma unroll
        for (int k = 0; k < 16; ++k) wv[k] = w4[(k0 + k) * 1024 + col];
#pragma unroll
        for (int k = 0; k < 16; ++k)
#pragma unroll
          for (int pp = 0; pp < PP; ++pp) acc[pp] += h3[pp * 64 + k0 + k] * wv[k]; }
      const float mind = -3.0701134573253945f, maxd = -15.350567286626973f;
      float delta = fabsf(mind + (float)c * ((maxd - mind) / 255.f));
#pragma unroll
      for (int pp = 0; pp < PP; ++pp) { float tn = (float)(pos0 + pp) / (float)(L - 1); float fv = acc[pp] * __expf(-tn * delta); if (TR) filt[(size_t)col * L + pos0 + pp] = fv; else filt[(size_t)(pos0 + pp) * 1024 + col] = fv; }
    }
    __syncthreads();
  }
}
__device__ __forceinline__ void phase_hy_conv(CParams& p, int layer, int stage, bool ctx, int bid, int nb, int tid_) {
  const int L = ctx ? CTX : SEQ, rbase = ctx ? TL : 0;
  const float* filt = ctx ? p.filtc : p.filt;
  const int ntt = L / 16;
  const int total = NB * ntt * 256;
  for (int i = bid * NT + tid_; i < total; i += nb * NT) {
    const int c = i & 255, tt = (i >> 8) % ntt, b = (i >> 8) / ntt, t0 = tt * 16;
    const float* ff = filt + stage * 512 + c;
    float acc[16], win[16];
#pragma unroll
    for (int k = 0; k < 16; ++k) acc[k] = 0.f;
#pragma unroll
    for (int k = 0; k < 16; ++k) win[k] = ff[(size_t)(t0 + k) * 1024];
    for (int s0 = 0; s0 < L; s0 += 16) {
#pragma unroll
      for (int ss = 0; ss < 16; ++ss) {
        const int s = s0 + ss; const int row = rbase + b * L + s;
        float uv = stage == 0 ? bf2f(p.prep[(size_t)row * 768 + c]) : p.zbuf[(size_t)row * 256 + c];
#pragma unroll
        for (int k = 0; k < 16; ++k) acc[k] += win[(k + 16 - ss) & 15] * uv;
        int dl = t0 - (s + 1);
        float nv = 0.f;
        if (s + 1 < L) nv = dl >= 0 ? ff[(size_t)dl * 1024] : ff[(size_t)(-dl) * 1024 + 256];
        win[(15 + 16 - ss) & 15] = nv;
      }
    }
    const float dsk = p.hy_d[(layer * 2 + stage) * 256 + c];
#pragma unroll
    for (int k = 0; k < 16; ++k) {
      const int row = rbase + b * L + t0 + k;
      if (stage == 0) { float vv = bf2f(p.prep[(size_t)row * 768 + c]); float x1 = bf2f(p.prep[(size_t)row * 768 + 256 + c]); p.zbuf[(size_t)row * 256 + c] = x1 * (acc[k] + dsk * vv); }
      else { float zz = p.zbuf[(size_t)row * 256 + c]; float x2 = bf2f(p.prep[(size_t)row * 768 + 512 + c]); p.y[(size_t)row * D + 256 + c] = f2bf(x2 * (acc[k] + dsk * zz)); }
    }
  }
}

__device__ __forceinline__ void phase_hy_prep_t(CParams& p, int layer, int bid, int nb, int tid_, char* smem) {
  bf16_t (*tl)[72] = (bf16_t (*)[72])smem;
  const float* w = p.hy_conv_w + (size_t)layer * 3 * 768; const float* bs = p.hy_conv_b + layer * 768;
  for (int task = bid; task < NB * (SEQ / 64); task += nb) {
    int tid = tid_; asm volatile("" : "+v"(tid));
    const int b = task / (SEQ / 64), t0 = (task % (SEQ / 64)) * 64;
#pragma unroll 4
    for (int i = tid; i < 64 * 96; i += NT) { const int ck = (i & 7) + 8 * ((i >> 6) % 12), tl_ = ((i >> 3) & 7) + 8 * (i / 768), t = t0 + tl_; const int row = b * SEQ + t;
      float o[8]; conv8(p.u, U_HY, row, t > 0 ? row - 1 : -1, t < SEQ - 1 ? row + 1 : -1, w, bs, ck * 8, o);
#pragma unroll
      for (int e = 0; e < 8; ++e) tl[ck * 8 + e][tl_] = f2bf(o[e]); }
    __syncthreads();
    for (int i = tid; i < 768 * 8; i += NT) { const int c = i >> 3, ch = i & 7; *(uint4*)(p.prep + ((size_t)(b * 768 + c)) * SEQ + t0 + ch * 8) = *(const uint4*)&tl[c][ch * 8]; }
    __syncthreads();
  }
}
#define FPAD(i) ((i) + (((i) >> 5) << 1))
struct FftLds { float2 x[16384 + 1024]; float2 t1[128]; float2 t0[128]; };
__device__ __forceinline__ float2 cmulf(float2 a, float2 b) { return make_float2(a.x * b.x - a.y * b.y, a.x * b.y + a.y * b.x); }
__device__ __forceinline__ float2 cmulcf(float2 a, float2 w) { return make_float2(a.x * w.x + a.y * w.y, a.y * w.x - a.x * w.y); }
__device__ __forceinline__ float2 caddf(float2 a, float2 b) { return make_float2(a.x + b.x, a.y + b.y); }
__device__ __forceinline__ float2 csubf(float2 a, float2 b) { return make_float2(a.x - b.x, a.y - b.y); }
template <bool INV> __device__ __forceinline__ void r4bf(float2& a0, float2& a1, float2& a2, float2& a3) {
  const float2 s0 = caddf(a0, a2), s1 = csubf(a0, a2), s2 = caddf(a1, a3), d = csubf(a1, a3);
  const float2 s3 = INV ? make_float2(-d.y, d.x) : make_float2(d.y, -d.x);
  a0 = caddf(s0, s2); a1 = caddf(s1, s3); a2 = csubf(s0, s2); a3 = csubf(s1, s3);
}
__device__ __forceinline__ float2 w16c(int k) {
  constexpr float C1 = 0.92387953251128674f, S1 = 0.38268343236508977f, R2 = 0.70710678118654752f;
  return k == 1 ? make_float2(C1, -S1) : k == 2 ? make_float2(R2, -R2) : k == 3 ? make_float2(S1, -C1) : k == 4 ? make_float2(0.f, -1.f) : k == 6 ? make_float2(-R2, -R2) :   make_float2(-C1, S1);
}
template <bool INV, int LQ, bool HALF = false>
__device__ __forceinline__ void fft_pass16(FftLds& L, int tid) {
  constexpr int Q = 1 << LQ;
#pragma unroll
  for (int i = 0; i < 2; ++i) {
    const int bf = tid + 512 * i, j = bf & (Q - 1), base = ((bf >> LQ) << (LQ + 4)) + j, k = j << (10 - LQ);
    float2 v[16];
#pragma unroll
    for (int s2 = 0; s2 < 16; ++s2) v[s2] = (HALF && !INV && s2 >= 8) ? make_float2(0.f, 0.f) : L.x[FPAD(base + s2 * Q)];
    const float2 w1 = cmulf(L.t1[k >> 7], L.t0[k & 127]), w2 = cmulf(w1, w1), w3 = cmulf(w2, w1), w4 = cmulf(w2, w2), w8 = cmulf(w4, w4), w12 = cmulf(w8, w4);
    const float2 wm[4] = {make_float2(1.f, 0.f), w1, w2, w3}, wn[4] = {make_float2(1.f, 0.f), w4, w8, w12};
    if (!INV) {
#pragma unroll
      for (int q = 0; q < 4; ++q) {
        if (HALF) { const float2 a0 = v[q], a1 = v[q + 4];
          v[q] = caddf(a0, a1); v[q + 4] = make_float2(a0.x + a1.y, a0.y - a1.x); v[q + 8] = csubf(a0, a1); v[q + 12] = make_float2(a0.x - a1.y, a0.y + a1.x); }
        else r4bf<false>(v[q], v[q + 4], v[q + 8], v[q + 12]); }
#pragma unroll
      for (int m = 1; m < 4; ++m)
#pragma unroll
        for (int q = 0; q < 4; ++q) { float2 t = v[q + 4 * m]; if (q > 0) t = cmulf(t, w16c(q * m)); v[q + 4 * m] = cmulf(t, wm[m]); }
#pragma unroll
      for (int m = 0; m < 4; ++m) { r4bf<false>(v[4 * m], v[4 * m + 1], v[4 * m + 2], v[4 * m + 3]);
#pragma unroll
        for (int n = 1; n < 4; ++n) v[4 * m + n] = cmulf(v[4 * m + n], wn[n]); }
    } else {
#pragma unroll
      for (int m = 0; m < 4; ++m) {
#pragma unroll
        for (int n = 1; n < 4; ++n) v[4 * m + n] = cmulcf(v[4 * m + n], wn[n]);
        r4bf<true>(v[4 * m], v[4 * m + 1], v[4 * m + 2], v[4 * m + 3]); }
#pragma unroll
      for (int m = 1; m < 4; ++m)
#pragma unroll
        for (int q = 0; q < 4; ++q) { float2 t = cmulcf(v[q + 4 * m], wm[m]); if (q > 0) t = cmulcf(t, w16c(q * m)); v[q + 4 * m] = t; }
#pragma unroll
      for (int q = 0; q < 4; ++q) {
        if (HALF) { const float2 c0 = v[q], c1 = v[q + 4], c2 = v[q + 8], c3 = v[q + 12]; const float2 s0 = caddf(c0, c2), s1 = csubf(c0, c2), s2 = caddf(c1, c3), d = csubf(c1, c3);
          v[q] = caddf(s0, s2); v[q + 4] = make_float2(s1.x - d.y, s1.y + d.x); }
        else r4bf<true>(v[q], v[q + 4], v[q + 8], v[q + 12]); }
    }
#pragma unroll
    for (int s2 = 0; s2 < ((HALF && INV) ? 8 : 16); ++s2) L.x[FPAD(base + s2 * Q)] = v[s2];
  }
  __syncthreads();
}
template <bool INV> __device__ __forceinline__ void fft_pass4_last(FftLds& L, int tid) {
#pragma unroll 2
  for (int i = 0; i < 8; ++i) { const int p0 = FPAD(4 * (tid + 512 * i));
    float4 u0 = *(const float4*)&L.x[p0], u1 = *(const float4*)&L.x[p0 + 2];
    float2 a0 = make_float2(u0.x, u0.y), a1 = make_float2(u0.z, u0.w), a2 = make_float2(u1.x, u1.y), a3 = make_float2(u1.z, u1.w);
    r4bf<INV>(a0, a1, a2, a3);
    *(float4*)&L.x[p0] = make_float4(a0.x, a0.y, a1.x, a1.y); *(float4*)&L.x[p0 + 2] = make_float4(a2.x, a2.y, a3.x, a3.y); }
  __syncthreads();
}
template <bool INV, bool HALF = false>
__device__ __forceinline__ void fft16k(FftLds& L, int tid) {
  if (!INV) { fft_pass16<false, 10, HALF>(L, tid); fft_pass16<false, 6>(L, tid); fft_pass16<false, 2>(L, tid); fft_pass4_last<false>(L, tid); }
  else { fft_pass4_last<true>(L, tid); fft_pass16<true, 2>(L, tid); fft_pass16<true, 6>(L, tid); fft_pass16<true, 10, HALF>(L, tid); }
}
__device__ __forceinline__ void phase_hy_fft(CParams& p, int layer, int bid, int nb, int tid_, char* smem) {
  FftLds& L = *(FftLds*)smem;
  for (int c = bid; c < 256; c += nb) {
    int tid = tid_; asm volatile("" : "+v"(tid));
    if (tid < 128) { float sn, cs; sincospif(-(float)tid / 64.f, &sn, &cs); L.t1[tid] = make_float2(cs, sn);
      sincospif(-(float)tid / 8192.f, &sn, &cs); L.t0[tid] = make_float2(cs, sn); }
#pragma unroll 1
    for (int o = 0; o < 2; ++o) {
      asm volatile("" : "+v"(tid));
      const float* hf = p.filt + (size_t)(o * 512 + c) * SEQ; const float* hb = p.filt + (size_t)(o * 512 + 256 + c) * SEQ;
      __syncthreads();
#pragma unroll 16
      for (int n = tid; n < 16384; n += NT) { float v = n < SEQ ? hf[n] : (n == SEQ ? 0.f : hb[16384 - n]); L.x[FPAD(n)] = make_float2(v, 0.f); }
      __syncthreads();
      fft16k<false>(L, tid);
      float2* specg = p.specg + (size_t)c * 16384;
#pragma unroll
      for (int k = 0; k < 32; ++k) { float2 v = L.x[FPAD(tid + 512 * k)]; specg[tid + 512 * k] = make_float2(v.x * (1.f / 16384.f), v.y * (1.f / 16384.f)); }
      const float dsk = p.hy_d[(layer * 2 + o) * 256 + c];
#pragma unroll 1
      for (int pr = 0; pr < 2; ++pr) {
        const int b0 = pr * 2, b1 = pr * 2 + 1;
        asm volatile("" : "+v"(tid));
        __syncthreads();
        if (o == 0) {
          const bf16_t* u0 = p.prep + ((size_t)(b0 * 768 + c)) * SEQ; const bf16_t* u1 = p.prep + ((size_t)(b1 * 768 + c)) * SEQ;
#pragma unroll 8
          for (int n2 = tid; n2 < SEQ / 2; n2 += NT) { unsigned x0 = *(const unsigned*)(u0 + 2 * n2), x1 = *(const unsigned*)(u1 + 2 * n2);
            *(float4*)&L.x[FPAD(2 * n2)] = make_float4(bf2f((bf16_t)(x0 & 0xffff)), bf2f((bf16_t)(x1 & 0xffff)), bf2f((bf16_t)(x0 >> 16)), bf2f((bf16_t)(x1 >> 16))); }
        } else {
          const float* u0 = p.zbuf + ((size_t)(b0 * 256 + c)) * SEQ; const float* u1 = p.zbuf + ((size_t)(b1 * 256 + c)) * SEQ;
#pragma unroll 8
          for (int n2 = tid; n2 < SEQ / 2; n2 += NT) { float2 x0 = *(const float2*)(u0 + 2 * n2), x1 = *(const float2*)(u1 + 2 * n2); *(float4*)&L.x[FPAD(2 * n2)] = make_float4(x0.x, x1.x, x0.y, x1.y); }
        }
        __syncthreads();
        fft16k<false, true>(L, tid);
#pragma unroll
        for (int k = 0; k < 32; ++k) { float2 v = L.x[FPAD(tid + 512 * k)]; L.x[FPAD(tid + 512 * k)] = cmulf(v, specg[tid + 512 * k]); }
        __syncthreads();
        fft16k<true, true>(L, tid);
        if (o == 0) {
          const bf16_t* v0 = p.prep + ((size_t)(b0 * 768 + c)) * SEQ; const bf16_t* v1 = p.prep + ((size_t)(b1 * 768 + c)) * SEQ;
          const bf16_t* g0 = p.prep + ((size_t)(b0 * 768 + 256 + c)) * SEQ; const bf16_t* g1 = p.prep + ((size_t)(b1 * 768 + 256 + c)) * SEQ;
          float* z0 = p.zbuf + ((size_t)(b0 * 256 + c)) * SEQ; float* z1 = p.zbuf + ((size_t)(b1 * 256 + c)) * SEQ;
#pragma unroll 8
          for (int n = tid; n < SEQ; n += NT) { float2 y = L.x[FPAD(n)]; z0[n] = bf2f(g0[n]) * (y.x + dsk * bf2f(v0[n])); z1[n] = bf2f(g1[n]) * (y.y + dsk * bf2f(v1[n])); }
        } else {
          const float* z0 = p.zbuf + ((size_t)(b0 * 256 + c)) * SEQ; const float* z1 = p.zbuf + ((size_t)(b1 * 256 + c)) * SEQ;
          float* y0 = p.yt + ((size_t)(b0 * 256 + c)) * SEQ; float* y1 = p.yt + ((size_t)(b1 * 256 + c)) * SEQ;
#pragma unroll 8
          for (int n = tid; n < SEQ; n += NT) { float2 y = L.x[FPAD(n)]; y0[n] = y.x + dsk * z0[n]; y1[n] = y.y + dsk * z1[n]; }
        }
      }
      __threadfence();
    }
    __syncthreads();
  }
}
__device__ __forceinline__ void phase_hy_fin(CParams& p, int bid, int nb, int tid_, char* smem) {
  bf16_t (*tl)[264] = (bf16_t (*)[264])smem;
  for (int task = bid; task < NB * (SEQ / 64); task += nb) {
    int tid = tid_; asm volatile("" : "+v"(tid));
    const int b = task / (SEQ / 64), t0 = (task % (SEQ / 64)) * 64;
#pragma unroll 8
    for (int i = tid; i < 256 * 64; i += NT) { const int t = i & 63, c = i >> 6;
      float v = bf2f(p.prep[((size_t)(b * 768 + 512 + c)) * SEQ + t0 + t]) * p.yt[((size_t)(b * 256 + c)) * SEQ + t0 + t];
      tl[t][c] = f2bf(v); }
    __syncthreads();
    for (int i = tid; i < 64 * 32; i += NT) { const int t = i >> 5, ch = i & 31; *(uint4*)(p.y + ((size_t)b * SEQ + t0 + t) * D + 256 + ch * 8) = *(const uint4*)&tl[t][ch * 8]; }
    __syncthreads();
  }
}

__device__ __forceinline__ void phase_mb_prep(CParams& p, int layer, int bid, int nb, int tid_) {
  const int lane = tid_ & 63, wv = tid_ >> 6;
  const float* w = p.mb_conv_w + (size_t)layer * 3 * 768; const float* bs = p.mb_conv_b + layer * 768;
  for (int row0 = (bid * NW + wv) * 4; row0 < TT; row0 += nb * NW * 4) {
    float o[4][2][8];
#pragma unroll
    for (int r = 0; r < 4; ++r) { const int row = row0 + r; const int rm = seq_nb(row, -1, true), rp = seq_nb(row, 1, true);
#pragma unroll
      for (int j = 0; j < 2; ++j) { const int ck = lane + 64 * j; if (ck < 96) conv8(p.u, U_MB + 256, row, rm, rp, w, bs, ck * 8, o[r][j]); } }
#pragma unroll
    for (int r = 0; r < 4; ++r) { const int row = row0 + r;
#pragma unroll
      for (int j = 0; j < 2; ++j) { const int ck = lane + 64 * j; if (ck < 96) {
#pragma unroll
          for (int e = 0; e < 8; ++e) o[r][j][e] = siluf(o[r][j][e]);
          uint4 pk; pk.x = pack2(o[r][j][0], o[r][j][1]); pk.y = pack2(o[r][j][2], o[r][j][3]); pk.z = pack2(o[r][j][4], o[r][j][5]); pk.w = pack2(o[r][j][6], o[r][j][7]); *(uint4*)(p.prep + (size_t)row * 768 + ck * 8) = pk; } }
      if (lane < 8) p.dt[(size_t)row * 8 + lane] = softplusf_(bf2f(p.u[(size_t)row * NU + U_MB + 1024 + lane]) + p.mb_dt_bias[layer * 8 + lane]); }
  }
}
__device__ __forceinline__ int mb_row(int b, int cpos, int i) {
  if (cpos < 4) return TL + b * CTX + cpos * 64 + i;
  const int n = cpos - 4; return b * SEQ + ((n & 1) * 64 + i) * 64 + (n >> 1);
}
struct MbLds {
  bf16_t bimg[64][136]; bf16_t cimg[64][136];
  bf16_t bt[128][72];
  bf16_t xt[2][64][72];
  bf16_t pm[2][64][72];
  float ox[64][65];
  float dtv[2][64], cum[2][64], tot[2]; int rows[64];
};
template <int PASS>
__device__ __forceinline__ void phase_mb_chunk(CParams& p, int layer, int bid, int nb, int tid_, char* smem) {
  MbLds& L = *(MbLds*)smem;
  const int c_lo = (PASS == 1 && layer == DEPTH - 1) ? 4 : 0, ncp = NCH - c_lo;
  uint4 pbc[4]; float pdt = 0.f;
#pragma unroll
  for (int q = 0; q < 4; ++q) pbc[q] = make_uint4(0u, 0u, 0u, 0u);
  auto mfetch = [&](int task_, int tid) { const int h_ = task_ & 3, cpos_ = c_lo + (task_ >> 2) % ncp, b_ = (task_ >> 2) / ncp, g_ = h_ >> 1;
#pragma unroll
    for (int q = 0; q < 4; ++q) { const int i = tid + q * NT, which = i >> 10, t = (i >> 4) & 63, ch = i & 15;
      pbc[q] = *(const uint4*)(p.prep + (size_t)mb_row(b_, cpos_, t) * 768 + 256 + which * 256 + g_ * 128 + ch * 8); }
    if (tid < 128) pdt = p.dt[(size_t)mb_row(b_, cpos_, tid & 63) * 8 + (tid >> 6) * 4 + h_]; };
  if (bid < NB * ncp * 4) mfetch(bid, tid_);
  for (int task = bid; task < NB * ncp * 4; task += nb) {
    int tid = tid_; asm volatile("" : "+v"(tid));
    const int lane = tid & 63, wv = tid >> 6, fr = lane & 15, fq = lane >> 4, dirw = wv >> 2, s4 = wv & 3;
    const int h = task & 3, cpos = c_lo + (task >> 2) % ncp, b = (task >> 2) / ncp, g = h >> 1;
    bf16x8 sfo[4][4]; float xsv[4][4], zzv[4][4];
    if (PASS == 1) { const bf16_t* sb0 = p.mb_l + ((size_t)((b * 4 + h) * 2 + dirw) * NCH + scan_idx(cpos, dirw)) * 8192;
#pragma unroll
      for (int ks = 0; ks < 4; ++ks)
#pragma unroll
        for (int n = 0; n < 4; ++n) sfo[ks][n] = *(const bf16x8*)(sb0 + (n * 16 + fr) * 128 + ks * 32 + fq * 8);
      if (dirw == 0) {
#pragma unroll
        for (int n = 0; n < 4; ++n)
#pragma unroll
          for (int q = 0; q < 4; ++q) { const int row = mb_row(b, cpos, s4 * 16 + fq * 4 + q), pc = n * 16 + fr;
            xsv[n][q] = bf2f(p.prep[(size_t)row * 768 + h * 64 + pc]); zzv[n][q] = bf2f(p.u[(size_t)row * NU + U_MB + h * 64 + pc]); } } }
    if (tid < 64) L.rows[tid] = mb_row(b, cpos, tid);
    if (tid < 128) L.dtv[tid >> 6][tid & 63] = pdt;
#pragma unroll
    for (int q = 0; q < 4; ++q) { const int i = tid + q * NT, which = i >> 10, t = (i >> 4) & 63, ch = i & 15; *(uint4*)(which ? &L.cimg[t][ch * 8] : &L.bimg[t][ch * 8]) = pbc[q]; }
    if (task + nb < NB * ncp * 4) mfetch(task + nb, tid);
    __syncthreads();
    if (wv < 2) { const int dir = wv, i = dir ? 63 - lane : lane; const float a = -__expf(p.mb_a_log[layer * 8 + dir * 4 + h]);
      float v = L.dtv[dir][i] * a;
#pragma unroll
      for (int o = 1; o < 64; o <<= 1) { const float t = __shfl_up(v, o); if (lane >= o) v += t; }
      L.cum[dir][i] = v; if (lane == 63) L.tot[dir] = v; }
    __syncthreads();
    if (PASS == 0) {
      for (int i = tid; i < 128 * 16; i += NT) { int n = i & 127, f0 = (i >> 7) * 4; uint2 pk;
        pk.x = (unsigned)L.bimg[f0][n] | ((unsigned)L.bimg[f0 + 1][n] << 16); pk.y = (unsigned)L.bimg[f0 + 2][n] | ((unsigned)L.bimg[f0 + 3][n] << 16);
        *(uint2*)&L.bt[n][f0] = pk; }
#pragma unroll
      for (int i = tid; i < 2 * 64 * 16; i += NT) { int pc = i & 63, f0 = ((i >> 6) & 15) * 4, dir = i >> 10; float v[4];
#pragma unroll
        for (int q = 0; q < 4; ++q) v[q] = bf2f(p.prep[(size_t)L.rows[f0 + q] * 768 + h * 64 + pc]) * L.dtv[dir][f0 + q] * __expf(L.tot[dir] - L.cum[dir][f0 + q]);
        uint2 pk; pk.x = pack2(v[0], v[1]); pk.y = pack2(v[2], v[3]); *(uint2*)&L.xt[dir][pc][f0] = pk; }
      __syncthreads();
      const int seq = (b * 4 + h) * 2 + dirw, nsc = scan_idx(cpos, dirw);
      f32x4 acc[2][4];
#pragma unroll
      for (int m = 0; m < 2; ++m)
#pragma unroll
        for (int n = 0; n < 4; ++n) acc[m][n] = (f32x4){0.f, 0.f, 0.f, 0.f};
      wmm<2, 4, 2, 72, 72>(acc, &L.bt[s4 * 32][0], &L.xt[dirw][0][0], fr, fq);
      bf16_t* dst = p.mb_l + ((size_t)seq * NCH + nsc) * 8192;
#pragma unroll
      for (int m = 0; m < 2; ++m)
#pragma unroll
        for (int n = 0; n < 4; ++n) { uint2 pk; pk.x = pack2(acc[m][n][0], acc[m][n][1]); pk.y = pack2(acc[m][n][2], acc[m][n][3]);
          *(uint2*)(dst + (n * 16 + fr) * 128 + s4 * 32 + m * 16 + fq * 4) = pk; }
      if (tid < 2) p.mb_dec[(size_t)((b * 4 + h) * 2 + tid) * NCH + scan_idx(cpos, tid)] = __expf(L.tot[tid]);
    } else {
#pragma unroll
      for (int i = tid; i < 64 * 16; i += NT) { int pc = i & 63, f0 = (i >> 6) * 4; uint2 pk; unsigned short v[4];
#pragma unroll
        for (int q = 0; q < 4; ++q) v[q] = p.prep[(size_t)L.rows[f0 + q] * 768 + h * 64 + pc];
        pk.x = (unsigned)v[0] | ((unsigned)v[1] << 16); pk.y = (unsigned)v[2] | ((unsigned)v[3] << 16); *(uint2*)&L.xt[0][pc][f0] = pk; }
      { f32x4 acc[4][1];
#pragma unroll
        for (int m = 0; m < 4; ++m) acc[m][0] = (f32x4){0.f, 0.f, 0.f, 0.f};
        wmm<4, 1, 4, 136, 136>(acc, &L.bimg[0][0], &L.cimg[s4 * 16][0], fr, fq);
        const int i = s4 * 16 + fr; const float ci = L.cum[dirw][i];
#pragma unroll
        for (int m = 0; m < 4; ++m) { float v[4];
#pragma unroll
          for (int q = 0; q < 4; ++q) { int j = m * 16 + fq * 4 + q; bool keep = dirw == 0 ? (j <= i) : (j >= i);
            v[q] = keep ? acc[m][0][q] * __expf(ci - L.cum[dirw][j]) * L.dtv[dirw][j] : 0.f; }
          uint2 pk; pk.x = pack2(v[0], v[1]); pk.y = pack2(v[2], v[3]); *(uint2*)&L.pm[dirw][i][m * 16 + fq * 4] = pk; } }
      __syncthreads();
      f32x4 ao[1][4];
#pragma unroll
      for (int n = 0; n < 4; ++n) ao[0][n] = (f32x4){0.f, 0.f, 0.f, 0.f};
      {
#pragma unroll
        for (int ks = 0; ks < 4; ++ks) { bf16x8 a = *(const bf16x8*)&L.cimg[s4 * 16 + fr][ks * 32 + fq * 8];
#pragma unroll
          for (int n = 0; n < 4; ++n) ao[0][n] = __builtin_amdgcn_mfma_f32_16x16x32_bf16(a, sfo[ks][n], ao[0][n], 0, 0, 0); } }
#pragma unroll
      for (int q = 0; q < 4; ++q) { const float e = __expf(L.cum[dirw][s4 * 16 + fq * 4 + q]);
#pragma unroll
        for (int n = 0; n < 4; ++n) ao[0][n][q] *= e; }
      wmm<1, 4, 2, 72, 72>(ao, &L.pm[dirw][s4 * 16][0], &L.xt[0][0][0], fr, fq);
      if (dirw == 1) {
#pragma unroll
        for (int n = 0; n < 4; ++n)
#pragma unroll
          for (int q = 0; q < 4; ++q) L.ox[s4 * 16 + fq * 4 + q][n * 16 + fr] = ao[0][n][q]; }
      __syncthreads();
      if (dirw == 0) {
        const float dsk = p.mb_d[layer * 4 + h];
        float ss[4] = {0.f, 0.f, 0.f, 0.f};
#pragma unroll
        for (int n = 0; n < 4; ++n)
#pragma unroll
          for (int q = 0; q < 4; ++q) { const int i = s4 * 16 + fq * 4 + q, pc = n * 16 + fr;
            float v = (ao[0][n][q] + L.ox[i][pc] + xsv[n][q] * dsk) * siluf(zzv[n][q]); ao[0][n][q] = v; ss[q] += v * v; }
#pragma unroll
        for (int q = 0; q < 4; ++q) {
#pragma unroll
          for (int o = 1; o < 16; o <<= 1) ss[q] += __shfl_xor(ss[q], o);
          ss[q] = rsqrtf(ss[q] * (1.f / 64.f) + 1e-6f); }
#pragma unroll
        for (int n = 0; n < 4; ++n) { const int c = h * 64 + n * 16 + fr; const float nw = p.mb_norm[layer * 256 + c];
#pragma unroll
          for (int q = 0; q < 4; ++q) p.y[(size_t)L.rows[s4 * 16 + fq * 4 + q] * D + 512 + c] = f2bf(ao[0][n][q] * ss[q] * nw); }
      }
    }
    __syncthreads();
  }
}
__device__ __forceinline__ void phase_mb_state(CParams& p, int bid, int nb, int tid_) {
  for (int i = bid * NT + tid_; i < 32 * 4096; i += nb * NT) {
    const int seq = i >> 12, e2 = (i & 4095) * 2;
    unsigned* lp = (unsigned*)(p.mb_l + (size_t)seq * NCH * 8192 + e2);
    const float* dp = p.mb_dec + (size_t)seq * NCH;
    float s0 = 0.f, s1 = 0.f;
    for (int n = 0; n < NCH; n += 12) {
      unsigned lv[12]; float dc[12];
#pragma unroll
      for (int q = 0; q < 12; ++q) { lv[q] = lp[(size_t)(n + q) * 4096]; dc[q] = dp[n + q]; }
#pragma unroll
      for (int q = 0; q < 12; ++q) { lp[(size_t)(n + q) * 4096] = pack2(s0, s1); s0 = s0 * dc[q] + bf2f((bf16_t)(lv[q] & 0xffff)); s1 = s1 * dc[q] + bf2f((bf16_t)(lv[q] >> 16)); }
    }
  }
}

__device__ __forceinline__ void phase_dn_prep(CParams& p, int layer, int bid, int nb, int tid_) {
  const int lane = tid_ & 63, wv = tid_ >> 6;
  const float* w = p.dn_conv_w + (size_t)layer * 3 * 768;
  for (int row0 = (bid * NW + wv) * 4; row0 < TT; row0 += nb * NW * 4) {
   float oo[4][2][8];
#pragma unroll
   for (int r = 0; r < 4; ++r) { const int row = row0 + r; const int rm = seq_nb(row, -1, false), rp = seq_nb(row, 1, false);
#pragma unroll
     for (int j = 0; j < 2; ++j) { const int ck = lane + 64 * j; if (ck < 96) conv8(p.u, U_DN, row, rm, rp, w, nullptr, ck * 8, oo[r][j]); } }
#pragma unroll
   for (int r = 0; r < 4; ++r) { const int row = row0 + r;
#pragma unroll
    for (int j = 0; j < 2; ++j) { const int ck = lane + 64 * j;
      if (ck < 96) { float (&o)[8] = oo[r][j];
        float ss = 0.f;
#pragma unroll
        for (int e = 0; e < 8; ++e) { o[e] = siluf(o[e]); ss += o[e] * o[e]; }
        if (j == 0) { ss += __shfl_xor(ss, 1); ss += __shfl_xor(ss, 2); ss += __shfl_xor(ss, 4); const float r = rsqrtf(ss + 1e-6f) * (ck < 32 ? 0.125f : 1.f);
#pragma unroll
          for (int e = 0; e < 8; ++e) o[e] *= r; }
        uint4 pk; pk.x = pack2(o[0], o[1]); pk.y = pack2(o[2], o[3]); pk.z = pack2(o[4], o[5]); pk.w = pack2(o[6], o[7]); *(uint4*)(p.prep + (size_t)row * 768 + ck * 8) = pk; } }
    if (lane < 8) {
      float beta = sigmoidf_(bf2f(p.u[(size_t)row * NU + U_DN + 1024 + lane]));
      float g = -__expf(p.dn_a_log[layer * 8 + lane]) * softplusf_(bf2f(p.u[(size_t)row * NU + U_DN + 1032 + lane]) + p.dn_dt_bias[layer * 8 + lane]);
      p.bg[(size_t)row * 16 + lane * 2] = beta; p.bg[(size_t)row * 16 + lane * 2 + 1] = g;
    }
   }
  }
}
struct DnLds {
  bf16_t q[64][72], k[64][72], v[64][72];
  float md[2][4][16][17];
  bf16_t msb[2][64][72];
  bf16_t td[2][4][16][40];
  bf16_t tmp[8][32][40];
  bf16_t a1[2][64][72];
  bf16_t wq[2][64][72];
  bf16_t ut[2][64][72];
  float ox[64][65];
  float beta[2][64], gl[2][64], cum[2][64], tot[2];
};
template <int PASS>
__device__ __forceinline__ void phase_dn_chunk(CParams& p, int layer, int bid, int nb, int tid_, char* smem) {
  DnLds& L = *(DnLds*)smem;
  const int c_lo = (PASS == 1 && layer == DEPTH - 1) ? 4 : 0, ncp = NCH - c_lo;
  uint4 pq = make_uint4(0u, 0u, 0u, 0u), pk_ = pq, pv = pq; float2 pbg = make_float2(0.f, 0.f);
  auto fetch = [&](int task_, int tid) { const int h_ = task_ & 3, cpos_ = c_lo + (task_ >> 2) % ncp, b_ = (task_ >> 2) / ncp; const int r0_ = chunk_row0(b_, cpos_);
    if (tid < 128) pbg = *(const float2*)(p.bg + (size_t)(r0_ + (tid & 63)) * 16 + ((tid >> 6) * 4 + h_) * 2);
    const bf16_t* src = p.prep + (size_t)(r0_ + (tid >> 3)) * 768 + h_ * 64 + (tid & 7) * 8;
    if (PASS == 1) pq = *(const uint4*)src;
    pk_ = *(const uint4*)(src + 256); pv = *(const uint4*)(src + 512); };
  if (bid < NB * ncp * 4) fetch(bid, tid_);
  for (int task = bid; task < NB * ncp * 4; task += nb) {
    int tid = tid_; asm volatile("" : "+v"(tid));
    const int lane = tid & 63, wv = tid >> 6, fr = lane & 15, fq = lane >> 4, dirw = wv >> 2, s4 = wv & 3;
    const int h = task & 3, cpos = c_lo + (task >> 2) % ncp, b = (task >> 2) / ncp;
    const int row0 = chunk_row0(b, cpos);
    bf16x8 sfr[2], sfo[2][4]; float ogv[4][4];
    if (PASS == 1) { const bf16_t* sb0 = p.dn_l + ((size_t)((b * 4 + h) * 2 + dirw) * NCH + scan_idx(cpos, dirw)) * 4096;
#pragma unroll
      for (int ks = 0; ks < 2; ++ks) { sfr[ks] = *(const bf16x8*)(sb0 + (s4 * 16 + fr) * 64 + ks * 32 + fq * 8);
#pragma unroll
        for (int n = 0; n < 4; ++n) sfo[ks][n] = *(const bf16x8*)(sb0 + (n * 16 + fr) * 64 + ks * 32 + fq * 8); }
#pragma unroll
      for (int n = 0; n < 4; ++n)
#pragma unroll
        for (int qq = 0; qq < 4; ++qq) ogv[n][qq] = bf2f(p.u[(size_t)(row0 + s4 * 16 + fq * 4 + qq) * NU + U_DN + 768 + h * 64 + n * 16 + fr]); }
    if (tid < 128) { L.beta[tid >> 6][tid & 63] = pbg.x; L.gl[tid >> 6][tid & 63] = pbg.y; }
    { const int t = tid >> 3, ch = tid & 7;
      if (PASS == 1) *(uint4*)&L.q[t][ch * 8] = pq;
      *(uint4*)&L.k[t][ch * 8] = pk_; *(uint4*)&L.v[t][ch * 8] = pv; }
    if (task + nb < NB * ncp * 4) fetch(task + nb, tid);
    for (int i = tid; i < (int)(sizeof(L.td) / 16); i += NT) ((uint4*)&L.td[0][0][0][0])[i] = make_uint4(0u, 0u, 0u, 0u);
    for (int i = tid; i < (int)(sizeof(L.tmp) / 16); i += NT) ((uint4*)&L.tmp[0][0][0])[i] = make_uint4(0u, 0u, 0u, 0u);
    for (int i = tid; i < (int)(sizeof(L.ut) / 16); i += NT) { ((uint4*)&L.ut[0][0][0])[i] = make_uint4(0u, 0u, 0u, 0u); ((uint4*)&L.wq[0][0][0])[i] = make_uint4(0u, 0u, 0u, 0u); }
    __syncthreads();
    if (wv < 2) { const int dir = wv, f = dir ? 63 - lane : lane;
      float v = L.gl[dir][f];
#pragma unroll
      for (int o = 1; o < 64; o <<= 1) { const float t = __shfl_up(v, o); if (lane >= o) v += t; }
      L.cum[dir][f] = v; if (lane == 63) L.tot[dir] = v; }
    __syncthreads();
    { f32x4 acc[4][1];
#pragma unroll
      for (int m = 0; m < 4; ++m) acc[m][0] = (f32x4){0.f, 0.f, 0.f, 0.f};
      wmm<4, 1, 2, 72, 72>(acc, &L.k[0][0], &L.k[s4 * 16][0], fr, fq);
      const int j = s4 * 16 + fr; const float cj = L.cum[dirw][j]; const int sj = dirw ? 63 - j : j;
#pragma unroll
      for (int m = 0; m < 4; ++m)
#pragma unroll
        for (int qq = 0; qq < 4; ++qq) { const int i = m * 16 + fq * 4 + qq, si = dirw ? 63 - i : i; const bool keep = sj < si;
          const float v = keep ? L.beta[dirw][i] * acc[m][0][qq] * __expf(L.cum[dirw][i] - cj) : 0.f;
          L.msb[dirw][si][sj] = f2bf(v);
          if ((si >> 4) == (sj >> 4)) L.md[dirw][si >> 4][sj & 15][si & 15] = v; } }
    __syncthreads();
    if (wv < 2) { const int dir = wv, d = lane >> 4, c = lane & 15;
      float x[16];
#pragma unroll
      for (int s = 0; s < 16; ++s) x[s] = s == c ? 1.f : 0.f;
#pragma unroll
      for (int t = 0; t < 15; ++t) { const float xt = x[t];
#pragma unroll
        for (int s = t + 1; s < 16; ++s) x[s] -= L.md[dir][d][t][s] * xt; }
#pragma unroll
      for (int s = 0; s < 16; ++s) L.td[dir][d][s][c] = f2bf(x[s]); }
    __syncthreads();
    { bf16_t* xb = s4 < 2 ? &L.ut[dirw][s4 * 32][0] : &L.wq[dirw][(s4 - 2) * 32][0];
      const bf16_t (*src)[72] = s4 < 2 ? L.v : L.k; const int cb = (s4 & 1) * 32;
#pragma unroll
      for (int I = 0; I < 4; ++I) {
        f32x4 acc[1][2];
#pragma unroll
        for (int nt = 0; nt < 2; ++nt)
#pragma unroll
          for (int qq = 0; qq < 4; ++qq) { const int s = I * 16 + fq * 4 + qq, f = dirw ? 63 - s : s; const float sc = s4 < 2 ? L.beta[dirw][f] : L.beta[dirw][f] * __expf(L.cum[dirw][f]);
            acc[0][nt][qq] = sc * bf2f(src[f][cb + nt * 16 + fr]); }
        if (I > 0) { f32x4 pr[1][2] = {{{0.f, 0.f, 0.f, 0.f}, {0.f, 0.f, 0.f, 0.f}}};
          wmm<1, 2, 2, 72, 72>(pr, &L.msb[dirw][I * 16][0], xb, fr, fq);
#pragma unroll
          for (int nt = 0; nt < 2; ++nt) acc[0][nt] -= pr[0][nt]; }
#pragma unroll
        for (int nt = 0; nt < 2; ++nt) { uint2 pk; pk.x = pack2(acc[0][nt][0], acc[0][nt][1]); pk.y = pack2(acc[0][nt][2], acc[0][nt][3]); *(uint2*)&L.tmp[wv][nt * 16 + fr][fq * 4] = pk; }
        asm volatile("" ::: "memory");
        f32x4 xs[1][2] = {{{0.f, 0.f, 0.f, 0.f}, {0.f, 0.f, 0.f, 0.f}}};
        wmm<1, 2, 1, 40, 40>(xs, &L.td[dirw][I][0][0], &L.tmp[wv][0][0], fr, fq);
#pragma unroll
        for (int nt = 0; nt < 2; ++nt) { uint2 pk; pk.x = pack2(xs[0][nt][0], xs[0][nt][1]); pk.y = pack2(xs[0][nt][2], xs[0][nt][3]); *(uint2*)(xb + (nt * 16 + fr) * 72 + I * 16 + fq * 4) = pk; }
        asm volatile("" ::: "memory");
      } }
    if (PASS == 0) {
      for (int i = tid; i < 2 * 64 * 16; i += NT) { int d = i & 63, f0 = ((i >> 6) & 15) * 4, dir = i >> 10; float v[4];
#pragma unroll
        for (int qq = 0; qq < 4; ++qq) v[qq] = bf2f(L.k[f0 + qq][d]) * __expf(L.tot[dir] - L.cum[dir][f0 + qq]);
        uint2 pk;
        if (dir == 0) { pk.x = pack2(v[0], v[1]); pk.y = pack2(v[2], v[3]); *(uint2*)&L.a1[0][d][f0] = pk; }
        else { pk.x = pack2(v[3], v[2]); pk.y = pack2(v[1], v[0]); *(uint2*)&L.a1[1][d][60 - f0] = pk; } }
      __syncthreads();
      const int seq = (b * 4 + h) * 2 + dirw, nsc = scan_idx(cpos, dirw); const float dec = __expf(L.tot[dirw]);
      { f32x4 acc[4][1];
#pragma unroll
        for (int m = 0; m < 4; ++m) acc[m][0] = (f32x4){0.f, 0.f, 0.f, 0.f};
        wmm<4, 1, 2, 72, 72>(acc, &L.wq[dirw][0][0], &L.a1[dirw][s4 * 16][0], fr, fq);
        const int d = s4 * 16 + fr; bf16_t* dst = p.dn_m + ((size_t)seq * NCH + nsc) * 4096 + d * 64;
#pragma unroll
        for (int m = 0; m < 4; ++m) { float v[4];
#pragma unroll
          for (int qq = 0; qq < 4; ++qq) { int d2 = m * 16 + fq * 4 + qq; v[qq] = (d2 == d ? dec : 0.f) - acc[m][0][qq]; }
          uint2 pk; pk.x = pack2(v[0], v[1]); pk.y = pack2(v[2], v[3]); *(uint2*)(dst + m * 16 + fq * 4) = pk; } }
      { f32x4 acc[4][1];
#pragma unroll
        for (int m = 0; m < 4; ++m) acc[m][0] = (f32x4){0.f, 0.f, 0.f, 0.f};
        wmm<4, 1, 2, 72, 72>(acc, &L.a1[dirw][0][0], &L.ut[dirw][s4 * 16][0], fr, fq);
        bf16_t* dst = p.dn_l + ((size_t)seq * NCH + nsc) * 4096 + (s4 * 16 + fr) * 64;
#pragma unroll
        for (int m = 0; m < 4; ++m) { uint2 pk; pk.x = pack2(acc[m][0][0], acc[m][0][1]); pk.y = pack2(acc[m][0][2], acc[m][0][3]); *(uint2*)(dst + m * 16 + fq * 4) = pk; } }
    } else {
      __syncthreads();
      for (int i = tid; i < 2 * 64 * 16; i += NT) { int d = i & 63, s0 = ((i >> 6) & 15) * 4, dir = i >> 10; const uint2 wv2 = *(const uint2*)&L.wq[dir][d][s0];
        L.a1[dir][s0][d] = (bf16_t)(wv2.x & 0xffff); L.a1[dir][s0 + 1][d] = (bf16_t)(wv2.x >> 16); L.a1[dir][s0 + 2][d] = (bf16_t)(wv2.y & 0xffff); L.a1[dir][s0 + 3][d] = (bf16_t)(wv2.y >> 16); }
      __syncthreads();
      { f32x4 acc[4][1];
#pragma unroll
        for (int m = 0; m < 4; ++m) acc[m][0] = (f32x4){0.f, 0.f, 0.f, 0.f};
#pragma unroll
        for (int ks = 0; ks < 2; ++ks)
#pragma unroll
          for (int m = 0; m < 4; ++m) { bf16x8 a = *(const bf16x8*)&L.a1[dirw][m * 16 + fr][ks * 32 + fq * 8]; acc[m][0] = __builtin_amdgcn_mfma_f32_16x16x32_bf16(a, sfr[ks], acc[m][0], 0, 0, 0); }
        const int c = s4 * 16 + fr;
#pragma unroll
        for (int m = 0; m < 4; ++m) { uint2 uu = *(const uint2*)&L.ut[dirw][c][m * 16 + fq * 4];
          float v0 = bf2f((bf16_t)(uu.x & 0xffff)) - acc[m][0][0], v1 = bf2f((bf16_t)(uu.x >> 16)) - acc[m][0][1], v2 = bf2f((bf16_t)(uu.y & 0xffff)) - acc[m][0][2], v3 = bf2f((bf16_t)(uu.y >> 16)) - acc[m][0][3];
          uint2 pk; pk.x = pack2(v0, v1); pk.y = pack2(v2, v3); *(uint2*)&L.ut[dirw][c][m * 16 + fq * 4] = pk; } }
      { f32x4 acc[4][1];
#pragma unroll
        for (int m = 0; m < 4; ++m) acc[m][0] = (f32x4){0.f, 0.f, 0.f, 0.f};
        wmm<4, 1, 2, 72, 72>(acc, &L.k[0][0], &L.q[s4 * 16][0], fr, fq);
        const int i = s4 * 16 + fr; const float ci = L.cum[dirw][i];
#pragma unroll
        for (int m = 0; m < 4; ++m) { float v[4];
#pragma unroll
          for (int qq = 0; qq < 4; ++qq) { int j = m * 16 + fq * 4 + qq; bool keep = dirw == 0 ? (j <= i) : (j >= i); v[qq] = keep ? acc[m][0][qq] * __expf(ci - L.cum[dirw][j]) : 0.f; }
          uint2 pk;
          if (dirw == 0) { pk.x = pack2(v[0], v[1]); pk.y = pack2(v[2], v[3]); *(uint2*)&L.wq[0][i][m * 16 + fq * 4] = pk; }
          else { pk.x = pack2(v[3], v[2]); pk.y = pack2(v[1], v[0]); *(uint2*)&L.wq[1][i][60 - m * 16 - fq * 4] = pk; } } }
      __syncthreads();
      f32x4 ao[1][4];
#pragma unroll
      for (int n = 0; n < 4; ++n) ao[0][n] = (f32x4){0.f, 0.f, 0.f, 0.f};
#pragma unroll
      for (int ks = 0; ks < 2; ++ks) { bf16x8 a = *(const bf16x8*)&L.q[s4 * 16 + fr][ks * 32 + fq * 8];
#pragma unroll
        for (int n = 0; n < 4; ++n) ao[0][n] = __builtin_amdgcn_mfma_f32_16x16x32_bf16(a, sfo[ks][n], ao[0][n], 0, 0, 0); }
#pragma unroll
      for (int qq = 0; qq < 4; ++qq) { const float e = __expf(L.cum[dirw][s4 * 16 + fq * 4 + qq]);
#pragma unroll
        for (int n = 0; n < 4; ++n) ao[0][n][qq] *= e; }
      wmm<1, 4, 2, 72, 72>(ao, &L.wq[dirw][s4 * 16][0], &L.ut[dirw][0][0], fr, fq);
      if (dirw == 1) {
#pragma unroll
        for (int n = 0; n < 4; ++n)
#pragma unroll
          for (int qq = 0; qq < 4; ++qq) L.ox[s4 * 16 + fq * 4 + qq][n * 16 + fr] = ao[0][n][qq]; }
      __syncthreads();
      if (dirw == 0) {
        float ss[4] = {0.f, 0.f, 0.f, 0.f};
#pragma unroll
        for (int n = 0; n < 4; ++n)
#pragma unroll
          for (int qq = 0; qq < 4; ++qq) { ao[0][n][qq] += L.ox[s4 * 16 + fq * 4 + qq][n * 16 + fr]; ss[qq] += ao[0][n][qq] * ao[0][n][qq]; }
#pragma unroll
        for (int qq = 0; qq < 4; ++qq) {
#pragma unroll
          for (int o = 1; o < 16; o <<= 1) ss[qq] += __shfl_xor(ss[qq], o);
          ss[qq] = rsqrtf(ss[qq] * (1.f / 64.f) + 1e-6f); }
#pragma unroll
        for (int n = 0; n < 4; ++n) { const int c = h * 64 + n * 16 + fr; const float nw = p.dn_norm[layer * 256 + c];
#pragma unroll
          for (int qq = 0; qq < 4; ++qq) { const int f = s4 * 16 + fq * 4 + qq;
            p.y[(size_t)(row0 + f) * D + 768 + c] = f2bf(ao[0][n][qq] * ss[qq] * nw * siluf(ogv[n][qq])); } }
      }
    }
    __syncthreads();
  }
}
struct DnBLds { bf16_t sh[2][64][72]; bf16_t sl[2][64][72]; };
__device__ __forceinline__ void phase_dn_state(CParams& p, int bid, int nb, int tid_, char* smem) {
  DnBLds& L = *(DnBLds*)smem;
  const int tid = tid_, lane = tid & 63, wv = tid >> 6, fr = lane & 15, fq = lane >> 4, mt = wv >> 1, ntb = (wv & 1) * 2;
  for (int seq = bid; seq < 32; seq += nb) {
    for (int i = tid; i < 64 * 72 / 2; i += NT) { ((unsigned*)&L.sh[0][0][0])[i] = 0u; ((unsigned*)&L.sl[0][0][0])[i] = 0u; }
    __syncthreads();
    f32x4 S[2] = {{0.f, 0.f, 0.f, 0.f}, {0.f, 0.f, 0.f, 0.f}};
    const bf16_t* mb = p.dn_m + (size_t)seq * NCH * 4096 + (mt * 16 + fr) * 64 + fq * 8;
    bf16x8 a[2]; a[0] = *(const bf16x8*)mb; a[1] = *(const bf16x8*)(mb + 32);
    uint2* lbase[2]; uint2 lvn[2];
#pragma unroll
    for (int t = 0; t < 2; ++t) { lbase[t] = (uint2*)(p.dn_l + (size_t)seq * NCH * 4096 + ((ntb + t) * 16 + fr) * 64 + mt * 16 + fq * 4); lvn[t] = *lbase[t]; }
    for (int n = 0; n < NCH; ++n) {
      const int cur = n & 1;
      f32x4 acc[2];
#pragma unroll
      for (int t = 0; t < 2; ++t) { uint2* lp = lbase[t] + (size_t)n * 1024;
        const uint2 lv = lvn[t]; uint2 sv; sv.x = pack2(S[t][0], S[t][1]); sv.y = pack2(S[t][2], S[t][3]); *lp = sv;
        acc[t] = (f32x4){bf2f((bf16_t)(lv.x & 0xffff)), bf2f((bf16_t)(lv.x >> 16)), bf2f((bf16_t)(lv.y & 0xffff)), bf2f((bf16_t)(lv.y >> 16))}; }
      bf16x8 an[2] = {a[0], a[1]};
      if (n + 1 < NCH) { an[0] = *(const bf16x8*)(mb + (size_t)(n + 1) * 4096); an[1] = *(const bf16x8*)(mb + (size_t)(n + 1) * 4096 + 32);
#pragma unroll
        for (int t = 0; t < 2; ++t) lvn[t] = *(lbase[t] + (size_t)(n + 1) * 1024); }
#pragma unroll
      for (int ks = 0; ks < 2; ++ks)
#pragma unroll
        for (int t = 0; t < 2; ++t) { bf16x8 bh = *(const bf16x8*)&L.sh[cur][(ntb + t) * 16 + fr][ks * 32 + fq * 8], bl = *(const bf16x8*)&L.sl[cur][(ntb + t) * 16 + fr][ks * 32 + fq * 8];
          acc[t] = __builtin_amdgcn_mfma_f32_16x16x32_bf16(a[ks], bh, acc[t], 0, 0, 0); acc[t] = __builtin_amdgcn_mfma_f32_16x16x32_bf16(a[ks], bl, acc[t], 0, 0, 0); }
#pragma unroll
      for (int t = 0; t < 2; ++t) { S[t] = acc[t]; float hi[4], lo[4];
#pragma unroll
        for (int q = 0; q < 4; ++q) { hi[q] = bf2f(f2bf(acc[t][q])); lo[q] = acc[t][q] - hi[q]; }
        uint2 ph, pl; ph.x = pack2(hi[0], hi[1]); ph.y = pack2(hi[2], hi[3]); pl.x = pack2(lo[0], lo[1]); pl.y = pack2(lo[2], lo[3]);
        *(uint2*)&L.sh[cur ^ 1][(ntb + t) * 16 + fr][mt * 16 + fq * 4] = ph; *(uint2*)&L.sl[cur ^ 1][(ntb + t) * 16 + fr][mt * 16 + fq * 4] = pl; }
      a[0] = an[0]; a[1] = an[1];
      asm volatile("s_waitcnt lgkmcnt(0)" ::: "memory"); __builtin_amdgcn_s_barrier();
    }
    __syncthreads();
  }
}

__device__ __forceinline__ void row_router(CParams& p, const float4* rts, const float (&hv)[16], int lane, int row) {
  float lg[16];
#pragma unroll
  for (int e = 0; e < 16; ++e) lg[e] = 0.f;
#pragma unroll
  for (int i = 0; i < 4; ++i)
#pragma unroll
    for (int j = 0; j < 4; ++j) { float hvv = hv[i * 4 + j];
#pragma unroll
      for (int q = 0; q < 4; ++q) { float4 r4 = rts[((i * 4 + j) * 4 + q) * 64 + lane]; lg[q * 4] += hvv * r4.x; lg[q * 4 + 1] += hvv * r4.y; lg[q * 4 + 2] += hvv * r4.z; lg[q * 4 + 3] += hvv * r4.w; }
      if (j & 1) asm volatile("" ::: "memory"); }
  float mx = -1e30f;
#pragma unroll
  for (int e = 0; e < 16; ++e) { lg[e] = wave_sum(lg[e]); mx = fmaxf(mx, lg[e]); }
  float den = 0.f;
#pragma unroll
  for (int e = 0; e < 16; ++e) { lg[e] = expf(lg[e] - mx); den += lg[e]; }
  float inv = 1.f / den;
  if (lane < 16) { float v = 0.f;
#pragma unroll
    for (int e = 0; e < 16; ++e) v = lane == e ? lg[e] * inv : v;
    p.aff[(size_t)row * 16 + lane] = v; }
}
__device__ __forceinline__ void phase_postmix(CParams& p, int layer, int bid, int nb, int tid_, char* smem) {
  const int lane = tid_ & 63, wv = tid_ >> 6;
  float4* rts = (float4*)smem;
  for (int x = tid_; x < D * 4; x += NT) { const int ln = x & 63, q = (x >> 6) & 3, ij = x >> 8, k = (ij >> 2) * 256 + ln * 4 + (ij & 3); rts[x] = *(const float4*)(p.moe_router + ((size_t)layer * D + k) * 16 + q * 4); }
  __syncthreads();
  const int nrows = layer == 0 ? TT : TL, stride = nb * NW;
  const float* ng1 = p.norm_g + (size_t)layer * 4 * D + 1 * D;
  for (int row0 = bid * NW + wv; row0 < nrows; row0 += 2 * stride) {
    int rows[2] = {row0, row0 + stride}; const bool val1 = rows[1] < nrows; if (!val1) rows[1] = row0;
    uint2 yr[2][4]; float4 xr[2][4];
#pragma unroll
    for (int r = 0; r < 2; ++r) { const int row = rows[r];
      const float* xsrc = layer == 0 ? (row < TL ? p.x + (size_t)row * D : p.ctx + (size_t)(row - TL) * D) : xrow_ptr(p, row);
#pragma unroll
      for (int i = 0; i < 4; ++i) { yr[r][i] = *(const uint2*)(p.yo + (size_t)row * D + i * 256 + lane * 4); xr[r][i] = *(const float4*)(xsrc + i * 256 + lane * 4); } }
#pragma unroll
    for (int r = 0; r < 2; ++r) { if (r == 1 && !val1) break;
      const int row = rows[r]; float* xs = xrow_ptr(p, row);
      const float* m = p.mod + (size_t)(layer * 5 + mod_idx(row)) * 6 * D;
      float yv[16], xv[16], hv[16]; float ss = 0.f;
#pragma unroll
      for (int i = 0; i < 4; ++i) { const uint2 v = yr[r][i]; yv[i * 4] = __uint_as_float(v.x << 16); yv[i * 4 + 1] = __uint_as_float(v.x & 0xffff0000u); yv[i * 4 + 2] = __uint_as_float(v.y << 16); yv[i * 4 + 3] = __uint_as_float(v.y & 0xffff0000u); }
#pragma unroll
      for (int i = 0; i < 16; ++i) ss += yv[i] * yv[i];
      ss = wave_sum(ss);
      const float rstd = rsqrtf(ss * (1.f / D) + 1e-6f);
#pragma unroll
      for (int i = 0; i < 4; ++i) { const int k = i * 256 + lane * 4; const float4 xo = xr[r][i]; const float4 gg = *(const float4*)(ng1 + k); const float4 g1 = *(const float4*)(m + 2 * D + k);
        xv[i * 4] = xo.x + g1.x * yv[i * 4] * rstd * gg.x; xv[i * 4 + 1] = xo.y + g1.y * yv[i * 4 + 1] * rstd * gg.y; xv[i * 4 + 2] = xo.z + g1.z * yv[i * 4 + 2] * rstd * gg.z; xv[i * 4 + 3] = xo.w + g1.w * yv[i * 4 + 3] * rstd * gg.w;
        *(float4*)(xs + k) = make_float4(xv[i * 4], xv[i * 4 + 1], xv[i * 4 + 2], xv[i * 4 + 3]); }
      row_modulate_store(xv, p.norm_g + (size_t)layer * 4 * D + 2 * D, m + 3 * D, m + 4 * D, p.hb + (size_t)row * D, lane, hv);
      row_router(p, rts, hv, lane, row);
    }
  }
}
struct TkLds { unsigned key[SEQ]; unsigned hist[NW][256]; unsigned part[NT]; unsigned sh[4]; };
__device__ __forceinline__ void phase_topk(CParams& p, int layer, int bid, int nb, int tid_, char* smem) {
  TkLds& L = *(TkLds*)smem;
  if (layer == 0) for (int i = bid * NT + tid_; i < NE * 128; i += nb * NT) { const int sl = (i >> 7) * SLOTS_E + NB * CAP_L + NB * CAP_C + (i & 127); p.slot_tok[sl] = 0; p.slot_w[sl] = 0.f; }
  const int nlat = NB * NE, nctx = layer == 0 ? NB * NE : 0;
  for (int task = bid; task < nlat + nctx; task += nb) {
    int tid = tid_; asm volatile("" : "+v"(tid));
    int b, e, n, cap, rbase, sbase;
    if (task < nlat) { b = task / NE; e = task % NE; n = SEQ; cap = CAP_L; rbase = b * SEQ; sbase = e * SLOTS_E + b * CAP_L; }
    else { int j = task - nlat; b = j / NE; e = j % NE; n = CTX; cap = CAP_C; rbase = TL + b * CTX; sbase = e * SLOTS_E + NB * CAP_L + b * CAP_C; }
    __syncthreads();
#pragma unroll 16
    for (int s2 = tid; s2 < n; s2 += NT) L.key[s2] = __float_as_uint(p.aff[(size_t)(rbase + s2) * 16 + e]);
    unsigned prefix = 0u, remaining = (unsigned)cap;
#pragma unroll 1
    for (int pass = 0; pass < 4; ++pass) {
      const int shift = 24 - 8 * pass;
      for (int i = tid; i < NW * 256; i += NT) (&L.hist[0][0])[i] = 0u;
      __syncthreads();
      for (int s2 = tid; s2 < n; s2 += NT) { const unsigned k = L.key[s2]; if (pass == 0 || (k >> (shift + 8)) == (prefix >> (shift + 8))) atomicAdd(&L.hist[tid >> 6][(k >> shift) & 255u], 1u); }
      __syncthreads();
      if (tid < 256) { unsigned t = 0u;
#pragma unroll
        for (int w = 0; w < NW; ++w) t += L.hist[w][tid];
        L.hist[0][tid] = t; }
      __syncthreads();
      if (tid < 64) {
        unsigned c4[4]; unsigned loc = 0u;
#pragma unroll
        for (int e = 0; e < 4; ++e) { c4[e] = L.hist[0][255 - 4 * tid - e]; loc += c4[e]; }
        unsigned inc = loc;
#pragma unroll
        for (int o = 1; o < 64; o <<= 1) { const unsigned t = __shfl_up(inc, o); if (tid >= o) inc += t; }
        unsigned cum = inc - loc;
        const bool hit = inc >= remaining;
        const unsigned long long mk = __ballot(hit);
        const int first = mk ? __builtin_ctzll(mk) : 63;
        if (tid == first) { int e = 0;
#pragma unroll
          for (; e < 3; ++e) { if (cum + c4[e] >= remaining) break; cum += c4[e]; }
          const int d = 255 - 4 * tid - e; L.sh[0] = prefix | ((unsigned)d << shift); L.sh[1] = remaining - cum; } }
      __syncthreads();
      prefix = L.sh[0]; remaining = L.sh[1];
    }
    const int per = n / NT > 0 ? n / NT : 1, t0 = tid * per;
    unsigned cg = 0u, ce = 0u;
    if (t0 < n) for (int q = 0; q < per; ++q) { const unsigned k = L.key[t0 + q]; cg += k > prefix ? 1u : 0u; ce += k == prefix ? 1u : 0u; }
    L.part[tid] = cg | (ce << 16);
    __syncthreads();
    unsigned og = 0u, oe = 0u;
    for (int j = 0; j < NT; ++j) { const unsigned v = L.part[j]; if (j < tid) { og += v & 0xffffu; oe += v >> 16; } }
    if (t0 < n) for (int q = 0; q < per; ++q) {
      const unsigned k = L.key[t0 + q]; const int row = rbase + t0 + q;
      const bool sel = k > prefix || (k == prefix && oe < remaining);
      if (sel) { const int slot = sbase + (int)(og + (oe < remaining ? oe : remaining)); p.slot_tok[slot] = row; p.slot_w[slot] = __uint_as_float(k); p.tok_slot[(size_t)row * 16 + e] = slot; }
      else p.tok_slot[(size_t)row * 16 + e] = -1;
      og += k > prefix ? 1u : 0u; oe += k == prefix ? 1u : 0u;
    }
    __syncthreads();
  }
}
__device__ __forceinline__ void phase_combine(CParams& p, int layer, int bid, int nb, int tid_) {
  const int lane = tid_ & 63, wv = tid_ >> 6;
  const int nrows = layer == 0 ? TT : TL, stride = nb * NW;
  const float* ng3 = p.norm_g + (size_t)layer * 4 * D + 3 * D;
  for (int row0 = bid * NW + wv; row0 < nrows; row0 += 2 * stride) {
    int rows[2] = {row0, row0 + stride}; const bool val1 = rows[1] < nrows; if (!val1) rows[1] = row0;
    int sk[2][4]; unsigned long long rest[2]; int slotv[2];
#pragma unroll
    for (int r = 0; r < 2; ++r) { slotv[r] = lane < 16 ? p.tok_slot[(size_t)rows[r] * 16 + lane] : -1; }
#pragma unroll
    for (int r = 0; r < 2; ++r) { unsigned long long mk = __ballot(slotv[r] >= 0);
#pragma unroll
      for (int k = 0; k < 4; ++k) { if (mk) { const int bit = __builtin_ctzll(mk); sk[r][k] = __builtin_amdgcn_readlane(slotv[r], bit); mk &= mk - 1; } else sk[r][k] = -1; }
      rest[r] = mk; }
    uint2 pk[2][4][4]; float4 xr[2][4];
#pragma unroll
    for (int r = 0; r < 2; ++r) { const float* xs = xrow_ptr(p, rows[r]);
#pragma unroll
      for (int i = 0; i < 4; ++i) xr[r][i] = *(const float4*)(xs + i * 256 + lane * 4);
#pragma unroll
      for (int k = 0; k < 4; ++k) { const int sl = sk[r][k] >= 0 ? sk[r][k] : 0;
#pragma unroll
        for (int i = 0; i < 4; ++i) pk[r][k][i] = *(const uint2*)(p.ymoe + (size_t)sl * D + i * 256 + lane * 4); } }
#pragma unroll
    for (int r = 0; r < 2; ++r) { if (r == 1 && !val1) break;
      const int row = rows[r]; float* xs = xrow_ptr(p, row);
      float mv[16];
#pragma unroll
      for (int i = 0; i < 16; ++i) mv[i] = 0.f;
#pragma unroll
      for (int k = 0; k < 4; ++k) { const float wk = sk[r][k] >= 0 ? 1.f : 0.f;
#pragma unroll
        for (int i = 0; i < 4; ++i) { const uint2 q = pk[r][k][i];
          mv[i * 4] += wk * __uint_as_float(q.x << 16); mv[i * 4 + 1] += wk * __uint_as_float(q.x & 0xffff0000u); mv[i * 4 + 2] += wk * __uint_as_float(q.y << 16); mv[i * 4 + 3] += wk * __uint_as_float(q.y & 0xffff0000u); } }
      for (unsigned long long mk = rest[r]; mk; mk &= mk - 1) { const int slot = __builtin_amdgcn_readlane(slotv[r], __builtin_ctzll(mk));
#pragma unroll
        for (int i = 0; i < 4; ++i) { const uint2 q = *(const uint2*)(p.ymoe + (size_t)slot * D + i * 256 + lane * 4);
          mv[i * 4] += __uint_as_float(q.x << 16); mv[i * 4 + 1] += __uint_as_float(q.x & 0xffff0000u); mv[i * 4 + 2] += __uint_as_float(q.y << 16); mv[i * 4 + 3] += __uint_as_float(q.y & 0xffff0000u); } }
      float ss = 0.f;
#pragma unroll
      for (int i = 0; i < 16; ++i) ss += mv[i] * mv[i];
      ss = wave_sum(ss);
      const float rstd = rsqrtf(ss * (1.f / D) + 1e-6f);
      const float* m = p.mod + (size_t)(layer * 5 + mod_idx(row)) * 6 * D;
      float xv[16], hv[16];
#pragma unroll
      for (int i = 0; i < 4; ++i) { const int k = i * 256 + lane * 4; const float4 xo = xr[r][i]; const float4 gg = *(const float4*)(ng3 + k); const float4 g2 = *(const float4*)(m + 5 * D + k);
        xv[i * 4] = xo.x + g2.x * mv[i * 4] * rstd * gg.x; xv[i * 4 + 1] = xo.y + g2.y * mv[i * 4 + 1] * rstd * gg.y; xv[i * 4 + 2] = xo.z + g2.z * mv[i * 4 + 2] * rstd * gg.z; xv[i * 4 + 3] = xo.w + g2.w * mv[i * 4 + 3] * rstd * gg.w;
        *(float4*)(xs + k) = make_float4(xv[i * 4], xv[i * 4 + 1], xv[i * 4 + 2], xv[i * 4 + 3]); }
      if (layer + 1 < DEPTH) {
        const float* m2 = p.mod + (size_t)((layer + 1) * 5 + mod_idx(row)) * 6 * D;
        row_modulate_store(xv, p.norm_g + (size_t)(layer + 1) * 4 * D, m2, m2 + D, p.hb + (size_t)row * D, lane, hv);
      }
    }
  }
}

#define XB_TMO      128
#define XB_XCNT(j)  (256  + 64 * (j))
#define XB_XSUB(j)  (1280 + 64 * (j))
#define XB_XGEN(j)  (2304 + 64 * (j))
#define XB_TOP      3328
#define XB_TOPGEN   3392
#define XCD_BAR_WORDS 3456
#define XB_SPIN_CAP (1u << 22)
__device__ __forceinline__ unsigned xb_ld(unsigned* q)              { return __hip_atomic_load(q, __ATOMIC_RELAXED, __HIP_MEMORY_SCOPE_AGENT); }
__device__ __forceinline__ unsigned xb_add(unsigned* q, unsigned v) { return __hip_atomic_fetch_add(q, v, __ATOMIC_RELAXED, __HIP_MEMORY_SCOPE_AGENT); }
__device__ __forceinline__ unsigned xb_xcc_id() { return (unsigned)__builtin_amdgcn_s_getreg((3 << 11) | 20) & 0xFu; }
#define XB_SPIN(cond, bar) do { unsigned _sp = 0; while (cond) { __builtin_amdgcn_s_sleep(1); \
    if ((++_sp & 255u) == 0u) { if (xb_ld(&(bar)[XB_TMO])) break; if (_sp > XB_SPIN_CAP) { atomicAdd(&(bar)[XB_TMO], 1u); break; } } } } while (0)
struct XcdBarrier { unsigned* bar; unsigned x; volatile LAS unsigned* st; };
__device__ __forceinline__ XcdBarrier xcd_barrier_post(unsigned* bar, volatile LAS unsigned* st) {
  XcdBarrier b; b.bar = bar; b.x = xb_xcc_id(); b.st = st;
  if (threadIdx.x == 0) (void)xb_add(&bar[XB_XCNT(b.x)], 1u);
  return b;
}
__device__ __forceinline__ void xcd_barrier_complete(unsigned* bar, unsigned x, unsigned& nloc, unsigned& nx) {
  const unsigned G = gridDim.x * gridDim.y * gridDim.z;
  unsigned sum, cnt, mine, sp = 0u;
  for (;;) {
    sum = 0u; cnt = 0u; mine = 0u;
#pragma unroll
    for (unsigned j = 0; j < 16; ++j) { const unsigned c = xb_ld(&bar[XB_XCNT(j)]); sum += c; cnt += (c > 0u) ? 1u : 0u; mine = (j == x) ? c : mine; }
    if (sum == G) break;
    __builtin_amdgcn_s_sleep(1);
    if ((++sp & 255u) == 0u) { if (xb_ld(&bar[XB_TMO])) break; if (sp > XB_SPIN_CAP) { atomicAdd(&bar[XB_TMO], 1u); break; } }
  }
  nloc = mine > 0u ? mine : 1u; nx = cnt > 0u ? cnt : 1u;
}
__device__ __forceinline__ void xcd_barrier(const XcdBarrier& b) {
  asm volatile("s_waitcnt vmcnt(0)" ::: "memory");
  __syncthreads();
  if (threadIdx.x == 0) {
    unsigned* bar = b.bar;
    __builtin_amdgcn_s_waitcnt(0);
    unsigned nloc = b.st[0], nx = b.st[1];
    if (nloc == 0u) { xcd_barrier_complete(bar, b.x, nloc, nx); b.st[0] = nloc; b.st[1] = nx; }
    const unsigned old = xb_add(&bar[XB_XSUB(b.x)], 1u);
    const unsigned gen = old / nloc;
    if (old + 1u == (gen + 1u) * nloc) {
      __builtin_amdgcn_fence(__ATOMIC_RELEASE, "agent");
      asm volatile("s_waitcnt vmcnt(0)" ::: "memory");
      const unsigned og = xb_add(&bar[XB_TOP], 1u);
      const unsigned tg = og / nx;
      if (og + 1u == (tg + 1u) * nx) xb_add(&bar[XB_TOPGEN], 1u);
      else XB_SPIN(xb_ld(&bar[XB_TOPGEN]) == tg, bar);
      __builtin_amdgcn_fence(__ATOMIC_ACQUIRE, "agent");
      xb_add(&bar[XB_XGEN(b.x)], 1u);
      asm volatile("s_waitcnt vmcnt(0)" ::: "memory");
    } else {
      XB_SPIN(xb_ld(&bar[XB_XGEN(b.x)]) == gen, bar);
      __builtin_amdgcn_fence(__ATOMIC_ACQUIRE, "agent");
      asm volatile("s_waitcnt vmcnt(0)" ::: "memory");
    }
  }
  __syncthreads();
}

namespace cg = cooperative_groups;
constexpr int LDS_BYTES = 163840 - 16;
static_assert(sizeof(GlaLds) <= LDS_BYTES && sizeof(MbLds) <= LDS_BYTES && sizeof(DnLds) <= LDS_BYTES && sizeof(FftLds) <= LDS_BYTES, "lds");
__global__ void __launch_bounds__(NT) mega(Params p_unused) {
  extern __shared__ __attribute__((aligned(16))) char smem[];
  cg::grid_group grid = cg::this_grid();
  int bid_s = blockIdx.x, nb_s = gridDim.x, tid_v = threadIdx.x;
  const __attribute__((address_space(4))) char* kb = (const __attribute__((address_space(4))) char*)__builtin_amdgcn_kernarg_segment_ptr();
#define p (*(CParams*)({ asm volatile("" : "+s"(kb)); kb; }))
#define BID ({ asm volatile("" : "+s"(bid_s)); bid_s; })
#define NBK ({ asm volatile("" : "+s"(nb_s)); nb_s; })
#define TID ({ asm volatile("" : "+v"(tid_v)); tid_v; })
#define LAYER ({ int l_ = l; asm volatile("" : "+s"(l_)); l_; })
#define GSYNC() do { XcdBarrier xb_; xb_.bar = p.bar; xb_.x = xb_xcc_id(); xb_.st = (volatile LAS unsigned*)(smem + LDS_BYTES); xcd_barrier(xb_); } while (0)
  volatile LAS unsigned* xst = (volatile LAS unsigned*)(smem + LDS_BYTES);
  if (threadIdx.x < 4) xst[threadIdx.x] = 0u;
  __syncthreads();
  (void)xcd_barrier_post(p.bar, xst);
  phase_conv_small(p, BID, NBK, TID, smem);
  phase_mod(p, BID, NBK, TID, smem);
  grid.sync();
  phase_prenorm0(p, BID, NBK, TID);
  GSYNC();
  for (int l = 0; l < DEPTH; ++l) {
    phase_gemm_in(p, LAYER, BID, NBK, TID, smem); GSYNC();
    phase_hy_prep(p, LAYER, BID, NBK, TID);
    phase_hy_prep_t(p, LAYER, BID, NBK, TID, smem);
    phase_hy_filt<true>(p, LAYER, SEQ, p.filt, BID, NBK, TID, smem);
    if (l == 0) phase_hy_filt<false>(p, LAYER, CTX, p.filtc, BID, NBK, TID, smem);
    GSYNC();
    phase_hy_fft(p, LAYER, BID, NBK, TID, smem);
    if (l == 0) phase_hy_conv(p, LAYER, 0, true, BID, NBK, TID);
    GSYNC();
    phase_hy_fin(p, BID, NBK, TID, smem);
    if (l == 0) phase_hy_conv(p, LAYER, 1, true, BID, NBK, TID);
    GSYNC();
    phase_mb_prep(p, LAYER, BID, NBK, TID); GSYNC();
    phase_mb_chunk<0>(p, LAYER, BID, NBK, TID, smem); GSYNC();
    phase_mb_state(p, BID, NBK, TID); GSYNC();
    phase_mb_chunk<1>(p, LAYER, BID, NBK, TID, smem); GSYNC();
    phase_dn_prep(p, LAYER, BID, NBK, TID);
    phase_gla_chunk<0>(p, LAYER, BID, NBK, TID, smem); GSYNC();
    phase_dn_chunk<0>(p, LAYER, BID, NBK, TID, smem);
    phase_gla_state(p, BID, NBK, TID); GSYNC();
    { const int b_ = BID, n_ = NBK;
      if (b_ < 32) phase_dn_state(p, b_, 32, TID, smem); else phase_gla_chunk<1>(p, LAYER, b_ - 32, n_ - 32, TID, smem); }
    GSYNC();
    phase_dn_chunk<1>(p, LAYER, BID, NBK, TID, smem); GSYNC();
    phase_gemm_out(p, LAYER, BID, NBK, TID, smem); GSYNC();
    phase_postmix(p, LAYER, BID, NBK, TID, smem); GSYNC();
    phase_topk(p, LAYER, BID, NBK, TID, smem);
    phase_conv_moe(p, LAYER, BID, NBK, TID, smem);
    GSYNC();
    phase_gemm_moe1(p, LAYER, BID, NBK, TID, smem); GSYNC();
    phase_gemm_moe2(p, LAYER, BID, NBK, TID, smem); GSYNC();
    phase_combine(p, LAYER, BID, NBK, TID);
    if (l + 1 < DEPTH) GSYNC();
  }
#undef p
}

extern "C" void kernel_launch(void* const* d_in, const int* in_sizes, int n_in, void* d_out, int out_size, void* d_ws, size_t ws_size, hipStream_t stream) {
  Params p{};
  const float** fp = (const float**)&p;
  for (int i = 0; i < 37; ++i) fp[i] = (const float*)d_in[i];
  p.out = (float*)d_out;
  char* ws = (char*)d_ws; size_t off = 0;
  auto alloc = [&](size_t bytes) { size_t o = off; off += (bytes + 255) & ~(size_t)255; return ws + o; };
  p.win_t = (bf16_t*)alloc((size_t)DEPTH * NUP * D * 2);
  p.wout_t = (bf16_t*)alloc((size_t)DEPTH * D * D * 2);
  p.mod = (float*)alloc((size_t)DEPTH * 5 * 6 * D * 4);
  p.xc = (float*)alloc((size_t)TC * D * 4);
  p.aff = (float*)alloc((size_t)TT * 16 * 4);
  p.slot_tok = (int*)alloc((size_t)NSLOT * 4);
  p.slot_w = (float*)alloc((size_t)NSLOT * 4);
  p.tok_slot = (int*)alloc((size_t)TT * 16 * 4);
  p.dt = (float*)alloc((size_t)TT * 8 * 4);
  p.bg = (float*)alloc((size_t)TT * 16 * 4);
  p.filt = (float*)alloc((size_t)SEQ * 1024 * 4);
  p.filtc = (float*)alloc((size_t)CTX * 1024 * 4);
  p.hb = (bf16_t*)alloc((size_t)TT * D * 2);
  p.prep = p.hb;
  char* R = alloc((size_t)NSLOT * D * 2 * 2);
  p.u = (bf16_t*)R; p.yo = (bf16_t*)R; p.act = (bf16_t*)R; p.ymoe = (bf16_t*)(R + (size_t)NSLOT * D * 2);
  p.y = (bf16_t*)alloc((size_t)TT * D * 2);
  char* W2 = alloc((size_t)NE * 3 * D * D * 2);
  p.wgu_t = (bf16_t*)W2; p.wdn_t = (bf16_t*)(W2 + (size_t)NE * 2 * D * D * 2);
  p.obuf = (float*)W2; p.zbuf = (float*)W2; p.yt = (float*)(W2 + (size_t)36 * 1024 * 1024);
  p.gla_l = (bf16_t*)(W2 + (size_t)72 * 1024 * 1024);
  p.gla_dec = (float*)alloc((size_t)32 * NCH * 32 * 4);
  p.bar = (unsigned*)alloc((size_t)XCD_BAR_WORDS * 4);
  p.specg = (float2*)alloc((size_t)256 * 16384 * 8);
  p.mb_l = (bf16_t*)W2;
  p.mb_dec = (float*)alloc((size_t)32 * NCH * 4);
  p.dn_m = (bf16_t*)W2; p.dn_l = (bf16_t*)(W2 + (size_t)32 * NCH * 4096 * 2);
  if (off > ws_size) { fprintf(stderr, "workspace too small: need %zu have %zu\n", off, ws_size); return; }

  static int grid_blocks = 0;
  if (!grid_blocks) {
    int dev = 0, cus = 0, per_cu = 0;
    hipGetDevice(&dev);
    hipDeviceGetAttribute(&cus, hipDeviceAttributeMultiprocessorCount, dev);
    hipFuncSetAttribute((const void*)mega, hipFuncAttributeMaxDynamicSharedMemorySize, LDS_BYTES + 16);
    hipOccupancyMaxActiveBlocksPerMultiprocessor(&per_cu, mega, NT, LDS_BYTES + 16);
    if (per_cu > 1) per_cu = 1;
    grid_blocks = cus * per_cu;
  }
  hipMemsetAsync(p.bar, 0, (size_t)XCD_BAR_WORDS * 4, stream);
  void* args[] = {&p};
  hipError_t e = hipLaunchCooperativeKernel((void*)mega, dim3(grid_blocks), dim3(NT), args, LDS_BYTES + 16, stream);
  if (e != hipSuccess) fprintf(stderr, "cooperative launch failed: %s (grid %d)\n", hipGetErrorString(e), grid_blocks);
}
```

```cpp
#include <hip/hip_runtime.h>
#include <hip/hip_cooperative_groups.h>
#include <stdint.h>
#include <stdio.h>

typedef unsigned short bf16_t;
using bf16x8 = __attribute__((ext_vector_type(8))) short;
using f32x4 = __attribute__((ext_vector_type(4))) float;

constexpr int D = 1024, NB = 4, SEQ = 8192, CTX = 256, DEPTH = 2;
constexpr int TL = NB * SEQ, TC = NB * CTX, TT = TL + TC;
constexpr int NUS = 3640, NU = 3840, NUP = 3840;
constexpr int NE = 16, CAP_L = 1024, CAP_C = 32, SLOTS_E = NB * CAP_L + 256, NSLOT = NE * SLOTS_E;
constexpr int NT = 512, NW = NT / 64;
constexpr int U_GLA = 0, U_HY = 800, U_MB = 1568, U_DN = 2600;

struct Params {
  const float *x, *c, *ctx, *c_ctx, *w_mod, *b_mod, *norm_g, *w_in, *w_out, *gla_w2, *gla_b, *gla_norm,
      *hy_conv_w, *hy_conv_b, *hy_w1, *hy_b1, *hy_w2, *hy_b2, *hy_w3, *hy_b3, *hy_w4, *hy_freq, *hy_d,
      *mb_conv_w, *mb_conv_b, *mb_a_log, *mb_dt_bias, *mb_d, *mb_norm, *dn_conv_w, *dn_a_log, *dn_dt_bias, *dn_norm,
      *moe_router, *moe_w_gate, *moe_w_up, *moe_w_down;
  float* out;
  bf16_t *win_t, *wout_t, *wgu_t, *wdn_t, *hb, *prep, *u, *y, *act, *ymoe;
  float *mod, *xc, *aff, *slot_w, *dt, *bg, *filt, *filtc, *obuf, *zbuf; bf16_t* yo;
  int *slot_tok, *tok_slot;
  bf16_t* gla_l; float* gla_dec;
  bf16_t* mb_l; float* mb_dec;
  bf16_t *dn_m, *dn_l;
  float* yt;
  unsigned* bar;
  float2* specg;
};

typedef const __attribute__((address_space(4))) Params CParams;

typedef float f32x2v __attribute__((ext_vector_type(2)));
typedef __bf16 bf16x2v __attribute__((ext_vector_type(2)));
__device__ __forceinline__ unsigned pack2(float a, float b) { const f32x2v v = {a, b}; return __builtin_bit_cast(unsigned, __builtin_convertvector(v, bf16x2v)); }
__device__ __forceinline__ bf16_t f2bf(float f) { return (bf16_t)(pack2(f, 0.f) & 0xffffu); }
__device__ __forceinline__ float bf2f(bf16_t h) { return __uint_as_float(((unsigned)h) << 16); }
__device__ __forceinline__ float siluf(float v) { return v * __builtin_amdgcn_rcpf(1.f + __expf(-v)); }
__device__ __forceinline__ float sigmoidf_(float v) { return __builtin_amdgcn_rcpf(1.f + __expf(-v)); }
__device__ __forceinline__ float softplusf_(float v) { const float e = __expf(v); return v > 15.f ? v : (v < -8.f ? e : __logf(1.f + e)); }
__device__ __forceinline__ float logsigmoidf_(float z) { return -softplusf_(-z); }
__device__ __forceinline__ float wave_sum(float v) {
#pragma unroll
  for (int o = 32; o > 0; o >>= 1) v += __shfl_xor(v, o);
  return v;
}
__device__ __forceinline__ float rdlane(float v, int l) { return __int_as_float(__builtin_amdgcn_readlane(__float_as_int(v), l)); }
__device__ __forceinline__ float* xrow_ptr(CParams& p, int row) { return row < TL ? p.out + (size_t)row * D : p.xc + (size_t)(row - TL) * D; }
__device__ __forceinline__ int mod_idx(int row) { return row < TL ? row / SEQ : 4; }

__device__ __forceinline__ int seq_nb(int row, int delta, bool mamba) {
  if (row < TL) {
    int b = row / SEQ, t = row % SEQ;
    if (mamba) { int pos = (t & 63) * 128 + (t >> 6) + delta; if (pos < 0 || pos >= SEQ) return -1; return b * SEQ + (pos & 127) * 64 + (pos >> 7); }
    int t2 = t + delta; if (t2 < 0 || t2 >= SEQ) return -1; return b * SEQ + t2;
  }
  int r = row - TL, b = r / CTX, t = r % CTX + delta; if (t < 0 || t >= CTX) return -1; return TL + b * CTX + t;
}

__device__ __forceinline__ void conv8(const bf16_t* u, int ucol, int row, int rm, int rp, const float* w, const float* bias, int c, float (&o)[8]) {
  const uint4 x1 = *(const uint4*)(u + (size_t)row * NU + ucol + c);
  uint4 x0 = make_uint4(0u, 0u, 0u, 0u), x2 = make_uint4(0u, 0u, 0u, 0u);
  if (rm >= 0) x0 = *(const uint4*)(u + (size_t)rm * NU + ucol + c);
  if (rp >= 0) x2 = *(const uint4*)(u + (size_t)rp * NU + ucol + c);
  const unsigned a0[4] = {x0.x, x0.y, x0.z, x0.w}, a1[4] = {x1.x, x1.y, x1.z, x1.w}, a2[4] = {x2.x, x2.y, x2.z, x2.w};
#pragma unroll
  for (int h = 0; h < 2; ++h) {
    const float4 w0 = *(const float4*)(w + c + h * 4), w1 = *(const float4*)(w + 768 + c + h * 4), w2 = *(const float4*)(w + 1536 + c + h * 4);
    const float4 bb = bias ? *(const float4*)(bias + c + h * 4) : make_float4(0.f, 0.f, 0.f, 0.f);
    const float ww0[4] = {w0.x, w0.y, w0.z, w0.w}, ww1[4] = {w1.x, w1.y, w1.z, w1.w}, ww2[4] = {w2.x, w2.y, w2.z, w2.w}, bv[4] = {bb.x, bb.y, bb.z, bb.w};
#pragma unroll
    for (int e = 0; e < 4; ++e) { const int wd = h * 2 + (e >> 1); const bool hi = e & 1;
      const float v0 = hi ? __uint_as_float(a0[wd] & 0xffff0000u) : __uint_as_float(a0[wd] << 16), v1 = hi ? __uint_as_float(a1[wd] & 0xffff0000u) : __uint_as_float(a1[wd] << 16), v2 = hi ? __uint_as_float(a2[wd] & 0xffff0000u) : __uint_as_float(a2[wd] << 16);
      o[h * 4 + e] = bv[e] + ww0[e] * v0 + ww1[e] * v1 + ww2[e] * v2; }
  }
}

template <int MAP>
__device__ __forceinline__ void conv_tile4(const float* src0, const float* src1, int ldsrc, int ncols, bf16_t* dst, int K, int k0, int n0, float* tile, int tid_) {
  const int t = tid_;
  {
    const int nn = t & 63, kk = t >> 6;
    float v[4][8];
#pragma unroll
    for (int q = 0; q < 4; ++q) { const int R = n0 + q * 64 + nn; const float* sp; int col;
      if (MAP == 0) { sp = src0; col = R < ncols ? R : -1; }
      else { int j = R >> 8, rem = R & 255; col = j * 128 + (rem & 127); sp = (rem >> 7) ? src1 : src0; }
#pragma unroll
      for (int i = 0; i < 8; ++i) { int k = i * 8 + kk; v[q][i] = col >= 0 ? sp[(size_t)(k0 + k) * ldsrc + col] : 0.f; } }
#pragma unroll
    for (int q = 0; q < 4; ++q)
#pragma unroll
      for (int i = 0; i < 8; ++i) tile[q * 64 * 65 + (i * 8 + kk) * 65 + nn] = v[q][i];
  }
  __syncthreads();
  {
    const int k2 = (t & 31) * 2, nn = t >> 5;
#pragma unroll
    for (int q = 0; q < 4; ++q)
#pragma unroll
      for (int i = 0; i < 4; ++i) { int n = i * 16 + nn; unsigned v = pack2(tile[q * 64 * 65 + k2 * 65 + n], tile[q * 64 * 65 + (k2 + 1) * 65 + n]);
        *(unsigned*)(dst + (size_t)(n0 + q * 64 + n) * K + k0 + k2) = v; }
  }
  __syncthreads();
}
__device__ __forceinline__ void phase_conv_small(CParams& p, int bid, int nb, int tid_, char* smem) {
  float* tile = (float*)smem;
  const int n_in = 16 * (NUP / 256), n_out = 16 * 4;
  for (int i = bid; i < DEPTH * (n_in + n_out); i += nb) {
    int l = i / (n_in + n_out), r = i % (n_in + n_out);
    if (r < n_in) { int kt = r % 16, nt = r / 16; conv_tile4<0>(p.w_in + (size_t)l * D * NUS, nullptr, NUS, NUS, p.win_t + (size_t)l * NUP * D, D, kt * 64, nt * 256, tile, tid_); }
    else { r -= n_in; int kt = r % 16, nt = r / 16; conv_tile4<0>(p.w_out + (size_t)l * D * D, nullptr, D, D, p.wout_t + (size_t)l * D * D, D, kt * 64, nt * 256, tile, tid_); }
  }
}
__device__ __forceinline__ void phase_conv_moe(CParams& p, int layer, int bid, int nb, int tid_, char* smem) {
  float* tile = (float*)smem;
  const int n_gu = 16 * 8, n_dn = 16 * 4;
  for (int i = bid; i < NE * (n_gu + n_dn); i += nb) {
    int e = i / (n_gu + n_dn), r = i % (n_gu + n_dn);
    size_t wo = ((size_t)layer * NE + e) * D * D;
    if (r < n_gu) { int kt = r % 16, nt = r / 16; conv_tile4<1>(p.moe_w_gate + wo, p.moe_w_up + wo, D, D, p.wgu_t + (size_t)e * 2048 * D, D, kt * 64, nt * 256, tile, tid_); }
    else { r -= n_gu; int kt = r % 16, nt = r / 16; conv_tile4<0>(p.moe_w_down + wo, nullptr, D, D, p.wdn_t + (size_t)e * D * D, D, kt * 64, nt * 256, tile, tid_); }
  }
}

__device__ __forceinline__ void phase_mod(CParams& p, int bid, int nb, int tid_, char* smem) {
  float* sc = (float*)smem;
  float* red = sc + 5 * D;
  const int lane = tid_ & 63, wv = tid_ >> 6;
  for (int i = tid_; i < 5 * D; i += NT) { int r = i / D, k = i % D; float v = r < 4 ? p.c[r * D + k] : p.c_ctx[k]; sc[i] = siluf(v); }
  __syncthreads();
  for (int blk = bid; blk < DEPTH * 6 * D / 64; blk += nb) {
    const int g = blk * 64 + lane, l = g / (6 * D), n = g % (6 * D);
    const float* w = p.w_mod + (size_t)l * D * 6 * D + n;
    float a0 = 0, a1 = 0, a2 = 0, a3 = 0, a4 = 0;
#pragma unroll 8
    for (int k = wv * 128; k < wv * 128 + 128; ++k) { float wvv = w[(size_t)k * 6 * D]; a0 += sc[k] * wvv; a1 += sc[D + k] * wvv; a2 += sc[2 * D + k] * wvv; a3 += sc[3 * D + k] * wvv; a4 += sc[4 * D + k] * wvv; }
    red[(wv * 5 + 0) * 64 + lane] = a0; red[(wv * 5 + 1) * 64 + lane] = a1; red[(wv * 5 + 2) * 64 + lane] = a2; red[(wv * 5 + 3) * 64 + lane] = a3; red[(wv * 5 + 4) * 64 + lane] = a4;
    __syncthreads();
    if (wv < 5) { float t = p.b_mod[l * 6 * D + n];
#pragma unroll
      for (int q = 0; q < 8; ++q) t += red[(q * 5 + wv) * 64 + lane];
      p.mod[((size_t)l * 5 + wv) * 6 * D + n] = t; }
    __syncthreads();
  }
}

__device__ __forceinline__ void row_modulate_store(const float (&xv)[16], const float* g, const float* sh, const float* sc, bf16_t* dst, int lane, float (&hv)[16]) {
  float ss = 0.f;
#pragma unroll
  for (int i = 0; i < 16; ++i) ss += xv[i] * xv[i];
  ss = wave_sum(ss);
  float rstd = rsqrtf(ss * (1.f / D) + 1e-6f);
#pragma unroll
  for (int i = 0; i < 4; ++i) {
    int k = i * 256 + lane * 4;
    float4 gv = *(const float4*)(g + k), shv = *(const float4*)(sh + k), scv = *(const float4*)(sc + k);
    hv[i * 4 + 0] = xv[i * 4 + 0] * rstd * gv.x * (1.f + scv.x) + shv.x;
    hv[i * 4 + 1] = xv[i * 4 + 1] * rstd * gv.y * (1.f + scv.y) + shv.y;
    hv[i * 4 + 2] = xv[i * 4 + 2] * rstd * gv.z * (1.f + scv.z) + shv.z;
    hv[i * 4 + 3] = xv[i * 4 + 3] * rstd * gv.w * (1.f + scv.w) + shv.w;
    uint2 pk; pk.x = pack2(hv[i * 4 + 0], hv[i * 4 + 1]); pk.y = pack2(hv[i * 4 + 2], hv[i * 4 + 3]);
    *(uint2*)(dst + k) = pk;
  }
}
__device__ __forceinline__ void phase_prenorm0(CParams& p, int bid, int nb, int tid_) {
  const int lane = tid_ & 63, wv = tid_ >> 6;
  for (int row0 = (bid * NW + wv) * 2; row0 < TT; row0 += nb * NW * 2) {
    float xv[2][16], hv[16];
#pragma unroll
    for (int r = 0; r < 2; ++r) { const int row = row0 + r; const float* src = row < TL ? p.x + (size_t)row * D : p.ctx + (size_t)(row - TL) * D;
#pragma unroll
      for (int i = 0; i < 4; ++i) { float4 v = *(const float4*)(src + i * 256 + lane * 4); xv[r][i * 4] = v.x; xv[r][i * 4 + 1] = v.y; xv[r][i * 4 + 2] = v.z; xv[r][i * 4 + 3] = v.w; } }
#pragma unroll
    for (int r = 0; r < 2; ++r) { const int row = row0 + r; const float* m = p.mod + (size_t)(0 * 5 + mod_idx(row)) * 6 * D;
      row_modulate_store(xv[r], p.norm_g + 0 * 4 * D + 0 * D, m + 0 * D, m + 1 * D, p.hb + (size_t)row * D, lane, hv); }
  }
}

#define LAS __attribute__((address_space(3)))
namespace g8 {
typedef unsigned u32x4 __attribute__((ext_vector_type(4)));
constexpr int BM = 256, BK = 64, HALF = 128, HTB = HALF * BK * 2, KD = 1024;
__device__ __forceinline__ int lds_byte(int r, int c) { const int st = (r >> 4) * 2 + (c >> 5), rr = r & 15, cc = c & 31, ob = rr * 64 + cc * 2; return st * 1024 + (ob ^ (((ob >> 9) & 1) << 5)); }
__device__ __forceinline__ void stage_rc(int b, int& R, int& C) { const int st = b / 1024, sb = b % 1024, swz = sb ^ (((sb >> 9) & 1) << 5); R = (st >> 1) * 16 + swz / 64; C = (st & 1) * 32 + (swz % 64) / 2; }
__device__ __forceinline__ int perm32(int rho) { const int n = rho >> 4, i = rho & 15; return 8 * (i >> 2) + 4 * n + (i & 3); }
__device__ __forceinline__ unsigned cvt_pk_bf16(float lo, float hi) { unsigned r; asm volatile("v_cvt_pk_bf16_f32 %0, %1, %2" : "=v"(r) : "v"(lo), "v"(hi)); return r; }
struct Unit { int ar0, br0, pn, e; };
struct SchedPlain {
  int nM, nN, nwg, G, c;
  __device__ __forceinline__ bool next(int i, Unit& u) const {
    const long Lx = (long)i * G + c; if (Lx >= nwg) return false;
    int wgid = (int)Lx; { const int q = nwg / 8, r = nwg % 8, xcd = wgid % 8, off = wgid / 8; wgid = (xcd < r ? xcd * (q + 1) : r * (q + 1) + (xcd - r) * q) + off; }
    const int nig = 8 * nN, gid = wgid / nig, fm = gid * 8, gsz = (nM - fm) < 8 ? (nM - fm) : 8;
    const int pm = fm + ((wgid % nig) % gsz), pn = (wgid % nig) / gsz;
    u.ar0 = pm * BM; u.br0 = pn * BM; u.pn = pn; u.e = 0; return true;
  }
};
struct SchedMoe {
  int mt_e, nN, G, c;
  __device__ __forceinline__ bool next(int i, Unit& u) const {
    const long Lx = (long)i * G + c; if (Lx >= (long)NE * mt_e * nN) return false;
    const int e = (int)Lx / (mt_e * nN), r = (int)Lx % (mt_e * nN);
    const int gid = r / (8 * nN), fm = gid * 8, gsz = (mt_e - fm) < 8 ? (mt_e - fm) : 8, rr = r - gid * 8 * nN, pm = fm + rr % gsz, pn = rr / gsz;
    u.ar0 = e * SLOTS_E + pm * BM; u.br0 = (e * nN + pn) * BM; u.pn = pn; u.e = e; return true;
  }
};
template <bool GATHER, class Epi, class Sched>
__device__ __forceinline__ void gemm8(LAS unsigned char* lds, const bf16_t* A, const int* aidx, const bf16_t* Bt, const Sched& S, const Epi& E, int tid) {
  const int wid = __builtin_amdgcn_readfirstlane(tid >> 6), lane = tid & 63, wr = wid >> 2, wc = wid & 3, fr = lane & 15, fq = lane >> 4;
  constexpr int K = KD, nt = K / BK;
  int Rr[2], Cc[2]; unsigned voffB[2];
#pragma unroll
  for (int i = 0; i < 2; ++i) { stage_rc(tid * 16 + i * 8192, Rr[i], Cc[i]); const int Rb = Epi::PERM ? ((Rr[i] & ~31) + perm32(Rr[i] & 31)) : Rr[i]; voffB[i] = (unsigned)(Rb * K + Cc[i]) * 2u; }
  const size_t kstep = (size_t)(BK * 2), hstep = (size_t)HALF * K * 2;
  const unsigned ldsw = (unsigned)wid * 1024u;
  const int aoff = lds_byte(wr * 64 + fr, fq * 8), boff = lds_byte(wc * 32 + fr, fq * 8);
#define G8_SA(b, h) (((b) * 2 + (h)) * HTB)
#define G8_SB(b, h) ((4 + (b) * 2 + (h)) * HTB)
#define G8_STAGE(bufoff, gbase, voff) do { _Pragma("unroll") for (int _i = 0; _i < 2; ++_i) \
    __builtin_amdgcn_global_load_lds((const unsigned*)((const char*)(gbase) + (voff)[_i]), (LAS unsigned*)(lds + (bufoff) + ldsw + _i * 8192), 16, 0, 0); } while (0)
#define G8_LDA(dst, b, h) do { _Pragma("unroll") for (int m = 0; m < 4; ++m) _Pragma("unroll") for (int k = 0; k < 2; ++k) dst[m][k] = *(const LAS bf16x8*)(lds + G8_SA(b, h) + aoff + m * 2048 + k * 1024); } while (0)
#define G8_LDB(dst, b, h) do { _Pragma("unroll") for (int n = 0; n < 2; ++n) _Pragma("unroll") for (int k = 0; k < 2; ++k) dst[n][k] = *(const LAS bf16x8*)(lds + G8_SB(b, h) + boff + n * 2048 + k * 1024); } while (0)
#define G8_MMA(ai, bj, At, Btf) do { __builtin_amdgcn_s_setprio(1); _Pragma("unroll") for (int m = 0; m < 4; ++m) _Pragma("unroll") for (int n = 0; n < 2; ++n) _Pragma("unroll") for (int k = 0; k < 2; ++k) \
    acc[ai][bj][m][n] = __builtin_amdgcn_mfma_f32_16x16x32_bf16(Btf[n][k], At[m][k], acc[ai][bj][m][n], 0, 0, 0); __builtin_amdgcn_s_setprio(0); } while (0)
#define G8_WAIT_V(n) asm volatile("s_waitcnt vmcnt(" #n ")" ::: "memory")
#define G8_WAIT_L(n) asm volatile("s_waitcnt lgkmcnt(" #n ")" ::: "memory")
#define G8_BAR __builtin_amdgcn_s_barrier()
#define G8_SCHED __builtin_amdgcn_sched_barrier(0)
#define G8_AOFF(dst, un) do { _Pragma("unroll") for (int h = 0; h < 2; ++h) _Pragma("unroll") for (int i = 0; i < 2; ++i) { const int r_ = (un).ar0 + h * HALF + Rr[i]; \
    const int g_ = GATHER ? aidx[r_] : r_; dst[h][i] = (unsigned)(g_ * K + Cc[i]) * 2u; } } while (0)
  Unit cur, nxt; int ui = 0;
  if (!S.next(0, cur)) return;
  f32x4 acc[2][2][4][2];
#pragma unroll
  for (int a = 0; a < 2; ++a)
#pragma unroll
    for (int b = 0; b < 2; ++b)
#pragma unroll
      for (int m = 0; m < 4; ++m)
#pragma unroll
        for (int n = 0; n < 2; ++n) acc[a][b][m][n] = (f32x4){0.f, 0.f, 0.f, 0.f};
  bf16x8 At[4][2], B0[2][2], B1[2][2];
  unsigned vA[2][2], vAn[2][2];
  G8_AOFF(vA, cur);
  const char* cA = (const char*)A; const char* cB = (const char*)Bt + (size_t)cur.br0 * K * 2;
  G8_STAGE(G8_SB(0, 0), cB, voffB); G8_STAGE(G8_SA(0, 0), cA, vA[0]); G8_STAGE(G8_SB(0, 1), cB + hstep, voffB); G8_STAGE(G8_SA(0, 1), cA, vA[1]);
  if (wr == 1) G8_BAR;
  G8_WAIT_V(4); G8_BAR;
  G8_STAGE(G8_SB(1, 0), cB + kstep, voffB); G8_STAGE(G8_SA(1, 0), cA + kstep, vA[0]); G8_STAGE(G8_SB(1, 1), cB + hstep + kstep, voffB);
  G8_WAIT_V(6); G8_BAR;
  for (;;) {
    const bool has_next = S.next(ui + 1, nxt);
    if (has_next) { G8_AOFF(vAn, nxt); } else {
#pragma unroll
      for (int h = 0; h < 2; ++h)
#pragma unroll
        for (int i = 0; i < 2; ++i) vAn[h][i] = vA[h][i]; }
    const char* nB = has_next ? (const char*)Bt + (size_t)nxt.br0 * K * 2 : cB;
    for (int t = 0; t < nt; t += 2) {
      const bool last = (t == nt - 2);
      const char* a1 = cA + (size_t)(t + 1) * kstep;
      const char* a2 = last ? cA : cA + (size_t)(t + 2) * kstep; const char* b2 = last ? nB : cB + (size_t)(t + 2) * kstep;
      const char* a3 = a2 + kstep; const char* b3 = b2 + kstep;
      unsigned v2[2][2];
#pragma unroll
      for (int h = 0; h < 2; ++h)
#pragma unroll
        for (int i = 0; i < 2; ++i) v2[h][i] = last ? vAn[h][i] : vA[h][i];
      G8_LDB(B0, 0, 0); G8_SCHED; G8_LDA(At, 0, 0); G8_STAGE(G8_SA(1, 1), a1, vA[1]);
      G8_WAIT_L(8); G8_BAR; G8_WAIT_L(0); G8_MMA(0, 0, At, B0); G8_BAR; G8_SCHED;
      G8_LDB(B1, 0, 1); G8_STAGE(G8_SB(0, 0), b2, voffB);
      G8_BAR; G8_WAIT_L(0); G8_MMA(0, 1, At, B1); G8_BAR;
      G8_LDA(At, 0, 1); G8_STAGE(G8_SA(0, 0), a2, v2[0]);
      G8_BAR; G8_WAIT_L(0); G8_MMA(1, 0, At, B0); G8_BAR; G8_SCHED;
      G8_STAGE(G8_SB(0, 1), b2 + hstep, voffB);
      G8_WAIT_V(6); G8_BAR; G8_MMA(1, 1, At, B1); G8_BAR;
      G8_LDB(B0, 1, 0); G8_SCHED; G8_LDA(At, 1, 0); G8_STAGE(G8_SA(0, 1), a2, v2[1]);
      G8_WAIT_L(8); G8_BAR; G8_WAIT_L(0); G8_MMA(0, 0, At, B0); G8_BAR; G8_SCHED;
      G8_LDB(B1, 1, 1); G8_STAGE(G8_SB(1, 0), b3, voffB);
      G8_BAR; G8_WAIT_L(0); G8_MMA(0, 1, At, B1); G8_BAR;
      G8_LDA(At, 1, 1); G8_STAGE(G8_SA(1, 0), a3, v2[0]);
      G8_BAR; G8_WAIT_L(0); G8_MMA(1, 0, At, B0); G8_BAR; G8_SCHED;
      G8_STAGE(G8_SB(1, 1), b3 + hstep, voffB);
      G8_WAIT_V(6); G8_BAR; G8_MMA(1, 1, At, B1); G8_BAR;
    }
    E(acc, cur, wr, wc, fr, fq);
    if (!has_next) break;
#pragma unroll
    for (int a = 0; a < 2; ++a)
#pragma unroll
      for (int b = 0; b < 2; ++b)
#pragma unroll
        for (int m = 0; m < 4; ++m)
#pragma unroll
          for (int n = 0; n < 2; ++n) acc[a][b][m][n] = (f32x4){0.f, 0.f, 0.f, 0.f};
    cur = nxt; cB = nB; ++ui;
#pragma unroll
    for (int h = 0; h < 2; ++h)
#pragma unroll
      for (int i = 0; i < 2; ++i) vA[h][i] = vAn[h][i];
  }
  G8_WAIT_V(0);
  if (wr == 0) G8_BAR;
  G8_BAR;
#undef G8_SA
#undef G8_SB
#undef G8_STAGE
#undef G8_LDA
#undef G8_LDB
#undef G8_MMA
#undef G8_WAIT_V
#undef G8_WAIT_L
#undef G8_BAR
#undef G8_SCHED
#undef G8_AOFF
}
struct EpiU {
  static constexpr bool PERM = true; bf16_t* u;
  __device__ __forceinline__ void operator()(const f32x4 (&acc)[2][2][4][2], const Unit& un, int wr, int wc, int fr, int fq) const {
#pragma unroll
    for (int ai = 0; ai < 2; ++ai)
#pragma unroll
      for (int m = 0; m < 4; ++m) { bf16_t* rowp = u + (size_t)(un.ar0 + ai * HALF + wr * 64 + m * 16 + fr) * NU;
#pragma unroll
        for (int bj = 0; bj < 2; ++bj) { const int c0 = un.pn * BM + bj * HALF + wc * 32 + 8 * fq;
          { u32x4 w; w.x = cvt_pk_bf16(acc[ai][bj][m][0][0], acc[ai][bj][m][0][1]); w.y = cvt_pk_bf16(acc[ai][bj][m][0][2], acc[ai][bj][m][0][3]);
            w.z = cvt_pk_bf16(acc[ai][bj][m][1][0], acc[ai][bj][m][1][1]); w.w = cvt_pk_bf16(acc[ai][bj][m][1][2], acc[ai][bj][m][1][3]); *(u32x4*)(rowp + c0) = w; } } }
  }
};
struct EpiYo {
  static constexpr bool PERM = true; bf16_t* yo;
  __device__ __forceinline__ void operator()(const f32x4 (&acc)[2][2][4][2], const Unit& un, int wr, int wc, int fr, int fq) const {
#pragma unroll
    for (int ai = 0; ai < 2; ++ai)
#pragma unroll
      for (int m = 0; m < 4; ++m) { bf16_t* rowp = yo + (size_t)(un.ar0 + ai * HALF + wr * 64 + m * 16 + fr) * D + un.pn * BM + wc * 32 + 8 * fq;
#pragma unroll
        for (int bj = 0; bj < 2; ++bj) { u32x4 w; w.x = cvt_pk_bf16(acc[ai][bj][m][0][0], acc[ai][bj][m][0][1]); w.y = cvt_pk_bf16(acc[ai][bj][m][0][2], acc[ai][bj][m][0][3]);
          w.z = cvt_pk_bf16(acc[ai][bj][m][1][0], acc[ai][bj][m][1][1]); w.w = cvt_pk_bf16(acc[ai][bj][m][1][2], acc[ai][bj][m][1][3]); *(u32x4*)(rowp + bj * HALF) = w; } }
  }
};
struct EpiAct {
  static constexpr bool PERM = true; bf16_t* act;
  __device__ __forceinline__ void operator()(const f32x4 (&acc)[2][2][4][2], const Unit& un, int wr, int wc, int fr, int fq) const {
#pragma unroll
    for (int ai = 0; ai < 2; ++ai)
#pragma unroll
      for (int m = 0; m < 4; ++m) { bf16_t* dst = act + (size_t)(un.ar0 + ai * HALF + wr * 64 + m * 16 + fr) * D + un.pn * HALF + wc * 32 + 8 * fq; float v[8];
#pragma unroll
        for (int n = 0; n < 2; ++n)
#pragma unroll
          for (int j = 0; j < 4; ++j) { const float g = acc[ai][0][m][n][j]; v[n * 4 + j] = g * __builtin_amdgcn_rcpf(1.f + __expf(-g)) * acc[ai][1][m][n][j]; }
        u32x4 w; w.x = cvt_pk_bf16(v[0], v[1]); w.y = cvt_pk_bf16(v[2], v[3]); w.z = cvt_pk_bf16(v[4], v[5]); w.w = cvt_pk_bf16(v[6], v[7]); *(u32x4*)dst = w; }
  }
};
struct EpiYm {
  static constexpr bool PERM = true; bf16_t* ym; const float* sw;
  __device__ __forceinline__ void operator()(const f32x4 (&acc)[2][2][4][2], const Unit& un, int wr, int wc, int fr, int fq) const {
#pragma unroll
    for (int ai = 0; ai < 2; ++ai)
#pragma unroll
      for (int m = 0; m < 4; ++m) { const int row = un.ar0 + ai * HALF + wr * 64 + m * 16 + fr; const float w8 = sw[row]; bf16_t* rowp = ym + (size_t)row * D + un.pn * BM + wc * 32 + 8 * fq;
#pragma unroll
        for (int bj = 0; bj < 2; ++bj) { u32x4 w; w.x = cvt_pk_bf16(acc[ai][bj][m][0][0] * w8, acc[ai][bj][m][0][1] * w8); w.y = cvt_pk_bf16(acc[ai][bj][m][0][2] * w8, acc[ai][bj][m][0][3] * w8);
          w.z = cvt_pk_bf16(acc[ai][bj][m][1][0] * w8, acc[ai][bj][m][1][1] * w8); w.w = cvt_pk_bf16(acc[ai][bj][m][1][2] * w8, acc[ai][bj][m][1][3] * w8); *(u32x4*)(rowp + bj * HALF) = w; } }
  }
};
}

__device__ __forceinline__ void phase_gemm_in(CParams& p, int layer, int bid, int nb, int tid_, char* smem) {
  g8::SchedPlain S; S.nM = TT / 256; S.nN = NUP / 256; S.nwg = S.nM * S.nN; S.G = nb; S.c = bid;
  g8::EpiU E; E.u = p.u;
  g8::gemm8<false>((LAS unsigned char*)smem, p.hb, nullptr, p.win_t + (size_t)layer * NUP * D, S, E, tid_);
}
__device__ __forceinline__ void phase_gemm_out(CParams& p, int layer, int bid, int nb, int tid_, char* smem) {
  g8::SchedPlain S; S.nM = (layer == 0 ? TT : TL) / 256; S.nN = D / 256; S.nwg = S.nM * S.nN; S.G = nb; S.c = bid;
  g8::EpiYo E; E.yo = p.yo;
  g8::gemm8<false>((LAS unsigned char*)smem, p.y, nullptr, p.wout_t + (size_t)layer * D * D, S, E, tid_);
}
__device__ __forceinline__ void phase_gemm_moe1(CParams& p, int layer, int bid, int nb, int tid_, char* smem) {
  g8::SchedMoe S; S.mt_e = layer == 0 ? 17 : 16; S.nN = 8; S.G = nb; S.c = bid;
  g8::EpiAct E; E.act = p.act;
  g8::gemm8<true>((LAS unsigned char*)smem, p.hb, p.slot_tok, p.wgu_t, S, E, tid_);
}
__device__ __forceinline__ void phase_gemm_moe2(CParams& p, int layer, int bid, int nb, int tid_, char* smem) {
  g8::SchedMoe S; S.mt_e = layer == 0 ? 17 : 16; S.nN = 4; S.G = nb; S.c = bid;
  g8::EpiYm E; E.ym = p.ymoe; E.sw = p.slot_w;
  g8::gemm8<false>((LAS unsigned char*)smem, p.act, nullptr, p.wdn_t, S, E, tid_);
}

template <int MT, int NTL, int KS, int LDA, int LDB>
__device__ __forceinline__ void wmm(f32x4 (&acc)[MT][NTL], const bf16_t* A, const bf16_t* B, int fr, int fq) {
#pragma unroll
  for (int ks = 0; ks < KS; ++ks) {
    bf16x8 a[MT], b[NTL];
#pragma unroll
    for (int m = 0; m < MT; ++m) a[m] = *(const bf16x8*)(A + (m * 16 + fr) * LDA + ks * 32 + fq * 8);
#pragma unroll
    for (int n = 0; n < NTL; ++n) b[n] = *(const bf16x8*)(B + (n * 16 + fr) * LDB + ks * 32 + fq * 8);
#pragma unroll
    for (int m = 0; m < MT; ++m)
#pragma unroll
      for (int n = 0; n < NTL; ++n) acc[m][n] = __builtin_amdgcn_mfma_f32_16x16x32_bf16(a[m], b[n], acc[m][n], 0, 0, 0);
  }
}
constexpr int NCH = 132;
__device__ __forceinline__ int chunk_row0(int b, int cpos) { return cpos < 4 ? TL + b * CTX + cpos * 64 : b * SEQ + (cpos - 4) * 64; }
__device__ __forceinline__ int scan_idx(int cpos, int dir) { return dir == 0 ? cpos : (cpos < 4 ? 3 - cpos : 135 - cpos); }

struct GlaLds {
  bf16_t rq[64][32], rk[64][32], rv[64][64], rog[64][64], rlr[64][32];
  float w2s[2][16][32]; float gbs[2][32]; float g[2][64][36]; float gt[2][32];
  bf16_t qg[2][64][40]; bf16_t kg[2][64][40];
  bf16_t vt[64][72]; bf16_t at[2][64][72]; float ox[64][65];
};
template <int PASS>
__device__ __forceinline__ void phase_gla_chunk(CParams& p, int layer, int bid, int nb, int tid_, char* smem) {
  GlaLds& L = *(GlaLds*)smem;
  const int c_lo = (PASS == 1 && layer == DEPTH - 1) ? 4 : 0, ncp = NCH - c_lo;
  uint4 r0 = make_uint4(0u, 0u, 0u, 0u), r1 = r0, r2 = r0, r3 = r0; float w2a = 0.f, w2b = 0.f, gbv = 0.f;
  auto gfetch = [&](int task_, int tid) { const int h_ = task_ & 3, cpos_ = c_lo + (task_ >> 2) % ncp, b_ = (task_ >> 2) / ncp; const bf16_t* U0_ = p.u + (size_t)chunk_row0(b_, cpos_) * NU;
    auto gsrc = [&](int i) -> const bf16_t* { const int f = (i * 2341) >> 16, c = i - f * 28;
      const int col = c < 4 ? h_ * 32 + c * 8 : (c < 8 ? 128 + h_ * 32 + (c - 4) * 8 : (c < 16 ? 256 + h_ * 64 + (c - 8) * 8 : (c < 24 ? 512 + h_ * 64 + (c - 16) * 8 : 768 + (c - 24) * 8)));
      return U0_ + (size_t)f * NU + col; };
    r0 = *(const uint4*)gsrc(tid); r1 = *(const uint4*)gsrc(tid + NT); r2 = *(const uint4*)gsrc(tid + 2 * NT);
    if (tid < 64 * 28 - 3 * NT) r3 = *(const uint4*)gsrc(tid + 3 * NT);
    const int i0 = tid, i1 = tid + NT;
    w2a = p.gla_w2[((size_t)(layer * 2 + (i0 >> 9)) * 16 + ((i0 >> 5) & 15)) * 128 + h_ * 32 + (i0 & 31)]; w2b = p.gla_w2[((size_t)(layer * 2 + (i1 >> 9)) * 16 + ((i1 >> 5) & 15)) * 128 + h_ * 32 + (i1 & 31)];
    if (tid < 64) gbv = p.gla_b[(layer * 2 + (tid >> 5)) * 128 + h_ * 32 + (tid & 31)]; };
  if (bid < NB * ncp * 4) gfetch(bid, tid_);
  for (int task = bid; task < NB * ncp * 4; task += nb) {
    int tid = tid_; asm volatile("" : "+v"(tid));
    const int lane = tid & 63, wv = tid >> 6, fr = lane & 15, fq = lane >> 4, dirw = wv >> 2, s4 = wv & 3;
    const int h = task & 3, cpos = c_lo + (task >> 2) % ncp, b = (task >> 2) / ncp;
    const int row0 = chunk_row0(b, cpos);
    const bf16_t* U0 = p.u + (size_t)row0 * NU;
    const int seq = (b * 4 + h) * 2 + dirw, nsc = scan_idx(cpos, dirw);
    bf16x8 sfrag[4];
    if (PASS == 1) { const bf16_t* sb = p.gla_l + ((size_t)seq * NCH + nsc) * 2048;
#pragma unroll
      for (int n = 0; n < 4; ++n) sfrag[n] = *(const bf16x8*)(sb + (n * 16 + fr) * 32 + fq * 8); }
    { auto ldst = [&](int i) -> bf16_t* { const int f = (i * 2341) >> 16, c = i - f * 28;
        return c < 4 ? &L.rq[f][c * 8] : (c < 8 ? &L.rk[f][(c - 4) * 8] : (c < 16 ? &L.rv[f][(c - 8) * 8] : (c < 24 ? &L.rog[f][(c - 16) * 8] : &L.rlr[f][(c - 24) * 8]))); };
      *(uint4*)ldst(tid) = r0; *(uint4*)ldst(tid + NT) = r1; *(uint4*)ldst(tid + 2 * NT) = r2;
      if (tid < 64 * 28 - 3 * NT) *(uint4*)ldst(tid + 3 * NT) = r3;
      (&L.w2s[0][0][0])[tid] = w2a; (&L.w2s[0][0][0])[tid + NT] = w2b;
      if (tid < 64) L.gbs[tid >> 5][tid & 31] = gbv; }
    if (task + nb < NB * ncp * 4) gfetch(task + nb, tid);
    __syncthreads();
    { const int dir = tid >> 8, f = (tid >> 2) & 63, d0 = (tid & 3) * 8;
      float z[8];
#pragma unroll
      for (int e = 0; e < 8; ++e) z[e] = L.gbs[dir][d0 + e];
      const uint4 l0 = *(const uint4*)&L.rlr[f][dir * 16], l1 = *(const uint4*)&L.rlr[f][dir * 16 + 8];
      const unsigned lw[8] = {l0.x, l0.y, l0.z, l0.w, l1.x, l1.y, l1.z, l1.w};
#pragma unroll
      for (int r = 0; r < 16; ++r) { const float lv = (r & 1) ? __uint_as_float(lw[r >> 1] & 0xffff0000u) : __uint_as_float(lw[r >> 1] << 16);
        const float4 wa = *(const float4*)&L.w2s[dir][r][d0], wb = *(const float4*)&L.w2s[dir][r][d0 + 4];
        z[0] += lv * wa.x; z[1] += lv * wa.y; z[2] += lv * wa.z; z[3] += lv * wa.w; z[4] += lv * wb.x; z[5] += lv * wb.y; z[6] += lv * wb.z; z[7] += lv * wb.w; }
#pragma unroll
      for (int e = 0; e < 8; ++e) z[e] = logsigmoidf_(z[e]) * (1.f / 16.f);
      *(float4*)&L.g[dir][f][d0] = make_float4(z[0], z[1], z[2], z[3]); *(float4*)&L.g[dir][f][d0 + 4] = make_float4(z[4], z[5], z[6], z[7]); }
    __syncthreads();
#pragma unroll
    for (int cc = 0; cc < 8; ++cc) { const int col = wv * 8 + cc, dir = col >> 5, d = col & 31, f = dir ? 63 - lane : lane;
      float v = L.g[dir][f][d];
#pragma unroll
      for (int o = 1; o < 64; o <<= 1) { const float t = __shfl_up(v, o); if (lane >= o) v += t; }
      L.g[dir][f][d] = v; if (lane == 63) L.gt[dir][d] = v; }
    __syncthreads();
    if (PASS == 1) {
      for (int i = tid; i < 2 * 64 * 16; i += NT) { int dir = i >> 10, f = (i >> 4) & 63, dp = i & 15;
        const unsigned qq = *(const unsigned*)&L.rq[f][2 * dp], kk = *(const unsigned*)&L.rk[f][2 * dp];
        const float2 cc = *(const float2*)&L.g[dir][f][2 * dp];
        const float e0 = __expf(cc.x), e1 = __expf(cc.y);
        *(unsigned*)&L.qg[dir][f][2 * dp] = pack2(__uint_as_float(qq << 16) * e0 * 0.17677669529663687f, __uint_as_float(qq & 0xffff0000u) * e1 * 0.17677669529663687f);
        *(unsigned*)&L.kg[dir][f][2 * dp] = pack2(__uint_as_float(kk << 16) * __builtin_amdgcn_rcpf(e0), __uint_as_float(kk & 0xffff0000u) * __builtin_amdgcn_rcpf(e1)); }
    } else {
      bf16_t (*ket)[32][72] = (bf16_t (*)[32][72])&L.kg[0][0][0];
      for (int i = tid; i < 2 * 32 * 16; i += NT) { int d = i & 31, f4 = (i >> 5) & 15, dir = i >> 9, f0 = f4 * 4; float v[4];
#pragma unroll
        for (int q = 0; q < 4; ++q) v[q] = bf2f(L.rk[f0 + q][d]) * __expf(L.gt[dir][d] - L.g[dir][f0 + q][d]);
        uint2 pk; pk.x = pack2(v[0], v[1]); pk.y = pack2(v[2], v[3]); *(uint2*)&ket[dir][d][f0] = pk; }
    }
    for (int i = tid; i < 64 * 16; i += NT) { int c = i & 63, f0 = (i >> 6) * 4;
      uint2 pk; pk.x = (unsigned)L.rv[f0][c] | ((unsigned)L.rv[f0 + 1][c] << 16); pk.y = (unsigned)L.rv[f0 + 2][c] | ((unsigned)L.rv[f0 + 3][c] << 16); *(uint2*)&L.vt[c][f0] = pk; }
    __syncthreads();
    if (PASS == 0) {
      const bf16_t (*ket)[32][72] = (const bf16_t (*)[32][72])&L.kg[0][0][0];
      f32x4 acc[2][1] = {{{0.f, 0.f, 0.f, 0.f}}, {{0.f, 0.f, 0.f, 0.f}}};
      wmm<2, 1, 2, 72, 72>(acc, &ket[dirw][0][0], &L.vt[s4 * 16][0], fr, fq);
      bf16_t* dst = p.gla_l + ((size_t)seq * NCH + nsc) * 2048 + (s4 * 16 + fr) * 32;
#pragma unroll
      for (int m = 0; m < 2; ++m) { uint2 pk; pk.x = pack2(acc[m][0][0], acc[m][0][1]); pk.y = pack2(acc[m][0][2], acc[m][0][3]); *(uint2*)(dst + m * 16 + fq * 4) = pk; }
      if (tid < 64) { int dir = tid >> 5, d = tid & 31; p.gla_dec[((size_t)((b * 4 + h) * 2 + dir) * NCH + scan_idx(cpos, dir)) * 32 + d] = __expf(L.gt[dir][d]); }
    } else {
      { f32x4 acc[4][1];
#pragma unroll
        for (int m = 0; m < 4; ++m) acc[m][0] = (f32x4){0.f, 0.f, 0.f, 0.f};
        wmm<4, 1, 1, 40, 40>(acc, &L.kg[dirw][0][0], &L.qg[dirw][s4 * 16][0], fr, fq);
        const int i = s4 * 16 + fr;
#pragma unroll
        for (int m = 0; m < 4; ++m) { float v[4];
#pragma unroll
          for (int q = 0; q < 4; ++q) { int j = m * 16 + fq * 4 + q; bool keep = dirw == 0 ? (j <= i) : (j >= i); v[q] = keep ? acc[m][0][q] : 0.f; }
          uint2 pk; pk.x = pack2(v[0], v[1]); pk.y = pack2(v[2], v[3]); *(uint2*)&L.at[dirw][i][m * 16 + fq * 4] = pk; } }
      f32x4 ao[1][4];
#pragma unroll
      for (int n = 0; n < 4; ++n) ao[0][n] = (f32x4){0.f, 0.f, 0.f, 0.f};
      wmm<1, 4, 2, 72, 72>(ao, &L.at[dirw][s4 * 16][0], &L.vt[0][0], fr, fq);
      { bf16x8 a = *(const bf16x8*)&L.qg[dirw][s4 * 16 + fr][fq * 8];
#pragma unroll
        for (int n = 0; n < 4; ++n) ao[0][n] = __builtin_amdgcn_mfma_f32_16x16x32_bf16(a, sfrag[n], ao[0][n], 0, 0, 0); }
      if (dirw == 1) {
#pragma unroll
        for (int n = 0; n < 4; ++n)
#pragma unroll
          for (int q = 0; q < 4; ++q) L.ox[s4 * 16 + fq * 4 + q][n * 16 + fr] = ao[0][n][q]; }
      __syncthreads();
      if (dirw == 0) {
        float ss[4] = {0.f, 0.f, 0.f, 0.f};
#pragma unroll
        for (int n = 0; n < 4; ++n)
#pragma unroll
          for (int q = 0; q < 4; ++q) { ao[0][n][q] += L.ox[s4 * 16 + fq * 4 + q][n * 16 + fr]; ss[q] += ao[0][n][q] * ao[0][n][q]; }
#pragma unroll
        for (int q = 0; q < 4; ++q) {
#pragma unroll
          for (int o = 1; o < 16; o <<= 1) ss[q] += __shfl_xor(ss[q], o);
          ss[q] = rsqrtf(ss[q] * (1.f / 64.f) + 1e-6f); }
#pragma unroll
        for (int n = 0; n < 4; ++n) { const int c = n * 16 + fr; const float nw = p.gla_norm[layer * 256 + h * 64 + c];
#pragma unroll
          for (int q = 0; q < 4; ++q) { const int f = s4 * 16 + fq * 4 + q; float og = bf2f(L.rog[f][c]);
            p.y[(size_t)(row0 + f) * D + h * 64 + c] = f2bf(ao[0][n][q] * ss[q] * nw * siluf(og)); } }
      }
    }
    __syncthreads();
  }
}
__device__ __forceinline__ void phase_gla_state(CParams& p, int bid, int nb, int tid_) {
  for (int i = bid * NT + tid_; i < 32 * 1024; i += nb * NT) {
    const int seq = i >> 10, e2 = (i & 1023) * 2;
    unsigned* lp = (unsigned*)(p.gla_l + (size_t)seq * NCH * 2048 + e2);
    const float* dp = p.gla_dec + (size_t)seq * NCH * 32 + (e2 & 31);
    float s0 = 0.f, s1 = 0.f;
    for (int n = 0; n < NCH; n += 12) {
      unsigned lv[12]; float2 dc[12];
#pragma unroll
      for (int q = 0; q < 12; ++q) { lv[q] = lp[(size_t)(n + q) * 1024]; dc[q] = *(const float2*)(dp + (n + q) * 32); }
#pragma unroll
      for (int q = 0; q < 12; ++q) { lp[(size_t)(n + q) * 1024] = pack2(s0, s1); s0 = s0 * dc[q].x + bf2f((bf16_t)(lv[q] & 0xffff)); s1 = s1 * dc[q].y + bf2f((bf16_t)(lv[q] >> 16)); }
    }
  }
}

__device__ __forceinline__ void phase_hy_prep(CParams& p, int layer, int bid, int nb, int tid_) {
  if (layer != 0) return;
  for (long i = (long)bid * NT + tid_; i < (long)TC * 768; i += (long)nb * NT) {
    int row = TL + (int)(i / 768), c = (int)(i % 768);
    int rm = seq_nb(row, -1, false), rp = seq_nb(row, 1, false);
    const float* w = p.hy_conv_w + (size_t)layer * 3 * 768;
    float a = p.hy_conv_b[layer * 768 + c] + w[768 + c] * bf2f(p.u[(size_t)row * NU + U_HY + c]);
    if (rm >= 0) a += w[c] * bf2f(p.u[(size_t)rm * NU + U_HY + c]);
    if (rp >= 0) a += w[2 * 768 + c] * bf2f(p.u[(size_t)rp * NU + U_HY + c]);
    p.prep[(size_t)row * 768 + c] = f2bf(a);
  }
}
template <bool TR>
__device__ __forceinline__ void phase_hy_filt(CParams& p, int layer, int L, float* filt, int bid, int nb, int tid_, char* smem) {
  constexpr int PP = 16;
  float* feats = (float*)smem;
  float* h1 = feats + PP * 36;
  float* h2 = h1 + PP * 64;
  float* h3 = h2 + PP * 64;
  float* w1s = h3 + PP * 64;
  float* w2s = w1s + 33 * 64; float* w3s = w2s + 64 * 64; float* bfs = w3s + 64 * 64;
  const int t = tid_;
  const float* w4 = p.hy_w4 + (size_t)layer * 64 * 1024;
  for (int i = t; i < 33 * 64; i += NT) w1s[i] = p.hy_w1[(size_t)layer * 33 * 64 + i];
  for (int i = t; i < 64 * 64; i += NT) { w2s[i] = p.hy_w2[(size_t)layer * 64 * 64 + i]; w3s[i] = p.hy_w3[(size_t)layer * 64 * 64 + i]; }
  if (t < 64) { bfs[t] = p.hy_b1[layer * 64 + t]; bfs[64 + t] = p.hy_b2[layer * 64 + t]; bfs[128 + t] = p.hy_b3[layer * 64 + t]; }
  if (t < 192) bfs[192 + t] = p.hy_freq[layer * 192 + t];
  __syncthreads();
  for (int blk = bid; blk < L / PP; blk += nb) {
    const int pos0 = blk * PP;
    for (int i = t; i < PP * 33; i += NT) {
      int pp = i / 33, f = i % 33; float pos = (float)(pos0 + pp); float v;
      if (f == 0) v = pos / (float)(L - 1);
      else { int j = (f - 1) & 15; float band = 1e-4f + (float)j * ((15.f - 1e-4f) / 15.f); float ang = (6.283185307179586f / (float)L) * pos * band; v = f <= 16 ? cosf(ang) : -sinf(ang); }
      feats[pp * 36 + f] = v;
    }
    __syncthreads();
    for (int i = t; i < PP * 64; i += NT) { int pp = i >> 6, j = i & 63; float a = bfs[j];
#pragma unroll
      for (int k = 0; k < 33; ++k) a += feats[pp * 36 + k] * w1s[k * 64 + j];
      h1[i] = sinf(bfs[192 + j] * a); }
    __syncthreads();
    for (int i = t; i < PP * 64; i += NT) { int pp = i >> 6, j = i & 63; float a = bfs[64 + j];
#pragma unroll 16
      for (int k = 0; k < 64; ++k) a += h1[pp * 64 + k] * w2s[k * 64 + j];
      h2[i] = sinf(bfs[256 + j] * a); }
    __syncthreads();
    for (int i = t; i < PP * 64; i += NT) { int pp = i >> 6, j = i & 63; float a = bfs[128 + j];
#pragma unroll 16
      for (int k = 0; k < 64; ++k) a += h2[pp * 64 + k] * w3s[k * 64 + j];
      h3[i] = sinf(bfs[320 + j] * a); }
    __syncthreads();
#pragma unroll 1
    for (int cc = 0; cc < 1024 / NT; ++cc) {
      int col = cc * NT + t, c = col & 255;
      float acc[PP];
#pragma unroll
      for (int pp = 0; pp < PP; ++pp) acc[pp] = 0.f;
#pragma unroll 1
      for (int k0 = 0; k0 < 64; k0 += 16) { float wv[16];
#pragma unroll
        for (int k = 0; k < 16; ++k) wv[k] = w4[(k0 + k) * 1024 + col];
#pragma unroll
        for (int k = 0; k < 16; ++k)
#pragma unroll
          for (int pp = 0; pp < PP; ++pp) acc[pp] += h3[pp * 64 + k0 + k] * wv[k]; }
      const float mind = -3.0701134573253945f, maxd = -15.350567286626973f;
      float delta = fabsf(mind + (float)c * ((maxd - mind) / 255.f));
#pragma unroll
      for (int pp = 0; pp < PP; ++pp) { float tn = (float)(pos0 + pp) / (float)(L - 1); float fv = acc[pp] * __expf(-tn * delta); if (TR) filt[(size_t)col * L + pos0 + pp] = fv; else filt[(size_t)(pos0 + pp) * 1024 + col] = fv; }
    }
    __syncthreads();
  }
}
__device__ __forceinline__ void phase_hy_conv(CParams& p, int layer, int stage, bool ctx, int bid, int nb, int tid_) {
  const int L = ctx ? CTX : SEQ, rbase = ctx ? TL : 0;
  const float* filt = ctx ? p.filtc : p.filt;
  const int ntt = L / 16;
  const int total = NB * ntt * 256;
  for (int i = bid * NT + tid_; i < total; i += nb * NT) {
    const int c = i & 255, tt = (i >> 8) % ntt, b = (i >> 8) / ntt, t0 = tt * 16;
    const float* ff = filt + stage * 512 + c;
    float acc[16], win[16];
#pragma unroll
    for (int k = 0; k < 16; ++k) acc[k] = 0.f;
#pragma unroll
    for (int k = 0; k < 16; ++k) win[k] = ff[(size_t)(t0 + k) * 1024];
    for (int s0 = 0; s0 < L; s0 += 16) {
#pragma unroll
      for (int ss = 0; ss < 16; ++ss) {
        const int s = s0 + ss; const int row = rbase + b * L + s;
        float uv = stage == 0 ? bf2f(p.prep[(size_t)row * 768 + c]) : p.zbuf[(size_t)row * 256 + c];
#pragma unroll
        for (int k = 0; k < 16; ++k) acc[k] += win[(k + 16 - ss) & 15] * uv;
        int dl = t0 - (s + 1);
        float nv = 0.f;
        if (s + 1 < L) nv = dl >= 0 ? ff[(size_t)dl * 1024] : ff[(size_t)(-dl) * 1024 + 256];
        win[(15 + 16 - ss) & 15] = nv;
      }
    }
    const float dsk = p.hy_d[(layer * 2 + stage) * 256 + c];
#pragma unroll
    for (int k = 0; k < 16; ++k) {
      const int row = rbase + b * L + t0 + k;
      if (stage == 0) { float vv = bf2f(p.prep[(size_t)row * 768 + c]); float x1 = bf2f(p.prep[(size_t)row * 768 + 256 + c]); p.zbuf[(size_t)row * 256 + c] = x1 * (acc[k] + dsk * vv); }
      else { float zz = p.zbuf[(size_t)row * 256 + c]; float x2 = bf2f(p.prep[(size_t)row * 768 + 512 + c]); p.y[(size_t)row * D + 256 + c] = f2bf(x2 * (acc[k] + dsk * zz)); }
    }
  }
}

__device__ __forceinline__ void phase_hy_prep_t(CParams& p, int layer, int bid, int nb, int tid_, char* smem) {
  bf16_t (*tl)[72] = (bf16_t (*)[72])smem;
  const float* w = p.hy_conv_w + (size_t)layer * 3 * 768; const float* bs = p.hy_conv_b + layer * 768;
  for (int task = bid; task < NB * (SEQ / 64); task += nb) {
    int tid = tid_; asm volatile("" : "+v"(tid));
    const int b = task / (SEQ / 64), t0 = (task % (SEQ / 64)) * 64;
#pragma unroll 4
    for (int i = tid; i < 64 * 96; i += NT) { const int c6 = i >> 6, cq = (c6 * 43) >> 9  , ck = (i & 7) + 8 * (c6 - cq * 12), tl_ = ((i >> 3) & 7) + 8 * cq, t = t0 + tl_; const int row = b * SEQ + t;
      float o[8]; conv8(p.u, U_HY, row, t > 0 ? row - 1 : -1, t < SEQ - 1 ? row + 1 : -1, w, bs, ck * 8, o);
#pragma unroll
      for (int e = 0; e < 8; ++e) tl[ck * 8 + e][tl_] = f2bf(o[e]); }
    __syncthreads();
    for (int i = tid; i < 768 * 8; i += NT) { const int c = i >> 3, ch = i & 7; *(uint4*)(p.prep + ((size_t)(b * 768 + c)) * SEQ + t0 + ch * 8) = *(const uint4*)&tl[c][ch * 8]; }
    __syncthreads();
  }
}
#define FPAD(i) ((i) + (((i) >> 5) << 1))
struct FftLds { float2 x[16384 + 1024]; float2 t1[128]; float2 t0[128]; };
__device__ __forceinline__ float2 cmulf(float2 a, float2 b) { return make_float2(a.x * b.x - a.y * b.y, a.x * b.y + a.y * b.x); }
__device__ __forceinline__ float2 cmulcf(float2 a, float2 w) { return make_float2(a.x * w.x + a.y * w.y, a.y * w.x - a.x * w.y); }
__device__ __forceinline__ float2 caddf(float2 a, float2 b) { return make_float2(a.x + b.x, a.y + b.y); }
__device__ __forceinline__ float2 csubf(float2 a, float2 b) { return make_float2(a.x - b.x, a.y - b.y); }
template <bool INV> __device__ __forceinline__ void r4bf(float2& a0, float2& a1, float2& a2, float2& a3) {
  const float2 s0 = caddf(a0, a2), s1 = csubf(a0, a2), s2 = caddf(a1, a3), d = csubf(a1, a3);
  const float2 s3 = INV ? make_float2(-d.y, d.x) : make_float2(d.y, -d.x);
  a0 = caddf(s0, s2); a1 = caddf(s1, s3); a2 = csubf(s0, s2); a3 = csubf(s1, s3);
}
__device__ __forceinline__ float2 w16c(int k) {
  constexpr float C1 = 0.92387953251128674f, S1 = 0.38268343236508977f, R2 = 0.70710678118654752f;
  return k == 1 ? make_float2(C1, -S1) : k == 2 ? make_float2(R2, -R2) : k == 3 ? make_float2(S1, -C1) : k == 4 ? make_float2(0.f, -1.f) : k == 6 ? make_float2(-R2, -R2) :   make_float2(-C1, S1);
}
template <bool INV, int LQ, bool HALF = false>
__device__ __forceinline__ void fft_pass16(FftLds& L, int tid) {
  constexpr int Q = 1 << LQ;
#pragma unroll
  for (int i = 0; i < 2; ++i) {
    const int bf = tid + 512 * i, j = bf & (Q - 1), base = ((bf >> LQ) << (LQ + 4)) + j, k = j << (10 - LQ);
    float2 v[16];
#pragma unroll
    for (int s2 = 0; s2 < 16; ++s2) v[s2] = (HALF && !INV && s2 >= 8) ? make_float2(0.f, 0.f) : L.x[FPAD(base + s2 * Q)];
    const float2 w1 = cmulf(L.t1[k >> 7], L.t0[k & 127]), w2 = cmulf(w1, w1), w3 = cmulf(w2, w1), w4 = cmulf(w2, w2), w8 = cmulf(w4, w4), w12 = cmulf(w8, w4);
    const float2 wm[4] = {make_float2(1.f, 0.f), w1, w2, w3}, wn[4] = {make_float2(1.f, 0.f), w4, w8, w12};
    if (!INV) {
#pragma unroll
      for (int q = 0; q < 4; ++q) {
        if (HALF) { const float2 a0 = v[q], a1 = v[q + 4];
          v[q] = caddf(a0, a1); v[q + 4] = make_float2(a0.x + a1.y, a0.y - a1.x); v[q + 8] = csubf(a0, a1); v[q + 12] = make_float2(a0.x - a1.y, a0.y + a1.x); }
        else r4bf<false>(v[q], v[q + 4], v[q + 8], v[q + 12]); }
#pragma unroll
      for (int m = 1; m < 4; ++m)
#pragma unroll
        for (int q = 0; q < 4; ++q) { float2 t = v[q + 4 * m]; if (q > 0) t = cmulf(t, w16c(q * m)); v[q + 4 * m] = cmulf(t, wm[m]); }
#pragma unroll
      for (int m = 0; m < 4; ++m) { r4bf<false>(v[4 * m], v[4 * m + 1], v[4 * m + 2], v[4 * m + 3]);
#pragma unroll
        for (int n = 1; n < 4; ++n) v[4 * m + n] = cmulf(v[4 * m + n], wn[n]); }
    } else {
#pragma unroll
      for (int m = 0; m < 4; ++m) {
#pragma unroll
        for (int n = 1; n < 4; ++n) v[4 * m + n] = cmulcf(v[4 * m + n], wn[n]);
        r4bf<true>(v[4 * m], v[4 * m + 1], v[4 * m + 2], v[4 * m + 3]); }
#pragma unroll
      for (int m = 1; m < 4; ++m)
#pragma unroll
        for (int q = 0; q < 4; ++q) { float2 t = cmulcf(v[q + 4 * m], wm[m]); if (q > 0) t = cmulcf(t, w16c(q * m)); v[q + 4 * m] = t; }
#pragma unroll
      for (int q = 0; q < 4; ++q) {
        if (HALF) { const float2 c0 = v[q], c1 = v[q + 4], c2 = v[q + 8], c3 = v[q + 12]; const float2 s0 = caddf(c0, c2), s1 = csubf(c0, c2), s2 = caddf(c1, c3), d = csubf(c1, c3);
          v[q] = caddf(s0, s2); v[q + 4] = make_float2(s1.x - d.y, s1.y + d.x); }
        else r4bf<true>(v[q], v[q + 4], v[q + 8], v[q + 12]); }
    }
#pragma unroll
    for (int s2 = 0; s2 < ((HALF && INV) ? 8 : 16); ++s2) L.x[FPAD(base + s2 * Q)] = v[s2];
  }
  __syncthreads();
}
template <bool INV> __device__ __forceinline__ void fft_pass4_last(FftLds& L, int tid) {
#pragma unroll 2
  for (int i = 0; i < 8; ++i) { const int p0 = FPAD(4 * (tid + 512 * i));
    float4 u0 = *(const float4*)&L.x[p0], u1 = *(const float4*)&L.x[p0 + 2];
    float2 a0 = make_float2(u0.x, u0.y), a1 = make_float2(u0.z, u0.w), a2 = make_float2(u1.x, u1.y), a3 = make_float2(u1.z, u1.w);
    r4bf<INV>(a0, a1, a2, a3);
    *(float4*)&L.x[p0] = make_float4(a0.x, a0.y, a1.x, a1.y); *(float4*)&L.x[p0 + 2] = make_float4(a2.x, a2.y, a3.x, a3.y); }
  __syncthreads();
}
template <bool INV, bool HALF = false>
__device__ __forceinline__ void fft16k(FftLds& L, int tid) {
  if (!INV) { fft_pass16<false, 10, HALF>(L, tid); fft_pass16<false, 6>(L, tid); fft_pass16<false, 2>(L, tid); fft_pass4_last<false>(L, tid); }
  else { fft_pass4_last<true>(L, tid); fft_pass16<true, 2>(L, tid); fft_pass16<true, 6>(L, tid); fft_pass16<true, 10, HALF>(L, tid); }
}
__device__ __forceinline__ void phase_hy_fft(CParams& p, int layer, int bid, int nb, int tid_, char* smem) {
  FftLds& L = *(FftLds*)smem;
  for (int c = bid; c < 256; c += nb) {
    int tid = tid_; asm volatile("" : "+v"(tid));
    if (tid < 128) { float sn, cs; sincospif(-(float)tid / 64.f, &sn, &cs); L.t1[tid] = make_float2(cs, sn);
      sincospif(-(float)tid / 8192.f, &sn, &cs); L.t0[tid] = make_float2(cs, sn); }
#pragma unroll 1
    for (int o = 0; o < 2; ++o) {
      asm volatile("" : "+v"(tid));
      const float* hf = p.filt + (size_t)(o * 512 + c) * SEQ; const float* hb = p.filt + (size_t)(o * 512 + 256 + c) * SEQ;
      __syncthreads();
#pragma unroll 16
      for (int n = tid; n < 16384; n += NT) { float v = n < SEQ ? hf[n] : (n == SEQ ? 0.f : hb[16384 - n]); L.x[FPAD(n)] = make_float2(v, 0.f); }
      __syncthreads();
      fft16k<false>(L, tid);
      float2* specg = p.specg + (size_t)c * 16384;
#pragma unroll
      for (int k = 0; k < 32; ++k) { float2 v = L.x[FPAD(tid + 512 * k)]; specg[tid + 512 * k] = make_float2(v.x * (1.f / 16384.f), v.y * (1.f / 16384.f)); }
      const float dsk = p.hy_d[(layer * 2 + o) * 256 + c];
#pragma unroll 1
      for (int pr = 0; pr < 2; ++pr) {
        const int b0 = pr * 2, b1 = pr * 2 + 1;
        asm volatile("" : "+v"(tid));
        __syncthreads();
        if (o == 0) {
          const bf16_t* u0 = p.prep + ((size_t)(b0 * 768 + c)) * SEQ; const bf16_t* u1 = p.prep + ((size_t)(b1 * 768 + c)) * SEQ;
#pragma unroll 8
          for (int n2 = tid; n2 < SEQ / 2; n2 += NT) { unsigned x0 = *(const unsigned*)(u0 + 2 * n2), x1 = *(const unsigned*)(u1 + 2 * n2);
            *(float4*)&L.x[FPAD(2 * n2)] = make_float4(bf2f((bf16_t)(x0 & 0xffff)), bf2f((bf16_t)(x1 & 0xffff)), bf2f((bf16_t)(x0 >> 16)), bf2f((bf16_t)(x1 >> 16))); }
        } else {
          const float* u0 = p.zbuf + ((size_t)(b0 * 256 + c)) * SEQ; const float* u1 = p.zbuf + ((size_t)(b1 * 256 + c)) * SEQ;
#pragma unroll 8
          for (int n2 = tid; n2 < SEQ / 2; n2 += NT) { float2 x0 = *(const float2*)(u0 + 2 * n2), x1 = *(const float2*)(u1 + 2 * n2); *(float4*)&L.x[FPAD(2 * n2)] = make_float4(x0.x, x1.x, x0.y, x1.y); }
        }
        __syncthreads();
        fft16k<false, true>(L, tid);
#pragma unroll
        for (int k = 0; k < 32; ++k) { float2 v = L.x[FPAD(tid + 512 * k)]; L.x[FPAD(tid + 512 * k)] = cmulf(v, specg[tid + 512 * k]); }
        __syncthreads();
        fft16k<true, true>(L, tid);
        if (o == 0) {
          const bf16_t* v0 = p.prep + ((size_t)(b0 * 768 + c)) * SEQ; const bf16_t* v1 = p.prep + ((size_t)(b1 * 768 + c)) * SEQ;
          const bf16_t* g0 = p.prep + ((size_t)(b0 * 768 + 256 + c)) * SEQ; const bf16_t* g1 = p.prep + ((size_t)(b1 * 768 + 256 + c)) * SEQ;
          float* z0 = p.zbuf + ((size_t)(b0 * 256 + c)) * SEQ; float* z1 = p.zbuf + ((size_t)(b1 * 256 + c)) * SEQ;
#pragma unroll 8
          for (int n = tid; n < SEQ; n += NT) { float2 y = L.x[FPAD(n)]; z0[n] = bf2f(g0[n]) * (y.x + dsk * bf2f(v0[n])); z1[n] = bf2f(g1[n]) * (y.y + dsk * bf2f(v1[n])); }
        } else {
          const float* z0 = p.zbuf + ((size_t)(b0 * 256 + c)) * SEQ; const float* z1 = p.zbuf + ((size_t)(b1 * 256 + c)) * SEQ;
          float* y0 = p.yt + ((size_t)(b0 * 256 + c)) * SEQ; float* y1 = p.yt + ((size_t)(b1 * 256 + c)) * SEQ;
#pragma unroll 8
          for (int n = tid; n < SEQ; n += NT) { float2 y = L.x[FPAD(n)]; y0[n] = y.x + dsk * z0[n]; y1[n] = y.y + dsk * z1[n]; }
        }
      }
      __threadfence();
    }
    __syncthreads();
  }
}
__device__ __forceinline__ void phase_hy_fin(CParams& p, int bid, int nb, int tid_, char* smem) {
  bf16_t (*tl)[264] = (bf16_t (*)[264])smem;
  for (int task = bid; task < NB * (SEQ / 64); task += nb) {
    int tid = tid_; asm volatile("" : "+v"(tid));
    const int b = task / (SEQ / 64), t0 = (task % (SEQ / 64)) * 64;
#pragma unroll 8
    for (int i = tid; i < 256 * 64; i += NT) { const int t = i & 63, c = i >> 6;
      float v = bf2f(p.prep[((size_t)(b * 768 + 512 + c)) * SEQ + t0 + t]) * p.yt[((size_t)(b * 256 + c)) * SEQ + t0 + t];
      tl[t][c] = f2bf(v); }
    __syncthreads();
    for (int i = tid; i < 64 * 32; i += NT) { const int t = i >> 5, ch = i & 31; *(uint4*)(p.y + ((size_t)b * SEQ + t0 + t) * D + 256 + ch * 8) = *(const uint4*)&tl[t][ch * 8]; }
    __syncthreads();
  }
}

__device__ __forceinline__ void phase_mb_prep(CParams& p, int layer, int bid, int nb, int tid_) {
  const int lane = tid_ & 63, wv = tid_ >> 6;
  const float* w = p.mb_conv_w + (size_t)layer * 3 * 768; const float* bs = p.mb_conv_b + layer * 768;
  for (int row0 = (bid * NW + wv) * 4; row0 < TT; row0 += nb * NW * 4) {
    float o[4][2][8];
#pragma unroll
    for (int r = 0; r < 4; ++r) { const int row = row0 + r; const int rm = seq_nb(row, -1, true), rp = seq_nb(row, 1, true);
#pragma unroll
      for (int j = 0; j < 2; ++j) { const int ck = lane + 64 * j; if (ck < 96) conv8(p.u, U_MB + 256, row, rm, rp, w, bs, ck * 8, o[r][j]); } }
#pragma unroll
    for (int r = 0; r < 4; ++r) { const int row = row0 + r;
#pragma unroll
      for (int j = 0; j < 2; ++j) { const int ck = lane + 64 * j; if (ck < 96) {
#pragma unroll
          for (int e = 0; e < 8; ++e) o[r][j][e] = siluf(o[r][j][e]);
          uint4 pk; pk.x = pack2(o[r][j][0], o[r][j][1]); pk.y = pack2(o[r][j][2], o[r][j][3]); pk.z = pack2(o[r][j][4], o[r][j][5]); pk.w = pack2(o[r][j][6], o[r][j][7]); *(uint4*)(p.prep + (size_t)row * 768 + ck * 8) = pk; } }
      if (lane < 8) p.dt[(size_t)row * 8 + lane] = softplusf_(bf2f(p.u[(size_t)row * NU + U_MB + 1024 + lane]) + p.mb_dt_bias[layer * 8 + lane]); }
  }
}
__device__ __forceinline__ int mb_row(int b, int cpos, int i) {
  if (cpos < 4) return TL + b * CTX + cpos * 64 + i;
  const int n = cpos - 4; return b * SEQ + ((n & 1) * 64 + i) * 64 + (n >> 1);
}
struct MbLds {
  bf16_t bimg[64][136]; bf16_t cimg[64][136];
  bf16_t bt[128][72];
  bf16_t xt[2][64][72];
  bf16_t pm[2][64][72];
  float ox[64][65];
  float dtv[2][64], cum[2][64], tot[2]; int rows[64];
};
template <int PASS>
__device__ __forceinline__ void phase_mb_chunk(CParams& p, int layer, int bid, int nb, int tid_, char* smem) {
  MbLds& L = *(MbLds*)smem;
  const int c_lo = (PASS == 1 && layer == DEPTH - 1) ? 4 : 0, ncp = NCH - c_lo;
  uint4 pbc[4]; float pdt = 0.f;
#pragma unroll
  for (int q = 0; q < 4; ++q) pbc[q] = make_uint4(0u, 0u, 0u, 0u);
  auto mfetch = [&](int task_, int tid) { const int h_ = task_ & 3, cpos_ = c_lo + (task_ >> 2) % ncp, b_ = (task_ >> 2) / ncp, g_ = h_ >> 1;
#pragma unroll
    for (int q = 0; q < 4; ++q) { const int i = tid + q * NT, which = i >> 10, t = (i >> 4) & 63, ch = i & 15;
      pbc[q] = *(const uint4*)(p.prep + (size_t)mb_row(b_, cpos_, t) * 768 + 256 + which * 256 + g_ * 128 + ch * 8); }
    if (tid < 128) pdt = p.dt[(size_t)mb_row(b_, cpos_, tid & 63) * 8 + (tid >> 6) * 4 + h_]; };
  if (bid < NB * ncp * 4) mfetch(bid, tid_);
  for (int task = bid; task < NB * ncp * 4; task += nb) {
    int tid = tid_; asm volatile("" : "+v"(tid));
    const int lane = tid & 63, wv = tid >> 6, fr = lane & 15, fq = lane >> 4, dirw = wv >> 2, s4 = wv & 3;
    const int h = task & 3, cpos = c_lo + (task >> 2) % ncp, b = (task >> 2) / ncp, g = h >> 1;
    bf16x8 sfo[4][4]; float xsv[4][4], zzv[4][4];
    if (PASS == 1) { const bf16_t* sb0 = p.mb_l + ((size_t)((b * 4 + h) * 2 + dirw) * NCH + scan_idx(cpos, dirw)) * 8192;
#pragma unroll
      for (int ks = 0; ks < 4; ++ks)
#pragma unroll
        for (int n = 0; n < 4; ++n) sfo[ks][n] = *(const bf16x8*)(sb0 + (n * 16 + fr) * 128 + ks * 32 + fq * 8);
      if (dirw == 0) {
#pragma unroll
        for (int n = 0; n < 4; ++n)
#pragma unroll
          for (int q = 0; q < 4; ++q) { const int row = mb_row(b, cpos, s4 * 16 + fq * 4 + q), pc = n * 16 + fr;
            xsv[n][q] = bf2f(p.prep[(size_t)row * 768 + h * 64 + pc]); zzv[n][q] = bf2f(p.u[(size_t)row * NU + U_MB + h * 64 + pc]); } } }
    if (tid < 64) L.rows[tid] = mb_row(b, cpos, tid);
    if (tid < 128) L.dtv[tid >> 6][tid & 63] = pdt;
#pragma unroll
    for (int q = 0; q < 4; ++q) { const int i = tid + q * NT, which = i >> 10, t = (i >> 4) & 63, ch = i & 15; *(uint4*)(which ? &L.cimg[t][ch * 8] : &L.bimg[t][ch * 8]) = pbc[q]; }
    if (task + nb < NB * ncp * 4) mfetch(task + nb, tid);
    __syncthreads();
    if (wv < 2) { const int dir = wv, i = dir ? 63 - lane : lane; const float a = -__expf(p.mb_a_log[layer * 8 + dir * 4 + h]);
      float v = L.dtv[dir][i] * a;
#pragma unroll
      for (int o = 1; o < 64; o <<= 1) { const float t = __shfl_up(v, o); if (lane >= o) v += t; }
      L.cum[dir][i] = v; if (lane == 63) L.tot[dir] = v; }
    __syncthreads();
    if (PASS == 0) {
      for (int i = tid; i < 128 * 16; i += NT) { int n = i & 127, f0 = (i >> 7) * 4; uint2 pk;
        pk.x = (unsigned)L.bimg[f0][n] | ((unsigned)L.bimg[f0 + 1][n] << 16); pk.y = (unsigned)L.bimg[f0 + 2][n] | ((unsigned)L.bimg[f0 + 3][n] << 16);
        *(uint2*)&L.bt[n][f0] = pk; }
#pragma unroll
      for (int i = tid; i < 2 * 64 * 16; i += NT) { int pc = i & 63, f0 = ((i >> 6) & 15) * 4, dir = i >> 10; float v[4];
#pragma unroll
        for (int q = 0; q < 4; ++q) v[q] = bf2f(p.prep[(size_t)L.rows[f0 + q] * 768 + h * 64 + pc]) * L.dtv[dir][f0 + q] * __expf(L.tot[dir] - L.cum[dir][f0 + q]);
        uint2 pk; pk.x = pack2(v[0], v[1]); pk.y = pack2(v[2], v[3]); *(uint2*)&L.xt[dir][pc][f0] = pk; }
      __syncthreads();
      const int seq = (b * 4 + h) * 2 + dirw, nsc = scan_idx(cpos, dirw);
      f32x4 acc[2][4];
#pragma unroll
      for (int m = 0; m < 2; ++m)
#pragma unroll
        for (int n = 0; n < 4; ++n) acc[m][n] = (f32x4){0.f, 0.f, 0.f, 0.f};
      wmm<2, 4, 2, 72, 72>(acc, &L.bt[s4 * 32][0], &L.xt[dirw][0][0], fr, fq);
      bf16_t* dst = p.mb_l + ((size_t)seq * NCH + nsc) * 8192;
#pragma unroll
      for (int m = 0; m < 2; ++m)
#pragma unroll
        for (int n = 0; n < 4; ++n) { uint2 pk; pk.x = pack2(acc[m][n][0], acc[m][n][1]); pk.y = pack2(acc[m][n][2], acc[m][n][3]);
          *(uint2*)(dst + (n * 16 + fr) * 128 + s4 * 32 + m * 16 + fq * 4) = pk; }
      if (tid < 2) p.mb_dec[(size_t)((b * 4 + h) * 2 + tid) * NCH + scan_idx(cpos, tid)] = __expf(L.tot[tid]);
    } else {
#pragma unroll
      for (int i = tid; i < 64 * 16; i += NT) { int pc = i & 63, f0 = (i >> 6) * 4; uint2 pk; unsigned short v[4];
#pragma unroll
        for (int q = 0; q < 4; ++q) v[q] = p.prep[(size_t)L.rows[f0 + q] * 768 + h * 64 + pc];
        pk.x = (unsigned)v[0] | ((unsigned)v[1] << 16); pk.y = (unsigned)v[2] | ((unsigned)v[3] << 16); *(uint2*)&L.xt[0][pc][f0] = pk; }
      { f32x4 acc[4][1];
#pragma unroll
        for (int m = 0; m < 4; ++m) acc[m][0] = (f32x4){0.f, 0.f, 0.f, 0.f};
        wmm<4, 1, 4, 136, 136>(acc, &L.bimg[0][0], &L.cimg[s4 * 16][0], fr, fq);
        const int i = s4 * 16 + fr; const float ci = L.cum[dirw][i];
#pragma unroll
        for (int m = 0; m < 4; ++m) { float v[4];
#pragma unroll
          for (int q = 0; q < 4; ++q) { int j = m * 16 + fq * 4 + q; bool keep = dirw == 0 ? (j <= i) : (j >= i);
            v[q] = keep ? acc[m][0][q] * __expf(ci - L.cum[dirw][j]) * L.dtv[dirw][j] : 0.f; }
          uint2 pk; pk.x = pack2(v[0], v[1]); pk.y = pack2(v[2], v[3]); *(uint2*)&L.pm[dirw][i][m * 16 + fq * 4] = pk; } }
      __syncthreads();
      f32x4 ao[1][4];
#pragma unroll
      for (int n = 0; n < 4; ++n) ao[0][n] = (f32x4){0.f, 0.f, 0.f, 0.f};
      {
#pragma unroll
        for (int ks = 0; ks < 4; ++ks) { bf16x8 a = *(const bf16x8*)&L.cimg[s4 * 16 + fr][ks * 32 + fq * 8];
#pragma unroll
          for (int n = 0; n < 4; ++n) ao[0][n] = __builtin_amdgcn_mfma_f32_16x16x32_bf16(a, sfo[ks][n], ao[0][n], 0, 0, 0); } }
#pragma unroll
      for (int q = 0; q < 4; ++q) { const float e = __expf(L.cum[dirw][s4 * 16 + fq * 4 + q]);
#pragma unroll
        for (int n = 0; n < 4; ++n) ao[0][n][q] *= e; }
      wmm<1, 4, 2, 72, 72>(ao, &L.pm[dirw][s4 * 16][0], &L.xt[0][0][0], fr, fq);
      if (dirw == 1) {
#pragma unroll
        for (int n = 0; n < 4; ++n)
#pragma unroll
          for (int q = 0; q < 4; ++q) L.ox[s4 * 16 + fq * 4 + q][n * 16 + fr] = ao[0][n][q]; }
      __syncthreads();
      if (dirw == 0) {
        const float dsk = p.mb_d[layer * 4 + h];
        float ss[4] = {0.f, 0.f, 0.f, 0.f};
#pragma unroll
        for (int n = 0; n < 4; ++n)
#pragma unroll
          for (int q = 0; q < 4; ++q) { const int i = s4 * 16 + fq * 4 + q, pc = n * 16 + fr;
            float v = (ao[0][n][q] + L.ox[i][pc] + xsv[n][q] * dsk) * siluf(zzv[n][q]); ao[0][n][q] = v; ss[q] += v * v; }
#pragma unroll
        for (int q = 0; q < 4; ++q) {
#pragma unroll
          for (int o = 1; o < 16; o <<= 1) ss[q] += __shfl_xor(ss[q], o);
          ss[q] = rsqrtf(ss[q] * (1.f / 64.f) + 1e-6f); }
#pragma unroll
        for (int n = 0; n < 4; ++n) { const int c = h * 64 + n * 16 + fr; const float nw = p.mb_norm[layer * 256 + c];
#pragma unroll
          for (int q = 0; q < 4; ++q) p.y[(size_t)L.rows[s4 * 16 + fq * 4 + q] * D + 512 + c] = f2bf(ao[0][n][q] * ss[q] * nw); }
      }
    }
    __syncthreads();
  }
}
__device__ __forceinline__ void phase_mb_state(CParams& p, int bid, int nb, int tid_) {
  for (int i = bid * NT + tid_; i < 32 * 4096; i += nb * NT) {
    const int seq = i >> 12, e2 = (i & 4095) * 2;
    unsigned* lp = (unsigned*)(p.mb_l + (size_t)seq * NCH * 8192 + e2);
    const float* dp = p.mb_dec + (size_t)seq * NCH;
    float s0 = 0.f, s1 = 0.f;
    for (int n = 0; n < NCH; n += 12) {
      unsigned lv[12]; float dc[12];
#pragma unroll
      for (int q = 0; q < 12; ++q) { lv[q] = lp[(size_t)(n + q) * 4096]; dc[q] = dp[n + q]; }
#pragma unroll
      for (int q = 0; q < 12; ++q) { lp[(size_t)(n + q) * 4096] = pack2(s0, s1); s0 = s0 * dc[q] + bf2f((bf16_t)(lv[q] & 0xffff)); s1 = s1 * dc[q] + bf2f((bf16_t)(lv[q] >> 16)); }
    }
  }
}

__device__ __forceinline__ void phase_dn_prep(CParams& p, int layer, int bid, int nb, int tid_) {
  const int lane = tid_ & 63, wv = tid_ >> 6;
  const float* w = p.dn_conv_w + (size_t)layer * 3 * 768;
  for (int row0 = (bid * NW + wv) * 4; row0 < TT; row0 += nb * NW * 4) {
   float oo[4][2][8];
#pragma unroll
   for (int r = 0; r < 4; ++r) { const int row = row0 + r; const int rm = seq_nb(row, -1, false), rp = seq_nb(row, 1, false);
#pragma unroll
     for (int j = 0; j < 2; ++j) { const int ck = lane + 64 * j; if (ck < 96) conv8(p.u, U_DN, row, rm, rp, w, nullptr, ck * 8, oo[r][j]); } }
#pragma unroll
   for (int r = 0; r < 4; ++r) { const int row = row0 + r;
#pragma unroll
    for (int j = 0; j < 2; ++j) { const int ck = lane + 64 * j;
      if (ck < 96) { float (&o)[8] = oo[r][j];
        float ss = 0.f;
#pragma unroll
        for (int e = 0; e < 8; ++e) { o[e] = siluf(o[e]); ss += o[e] * o[e]; }
        if (j == 0) { ss += __shfl_xor(ss, 1); ss += __shfl_xor(ss, 2); ss += __shfl_xor(ss, 4); const float r = rsqrtf(ss + 1e-6f) * (ck < 32 ? 0.125f : 1.f);
#pragma unroll
          for (int e = 0; e < 8; ++e) o[e] *= r; }
        uint4 pk; pk.x = pack2(o[0], o[1]); pk.y = pack2(o[2], o[3]); pk.z = pack2(o[4], o[5]); pk.w = pack2(o[6], o[7]); *(uint4*)(p.prep + (size_t)row * 768 + ck * 8) = pk; } }
    if (lane < 8) {
      float beta = sigmoidf_(bf2f(p.u[(size_t)row * NU + U_DN + 1024 + lane]));
      float g = -__expf(p.dn_a_log[layer * 8 + lane]) * softplusf_(bf2f(p.u[(size_t)row * NU + U_DN + 1032 + lane]) + p.dn_dt_bias[layer * 8 + lane]);
      p.bg[(size_t)row * 16 + lane * 2] = beta; p.bg[(size_t)row * 16 + lane * 2 + 1] = g;
    }
   }
  }
}
struct DnLds {
  bf16_t q[64][72], k[64][72], v[64][72];
  float md[2][4][16][17];
  bf16_t msb[2][64][72];
  bf16_t td[2][4][16][40];
  bf16_t tmp[8][32][40];
  bf16_t a1[2][64][72];
  bf16_t wq[2][64][72];
  bf16_t ut[2][64][72];
  float ox[64][65];
  float beta[2][64], gl[2][64], cum[2][64], tot[2];
};
template <int PASS>
__device__ __forceinline__ void phase_dn_chunk(CParams& p, int layer, int bid, int nb, int tid_, char* smem) {
  DnLds& L = *(DnLds*)smem;
  const int c_lo = (PASS == 1 && layer == DEPTH - 1) ? 4 : 0, ncp = NCH - c_lo;
  uint4 pq = make_uint4(0u, 0u, 0u, 0u), pk_ = pq, pv = pq; float2 pbg = make_float2(0.f, 0.f);
  auto fetch = [&](int task_, int tid) { const int h_ = task_ & 3, cpos_ = c_lo + (task_ >> 2) % ncp, b_ = (task_ >> 2) / ncp; const int r0_ = chunk_row0(b_, cpos_);
    if (tid < 128) pbg = *(const float2*)(p.bg + (size_t)(r0_ + (tid & 63)) * 16 + ((tid >> 6) * 4 + h_) * 2);
    const bf16_t* src = p.prep + (size_t)(r0_ + (tid >> 3)) * 768 + h_ * 64 + (tid & 7) * 8;
    if (PASS == 1) pq = *(const uint4*)src;
    pk_ = *(const uint4*)(src + 256); pv = *(const uint4*)(src + 512); };
  if (bid < NB * ncp * 4) fetch(bid, tid_);
  for (int task = bid; task < NB * ncp * 4; task += nb) {
    int tid = tid_; asm volatile("" : "+v"(tid));
    const int lane = tid & 63, wv = tid >> 6, fr = lane & 15, fq = lane >> 4, dirw = wv >> 2, s4 = wv & 3;
    const int h = task & 3, cpos = c_lo + (task >> 2) % ncp, b = (task >> 2) / ncp;
    const int row0 = chunk_row0(b, cpos);
    bf16x8 sfr[2], sfo[2][4]; float ogv[4][4];
    if (PASS == 1) { const bf16_t* sb0 = p.dn_l + ((size_t)((b * 4 + h) * 2 + dirw) * NCH + scan_idx(cpos, dirw)) * 4096;
#pragma unroll
      for (int ks = 0; ks < 2; ++ks) { sfr[ks] = *(const bf16x8*)(sb0 + (s4 * 16 + fr) * 64 + ks * 32 + fq * 8);
#pragma unroll
        for (int n = 0; n < 4; ++n) sfo[ks][n] = *(const bf16x8*)(sb0 + (n * 16 + fr) * 64 + ks * 32 + fq * 8); }
#pragma unroll
      for (int n = 0; n < 4; ++n)
#pragma unroll
        for (int qq = 0; qq < 4; ++qq) ogv[n][qq] = bf2f(p.u[(size_t)(row0 + s4 * 16 + fq * 4 + qq) * NU + U_DN + 768 + h * 64 + n * 16 + fr]); }
    if (tid < 128) { L.beta[tid >> 6][tid & 63] = pbg.x; L.gl[tid >> 6][tid & 63] = pbg.y; }
    { const int t = tid >> 3, ch = tid & 7;
      if (PASS == 1) *(uint4*)&L.q[t][ch * 8] = pq;
      *(uint4*)&L.k[t][ch * 8] = pk_; *(uint4*)&L.v[t][ch * 8] = pv; }
    if (task + nb < NB * ncp * 4) fetch(task + nb, tid);
    for (int i = tid; i < (int)(sizeof(L.td) / 16); i += NT) ((uint4*)&L.td[0][0][0][0])[i] = make_uint4(0u, 0u, 0u, 0u);
    for (int i = tid; i < (int)(sizeof(L.tmp) / 16); i += NT) ((uint4*)&L.tmp[0][0][0])[i] = make_uint4(0u, 0u, 0u, 0u);
    for (int i = tid; i < (int)(sizeof(L.ut) / 16); i += NT) { ((uint4*)&L.ut[0][0][0])[i] = make_uint4(0u, 0u, 0u, 0u); ((uint4*)&L.wq[0][0][0])[i] = make_uint4(0u, 0u, 0u, 0u); }
    __syncthreads();
    if (wv < 2) { const int dir = wv, f = dir ? 63 - lane : lane;
      float v = L.gl[dir][f];
#pragma unroll
      for (int o = 1; o < 64; o <<= 1) { const float t = __shfl_up(v, o); if (lane >= o) v += t; }
      L.cum[dir][f] = v; if (lane == 63) L.tot[dir] = v; }
    __syncthreads();
    { f32x4 acc[4][1];
#pragma unroll
      for (int m = 0; m < 4; ++m) acc[m][0] = (f32x4){0.f, 0.f, 0.f, 0.f};
      wmm<4, 1, 2, 72, 72>(acc, &L.k[0][0], &L.k[s4 * 16][0], fr, fq);
      const int j = s4 * 16 + fr; const float cj = L.cum[dirw][j]; const int sj = dirw ? 63 - j : j;
#pragma unroll
      for (int m = 0; m < 4; ++m)
#pragma unroll
        for (int qq = 0; qq < 4; ++qq) { const int i = m * 16 + fq * 4 + qq, si = dirw ? 63 - i : i; const bool keep = sj < si;
          const float v = keep ? L.beta[dirw][i] * acc[m][0][qq] * __expf(L.cum[dirw][i] - cj) : 0.f;
          L.msb[dirw][si][sj] = f2bf(v);
          if ((si >> 4) == (sj >> 4)) L.md[dirw][si >> 4][sj & 15][si & 15] = v; } }
    __syncthreads();
    if (wv < 2) { const int dir = wv, d = lane >> 4, c = lane & 15;
      float x[16];
#pragma unroll
      for (int s = 0; s < 16; ++s) x[s] = s == c ? 1.f : 0.f;
#pragma unroll
      for (int t = 0; t < 15; ++t) { const float xt = x[t];
#pragma unroll
        for (int s = t + 1; s < 16; ++s) x[s] -= L.md[dir][d][t][s] * xt; }
#pragma unroll
      for (int s = 0; s < 16; ++s) L.td[dir][d][s][c] = f2bf(x[s]); }
    __syncthreads();
    { bf16_t* xb = s4 < 2 ? &L.ut[dirw][s4 * 32][0] : &L.wq[dirw][(s4 - 2) * 32][0];
      const bf16_t (*src)[72] = s4 < 2 ? L.v : L.k; const int cb = (s4 & 1) * 32;
#pragma unroll
      for (int I = 0; I < 4; ++I) {
        f32x4 acc[1][2];
#pragma unroll
        for (int nt = 0; nt < 2; ++nt)
#pragma unroll
          for (int qq = 0; qq < 4; ++qq) { const int s = I * 16 + fq * 4 + qq, f = dirw ? 63 - s : s; const float sc = s4 < 2 ? L.beta[dirw][f] : L.beta[dirw][f] * __expf(L.cum[dirw][f]);
            acc[0][nt][qq] = sc * bf2f(src[f][cb + nt * 16 + fr]); }
        if (I > 0) { f32x4 pr[1][2] = {{{0.f, 0.f, 0.f, 0.f}, {0.f, 0.f, 0.f, 0.f}}};
          wmm<1, 2, 2, 72, 72>(pr, &L.msb[dirw][I * 16][0], xb, fr, fq);
#pragma unroll
          for (int nt = 0; nt < 2; ++nt) acc[0][nt] -= pr[0][nt]; }
#pragma unroll
        for (int nt = 0; nt < 2; ++nt) { uint2 pk; pk.x = pack2(acc[0][nt][0], acc[0][nt][1]); pk.y = pack2(acc[0][nt][2], acc[0][nt][3]); *(uint2*)&L.tmp[wv][nt * 16 + fr][fq * 4] = pk; }
        asm volatile("" ::: "memory");
        f32x4 xs[1][2] = {{{0.f, 0.f, 0.f, 0.f}, {0.f, 0.f, 0.f, 0.f}}};
        wmm<1, 2, 1, 40, 40>(xs, &L.td[dirw][I][0][0], &L.tmp[wv][0][0], fr, fq);
#pragma unroll
        for (int nt = 0; nt < 2; ++nt) { uint2 pk; pk.x = pack2(xs[0][nt][0], xs[0][nt][1]); pk.y = pack2(xs[0][nt][2], xs[0][nt][3]); *(uint2*)(xb + (nt * 16 + fr) * 72 + I * 16 + fq * 4) = pk; }
        asm volatile("" ::: "memory");
      } }
    if (PASS == 0) {
      for (int i = tid; i < 2 * 64 * 16; i += NT) { int d = i & 63, f0 = ((i >> 6) & 15) * 4, dir = i >> 10; float v[4];
#pragma unroll
        for (int qq = 0; qq < 4; ++qq) v[qq] = bf2f(L.k[f0 + qq][d]) * __expf(L.tot[dir] - L.cum[dir][f0 + qq]);
        uint2 pk;
        if (dir == 0) { pk.x = pack2(v[0], v[1]); pk.y = pack2(v[2], v[3]); *(uint2*)&L.a1[0][d][f0] = pk; }
        else { pk.x = pack2(v[3], v[2]); pk.y = pack2(v[1], v[0]); *(uint2*)&L.a1[1][d][60 - f0] = pk; } }
      __syncthreads();
      const int seq = (b * 4 + h) * 2 + dirw, nsc = scan_idx(cpos, dirw); const float dec = __expf(L.tot[dirw]);
      { f32x4 acc[4][1];
#pragma unroll
        for (int m = 0; m < 4; ++m) acc[m][0] = (f32x4){0.f, 0.f, 0.f, 0.f};
        wmm<4, 1, 2, 72, 72>(acc, &L.wq[dirw][0][0], &L.a1[dirw][s4 * 16][0], fr, fq);
        const int d = s4 * 16 + fr; bf16_t* dst = p.dn_m + ((size_t)seq * NCH + nsc) * 4096 + d * 64;
#pragma unroll
        for (int m = 0; m < 4; ++m) { float v[4];
#pragma unroll
          for (int qq = 0; qq < 4; ++qq) { int d2 = m * 16 + fq * 4 + qq; v[qq] = (d2 == d ? dec : 0.f) - acc[m][0][qq]; }
          uint2 pk; pk.x = pack2(v[0], v[1]); pk.y = pack2(v[2], v[3]); *(uint2*)(dst + m * 16 + fq * 4) = pk; } }
      { f32x4 acc[4][1];
#pragma unroll
        for (int m = 0; m < 4; ++m) acc[m][0] = (f32x4){0.f, 0.f, 0.f, 0.f};
        wmm<4, 1, 2, 72, 72>(acc, &L.a1[dirw][0][0], &L.ut[dirw][s4 * 16][0], fr, fq);
        bf16_t* dst = p.dn_l + ((size_t)seq * NCH + nsc) * 4096 + (s4 * 16 + fr) * 64;
#pragma unroll
        for (int m = 0; m < 4; ++m) { uint2 pk; pk.x = pack2(acc[m][0][0], acc[m][0][1]); pk.y = pack2(acc[m][0][2], acc[m][0][3]); *(uint2*)(dst + m * 16 + fq * 4) = pk; } }
    } else {
      __syncthreads();
      for (int i = tid; i < 2 * 64 * 16; i += NT) { int d = i & 63, s0 = ((i >> 6) & 15) * 4, dir = i >> 10; const uint2 wv2 = *(const uint2*)&L.wq[dir][d][s0];
        L.a1[dir][s0][d] = (bf16_t)(wv2.x & 0xffff); L.a1[dir][s0 + 1][d] = (bf16_t)(wv2.x >> 16); L.a1[dir][s0 + 2][d] = (bf16_t)(wv2.y & 0xffff); L.a1[dir][s0 + 3][d] = (bf16_t)(wv2.y >> 16); }
      __syncthreads();
      { f32x4 acc[4][1];
#pragma unroll
        for (int m = 0; m < 4; ++m) acc[m][0] = (f32x4){0.f, 0.f, 0.f, 0.f};
#pragma unroll
        for (int ks = 0; ks < 2; ++ks)
#pragma unroll
          for (int m = 0; m < 4; ++m) { bf16x8 a = *(const bf16x8*)&L.a1[dirw][m * 16 + fr][ks * 32 + fq * 8]; acc[m][0] = __builtin_amdgcn_mfma_f32_16x16x32_bf16(a, sfr[ks], acc[m][0], 0, 0, 0); }
        const int c = s4 * 16 + fr;
#pragma unroll
        for (int m = 0; m < 4; ++m) { uint2 uu = *(const uint2*)&L.ut[dirw][c][m * 16 + fq * 4];
          float v0 = bf2f((bf16_t)(uu.x & 0xffff)) - acc[m][0][0], v1 = bf2f((bf16_t)(uu.x >> 16)) - acc[m][0][1], v2 = bf2f((bf16_t)(uu.y & 0xffff)) - acc[m][0][2], v3 = bf2f((bf16_t)(uu.y >> 16)) - acc[m][0][3];
          uint2 pk; pk.x = pack2(v0, v1); pk.y = pack2(v2, v3); *(uint2*)&L.ut[dirw][c][m * 16 + fq * 4] = pk; } }
      { f32x4 acc[4][1];
#pragma unroll
        for (int m = 0; m < 4; ++m) acc[m][0] = (f32x4){0.f, 0.f, 0.f, 0.f};
        wmm<4, 1, 2, 72, 72>(acc, &L.k[0][0], &L.q[s4 * 16][0], fr, fq);
        const int i = s4 * 16 + fr; const float ci = L.cum[dirw][i];
#pragma unroll
        for (int m = 0; m < 4; ++m) { float v[4];
#pragma unroll
          for (int qq = 0; qq < 4; ++qq) { int j = m * 16 + fq * 4 + qq; bool keep = dirw == 0 ? (j <= i) : (j >= i); v[qq] = keep ? acc[m][0][qq] * __expf(ci - L.cum[dirw][j]) : 0.f; }
          uint2 pk;
          if (dirw == 0) { pk.x = pack2(v[0], v[1]); pk.y = pack2(v[2], v[3]); *(uint2*)&L.wq[0][i][m * 16 + fq * 4] = pk; }
          else { pk.x = pack2(v[3], v[2]); pk.y = pack2(v[1], v[0]); *(uint2*)&L.wq[1][i][60 - m * 16 - fq * 4] = pk; } } }
      __syncthreads();
      f32x4 ao[1][4];
#pragma unroll
      for (int n = 0; n < 4; ++n) ao[0][n] = (f32x4){0.f, 0.f, 0.f, 0.f};
#pragma unroll
      for (int ks = 0; ks < 2; ++ks) { bf16x8 a = *(const bf16x8*)&L.q[s4 * 16 + fr][ks * 32 + fq * 8];
#pragma unroll
        for (int n = 0; n < 4; ++n) ao[0][n] = __builtin_amdgcn_mfma_f32_16x16x32_bf16(a, sfo[ks][n], ao[0][n], 0, 0, 0); }
#pragma unroll
      for (int qq = 0; qq < 4; ++qq) { const float e = __expf(L.cum[dirw][s4 * 16 + fq * 4 + qq]);
#pragma unroll
        for (int n = 0; n < 4; ++n) ao[0][n][qq] *= e; }
      wmm<1, 4, 2, 72, 72>(ao, &L.wq[dirw][s4 * 16][0], &L.ut[dirw][0][0], fr, fq);
      if (dirw == 1) {
#pragma unroll
        for (int n = 0; n < 4; ++n)
#pragma unroll
          for (int qq = 0; qq < 4; ++qq) L.ox[s4 * 16 + fq * 4 + qq][n * 16 + fr] = ao[0][n][qq]; }
      __syncthreads();
      if (dirw == 0) {
        float ss[4] = {0.f, 0.f, 0.f, 0.f};
#pragma unroll
        for (int n = 0; n < 4; ++n)
#pragma unroll
          for (int qq = 0; qq < 4; ++qq) { ao[0][n][qq] += L.ox[s4 * 16 + fq * 4 + qq][n * 16 + fr]; ss[qq] += ao[0][n][qq] * ao[0][n][qq]; }
#pragma unroll
        for (int qq = 0; qq < 4; ++qq) {
#pragma unroll
          for (int o = 1; o < 16; o <<= 1) ss[qq] += __shfl_xor(ss[qq], o);
          ss[qq] = rsqrtf(ss[qq] * (1.f / 64.f) + 1e-6f); }
#pragma unroll
        for (int n = 0; n < 4; ++n) { const int c = h * 64 + n * 16 + fr; const float nw = p.dn_norm[layer * 256 + c];
#pragma unroll
          for (int qq = 0; qq < 4; ++qq) { const int f = s4 * 16 + fq * 4 + qq;
            p.y[(size_t)(row0 + f) * D + 768 + c] = f2bf(ao[0][n][qq] * ss[qq] * nw * siluf(ogv[n][qq])); } }
      }
    }
    __syncthreads();
  }
}
struct DnBLds { bf16_t sh[2][64][72]; bf16_t sl[2][64][72]; };
__device__ __forceinline__ void phase_dn_state(CParams& p, int bid, int nb, int tid_, char* smem) {
  DnBLds& L = *(DnBLds*)smem;
  const int tid = tid_, lane = tid & 63, wv = tid >> 6, fr = lane & 15, fq = lane >> 4, mt = wv >> 1, ntb = (wv & 1) * 2;
  for (int seq = bid; seq < 32; seq += nb) {
    for (int i = tid; i < 64 * 72 / 2; i += NT) { ((unsigned*)&L.sh[0][0][0])[i] = 0u; ((unsigned*)&L.sl[0][0][0])[i] = 0u; }
    __syncthreads();
    f32x4 S[2] = {{0.f, 0.f, 0.f, 0.f}, {0.f, 0.f, 0.f, 0.f}};
    const bf16_t* mb = p.dn_m + (size_t)seq * NCH * 4096 + (mt * 16 + fr) * 64 + fq * 8;
    bf16x8 a[2]; a[0] = *(const bf16x8*)mb; a[1] = *(const bf16x8*)(mb + 32);
    uint2* lbase[2]; uint2 lvn[2];
#pragma unroll
    for (int t = 0; t < 2; ++t) { lbase[t] = (uint2*)(p.dn_l + (size_t)seq * NCH * 4096 + ((ntb + t) * 16 + fr) * 64 + mt * 16 + fq * 4); lvn[t] = *lbase[t]; }
    for (int n = 0; n < NCH; ++n) {
      const int cur = n & 1;
      f32x4 acc[2];
#pragma unroll
      for (int t = 0; t < 2; ++t) { uint2* lp = lbase[t] + (size_t)n * 1024;
        const uint2 lv = lvn[t]; uint2 sv; sv.x = pack2(S[t][0], S[t][1]); sv.y = pack2(S[t][2], S[t][3]); *lp = sv;
        acc[t] = (f32x4){bf2f((bf16_t)(lv.x & 0xffff)), bf2f((bf16_t)(lv.x >> 16)), bf2f((bf16_t)(lv.y & 0xffff)), bf2f((bf16_t)(lv.y >> 16))}; }
      bf16x8 an[2] = {a[0], a[1]};
      if (n + 1 < NCH) { an[0] = *(const bf16x8*)(mb + (size_t)(n + 1) * 4096); an[1] = *(const bf16x8*)(mb + (size_t)(n + 1) * 4096 + 32);
#pragma unroll
        for (int t = 0; t < 2; ++t) lvn[t] = *(lbase[t] + (size_t)(n + 1) * 1024); }
#pragma unroll
      for (int ks = 0; ks < 2; ++ks)
#pragma unroll
        for (int t = 0; t < 2; ++t) { bf16x8 bh = *(const bf16x8*)&L.sh[cur][(ntb + t) * 16 + fr][ks * 32 + fq * 8], bl = *(const bf16x8*)&L.sl[cur][(ntb + t) * 16 + fr][ks * 32 + fq * 8];
          acc[t] = __builtin_amdgcn_mfma_f32_16x16x32_bf16(a[ks], bh, acc[t], 0, 0, 0); acc[t] = __builtin_amdgcn_mfma_f32_16x16x32_bf16(a[ks], bl, acc[t], 0, 0, 0); }
#pragma unroll
      for (int t = 0; t < 2; ++t) { S[t] = acc[t]; float hi[4], lo[4];
#pragma unroll
        for (int q = 0; q < 4; ++q) { hi[q] = bf2f(f2bf(acc[t][q])); lo[q] = acc[t][q] - hi[q]; }
        uint2 ph, pl; ph.x = pack2(hi[0], hi[1]); ph.y = pack2(hi[2], hi[3]); pl.x = pack2(lo[0], lo[1]); pl.y = pack2(lo[2], lo[3]);
        *(uint2*)&L.sh[cur ^ 1][(ntb + t) * 16 + fr][mt * 16 + fq * 4] = ph; *(uint2*)&L.sl[cur ^ 1][(ntb + t) * 16 + fr][mt * 16 + fq * 4] = pl; }
      a[0] = an[0]; a[1] = an[1];
      asm volatile("s_waitcnt lgkmcnt(0)" ::: "memory"); __builtin_amdgcn_s_barrier();
    }
    __syncthreads();
  }
}

__device__ __forceinline__ void row_router(CParams& p, const float4* rts, const float (&hv)[16], int lane, int row) {
  float lg[16];
#pragma unroll
  for (int e = 0; e < 16; ++e) lg[e] = 0.f;
#pragma unroll
  for (int i = 0; i < 4; ++i)
#pragma unroll
    for (int j = 0; j < 4; ++j) { float hvv = hv[i * 4 + j];
#pragma unroll
      for (int q = 0; q < 4; ++q) { float4 r4 = rts[((i * 4 + j) * 4 + q) * 64 + lane]; lg[q * 4] += hvv * r4.x; lg[q * 4 + 1] += hvv * r4.y; lg[q * 4 + 2] += hvv * r4.z; lg[q * 4 + 3] += hvv * r4.w; }
      if (j & 1) asm volatile("" ::: "memory"); }
  float mx = -1e30f;
#pragma unroll
  for (int e = 0; e < 16; ++e) { lg[e] = wave_sum(lg[e]); mx = fmaxf(mx, lg[e]); }
  float den = 0.f;
#pragma unroll
  for (int e = 0; e < 16; ++e) { lg[e] = __expf(lg[e] - mx); den += lg[e]; }
  float inv = 1.f / den;
  if (lane < 16) { float v = 0.f;
#pragma unroll
    for (int e = 0; e < 16; ++e) v = lane == e ? lg[e] * inv : v;
    p.aff[(size_t)row * 16 + lane] = v; }
}
__device__ __forceinline__ void phase_postmix(CParams& p, int layer, int bid, int nb, int tid_, char* smem) {
  const int lane = tid_ & 63, wv = tid_ >> 6;
  float4* rts = (float4*)smem;
  for (int x = tid_; x < D * 4; x += NT) { const int ln = x & 63, q = (x >> 6) & 3, ij = x >> 8, k = (ij >> 2) * 256 + ln * 4 + (ij & 3); rts[x] = *(const float4*)(p.moe_router + ((size_t)layer * D + k) * 16 + q * 4); }
  __syncthreads();
  const int nrows = layer == 0 ? TT : TL, stride = nb * NW;
  const float* ng1 = p.norm_g + (size_t)layer * 4 * D + 1 * D;
  for (int row0 = bid * NW + wv; row0 < nrows; row0 += 2 * stride) {
    int rows[2] = {row0, row0 + stride}; const bool val1 = rows[1] < nrows; if (!val1) rows[1] = row0;
    uint2 yr[2][4]; float4 xr[2][4];
#pragma unroll
    for (int r = 0; r < 2; ++r) { const int row = rows[r];
      const float* xsrc = layer == 0 ? (row < TL ? p.x + (size_t)row * D : p.ctx + (size_t)(row - TL) * D) : xrow_ptr(p, row);
#pragma unroll
      for (int i = 0; i < 4; ++i) { yr[r][i] = *(const uint2*)(p.yo + (size_t)row * D + i * 256 + lane * 4); xr[r][i] = *(const float4*)(xsrc + i * 256 + lane * 4); } }
#pragma unroll
    for (int r = 0; r < 2; ++r) { if (r == 1 && !val1) break;
      const int row = rows[r]; float* xs = xrow_ptr(p, row);
      const float* m = p.mod + (size_t)(layer * 5 + mod_idx(row)) * 6 * D;
      float yv[16], xv[16], hv[16]; float ss = 0.f;
#pragma unroll
      for (int i = 0; i < 4; ++i) { const uint2 v = yr[r][i]; yv[i * 4] = __uint_as_float(v.x << 16); yv[i * 4 + 1] = __uint_as_float(v.x & 0xffff0000u); yv[i * 4 + 2] = __uint_as_float(v.y << 16); yv[i * 4 + 3] = __uint_as_float(v.y & 0xffff0000u); }
#pragma unroll
      for (int i = 0; i < 16; ++i) ss += yv[i] * yv[i];
      ss = wave_sum(ss);
      const float rstd = rsqrtf(ss * (1.f / D) + 1e-6f);
#pragma unroll
      for (int i = 0; i < 4; ++i) { const int k = i * 256 + lane * 4; const float4 xo = xr[r][i]; const float4 gg = *(const float4*)(ng1 + k); const float4 g1 = *(const float4*)(m + 2 * D + k);
        xv[i * 4] = xo.x + g1.x * yv[i * 4] * rstd * gg.x; xv[i * 4 + 1] = xo.y + g1.y * yv[i * 4 + 1] * rstd * gg.y; xv[i * 4 + 2] = xo.z + g1.z * yv[i * 4 + 2] * rstd * gg.z; xv[i * 4 + 3] = xo.w + g1.w * yv[i * 4 + 3] * rstd * gg.w;
        *(float4*)(xs + k) = make_float4(xv[i * 4], xv[i * 4 + 1], xv[i * 4 + 2], xv[i * 4 + 3]); }
      row_modulate_store(xv, p.norm_g + (size_t)layer * 4 * D + 2 * D, m + 3 * D, m + 4 * D, p.hb + (size_t)row * D, lane, hv);
      row_router(p, rts, hv, lane, row);
    }
  }
}
struct TkLds { unsigned key[SEQ]; unsigned hist[NW][256]; unsigned part[NT]; unsigned sh[4]; };
__device__ __forceinline__ void phase_topk(CParams& p, int layer, int bid, int nb, int tid_, char* smem) {
  TkLds& L = *(TkLds*)smem;
  if (layer == 0) for (int i = bid * NT + tid_; i < NE * 128; i += nb * NT) { const int sl = (i >> 7) * SLOTS_E + NB * CAP_L + NB * CAP_C + (i & 127); p.slot_tok[sl] = 0; p.slot_w[sl] = 0.f; }
  const int nlat = NB * NE, nctx = layer == 0 ? NB * NE : 0;
  for (int task = bid; task < nlat + nctx; task += nb) {
    int tid = tid_; asm volatile("" : "+v"(tid));
    int b, e, n, cap, rbase, sbase;
    if (task < nlat) { b = task / NE; e = task % NE; n = SEQ; cap = CAP_L; rbase = b * SEQ; sbase = e * SLOTS_E + b * CAP_L; }
    else { int j = task - nlat; b = j / NE; e = j % NE; n = CTX; cap = CAP_C; rbase = TL + b * CTX; sbase = e * SLOTS_E + NB * CAP_L + b * CAP_C; }
    __syncthreads();
#pragma unroll 16
    for (int s2 = tid; s2 < n; s2 += NT) L.key[s2] = __float_as_uint(p.aff[(size_t)(rbase + s2) * 16 + e]);
    unsigned prefix = 0u, remaining = (unsigned)cap;
#pragma unroll 1
    for (int pass = 0; pass < 4; ++pass) {
      const int shift = 24 - 8 * pass;
      for (int i = tid; i < NW * 256; i += NT) (&L.hist[0][0])[i] = 0u;
      __syncthreads();
      for (int s2 = tid; s2 < n; s2 += NT) { const unsigned k = L.key[s2]; if (pass == 0 || (k >> (shift + 8)) == (prefix >> (shift + 8))) atomicAdd(&L.hist[tid >> 6][(k >> shift) & 255u], 1u); }
      __syncthreads();
      if (tid < 256) { unsigned t = 0u;
#pragma unroll
        for (int w = 0; w < NW; ++w) t += L.hist[w][tid];
        L.hist[0][tid] = t; }
      __syncthreads();
      if (tid < 64) {
        unsigned c4[4]; unsigned loc = 0u;
#pragma unroll
        for (int e = 0; e < 4; ++e) { c4[e] = L.hist[0][255 - 4 * tid - e]; loc += c4[e]; }
        unsigned inc = loc;
#pragma unroll
        for (int o = 1; o < 64; o <<= 1) { const unsigned t = __shfl_up(inc, o); if (tid >= o) inc += t; }
        unsigned cum = inc - loc;
        const bool hit = inc >= remaining;
        const unsigned long long mk = __ballot(hit);
        const int first = mk ? __builtin_ctzll(mk) : 63;
        if (tid == first) { int e = 0;
#pragma unroll
          for (; e < 3; ++e) { if (cum + c4[e] >= remaining) break; cum += c4[e]; }
          const int d = 255 - 4 * tid - e; L.sh[0] = prefix | ((unsigned)d << shift); L.sh[1] = remaining - cum; } }
      __syncthreads();
      prefix = L.sh[0]; remaining = L.sh[1];
    }
    const int per = n / NT > 0 ? n / NT : 1, t0 = tid * per;
    unsigned cg = 0u, ce = 0u;
    if (t0 < n) for (int q = 0; q < per; ++q) { const unsigned k = L.key[t0 + q]; cg += k > prefix ? 1u : 0u; ce += k == prefix ? 1u : 0u; }
    L.part[tid] = cg | (ce << 16);
    __syncthreads();
    unsigned og = 0u, oe = 0u;
    for (int j = 0; j < NT; ++j) { const unsigned v = L.part[j]; if (j < tid) { og += v & 0xffffu; oe += v >> 16; } }
    if (t0 < n) for (int q = 0; q < per; ++q) {
      const unsigned k = L.key[t0 + q]; const int row = rbase + t0 + q;
      const bool sel = k > prefix || (k == prefix && oe < remaining);
      if (sel) { const int slot = sbase + (int)(og + (oe < remaining ? oe : remaining)); p.slot_tok[slot] = row; p.slot_w[slot] = __uint_as_float(k); p.tok_slot[(size_t)row * 16 + e] = slot; }
      else p.tok_slot[(size_t)row * 16 + e] = -1;
      og += k > prefix ? 1u : 0u; oe += k == prefix ? 1u : 0u;
    }
    __syncthreads();
  }
}
__device__ __forceinline__ void phase_combine(CParams& p, int layer, int bid, int nb, int tid_) {
  const int lane = tid_ & 63, wv = tid_ >> 6;
  const int nrows = layer == 0 ? TT : TL, stride = nb * NW;
  const float* ng3 = p.norm_g + (size_t)layer * 4 * D + 3 * D;
  for (int row0 = bid * NW + wv; row0 < nrows; row0 += 2 * stride) {
    int rows[2] = {row0, row0 + stride}; const bool val1 = rows[1] < nrows; if (!val1) rows[1] = row0;
    int sk[2][4]; unsigned long long rest[2]; int slotv[2];
#pragma unroll
    for (int r = 0; r < 2; ++r) { slotv[r] = lane < 16 ? p.tok_slot[(size_t)rows[r] * 16 + lane] : -1; }
#pragma unroll
    for (int r = 0; r < 2; ++r) { unsigned long long mk = __ballot(slotv[r] >= 0);
#pragma unroll
      for (int k = 0; k < 4; ++k) { if (mk) { const int bit = __builtin_ctzll(mk); sk[r][k] = __builtin_amdgcn_readlane(slotv[r], bit); mk &= mk - 1; } else sk[r][k] = -1; }
      rest[r] = mk; }
    uint2 pk[2][4][4]; float4 xr[2][4];
#pragma unroll
    for (int r = 0; r < 2; ++r) { const float* xs = xrow_ptr(p, rows[r]);
#pragma unroll
      for (int i = 0; i < 4; ++i) xr[r][i] = *(const float4*)(xs + i * 256 + lane * 4);
#pragma unroll
      for (int k = 0; k < 4; ++k) { const int sl = sk[r][k] >= 0 ? sk[r][k] : 0;
#pragma unroll
        for (int i = 0; i < 4; ++i) pk[r][k][i] = *(const uint2*)(p.ymoe + (size_t)sl * D + i * 256 + lane * 4); } }
#pragma unroll
    for (int r = 0; r < 2; ++r) { if (r == 1 && !val1) break;
      const int row = rows[r]; float* xs = xrow_ptr(p, row);
      float mv[16];
#pragma unroll
      for (int i = 0; i < 16; ++i) mv[i] = 0.f;
#pragma unroll
      for (int k = 0; k < 4; ++k) { const float wk = sk[r][k] >= 0 ? 1.f : 0.f;
#pragma unroll
        for (int i = 0; i < 4; ++i) { const uint2 q = pk[r][k][i];
          mv[i * 4] += wk * __uint_as_float(q.x << 16); mv[i * 4 + 1] += wk * __uint_as_float(q.x & 0xffff0000u); mv[i * 4 + 2] += wk * __uint_as_float(q.y << 16); mv[i * 4 + 3] += wk * __uint_as_float(q.y & 0xffff0000u); } }
      for (unsigned long long mk = rest[r]; mk; mk &= mk - 1) { const int slot = __builtin_amdgcn_readlane(slotv[r], __builtin_ctzll(mk));
#pragma unroll
        for (int i = 0; i < 4; ++i) { const uint2 q = *(const uint2*)(p.ymoe + (size_t)slot * D + i * 256 + lane * 4);
          mv[i * 4] += __uint_as_float(q.x << 16); mv[i * 4 + 1] += __uint_as_float(q.x & 0xffff0000u); mv[i * 4 + 2] += __uint_as_float(q.y << 16); mv[i * 4 + 3] += __uint_as_float(q.y & 0xffff0000u); } }
      float ss = 0.f;
#pragma unroll
      for (int i = 0; i < 16; ++i) ss += mv[i] * mv[i];
      ss = wave_sum(ss);
      const float rstd = rsqrtf(ss * (1.f / D) + 1e-6f);
      const float* m = p.mod + (size_t)(layer * 5 + mod_idx(row)) * 6 * D;
      float xv[16], hv[16];
#pragma unroll
      for (int i = 0; i < 4; ++i) { const int k = i * 256 + lane * 4; const float4 xo = xr[r][i]; const float4 gg = *(const float4*)(ng3 + k); const float4 g2 = *(const float4*)(m + 5 * D + k);
        xv[i * 4] = xo.x + g2.x * mv[i * 4] * rstd * gg.x; xv[i * 4 + 1] = xo.y + g2.y * mv[i * 4 + 1] * rstd * gg.y; xv[i * 4 + 2] = xo.z + g2.z * mv[i * 4 + 2] * rstd * gg.z; xv[i * 4 + 3] = xo.w + g2.w * mv[i * 4 + 3] * rstd * gg.w;
        *(float4*)(xs + k) = make_float4(xv[i * 4], xv[i * 4 + 1], xv[i * 4 + 2], xv[i * 4 + 3]); }
      if (layer + 1 < DEPTH) {
        const float* m2 = p.mod + (size_t)((layer + 1) * 5 + mod_idx(row)) * 6 * D;
        row_modulate_store(xv, p.norm_g + (size_t)(layer + 1) * 4 * D, m2, m2 + D, p.hb + (size_t)row * D, lane, hv);
      }
    }
  }
}

#define XB_TMO      128
#define XB_XCNT(j)  (256  + 64 * (j))
#define XB_XSUB(j)  (1280 + 64 * (j))
#define XB_XGEN(j)  (2304 + 64 * (j))
#define XB_TOP      3328
#define XB_TOPGEN   3392
#define XCD_BAR_WORDS 3456
#define XB_SPIN_CAP (1u << 22)
__device__ __forceinline__ unsigned xb_ld(unsigned* q)              { return __hip_atomic_load(q, __ATOMIC_RELAXED, __HIP_MEMORY_SCOPE_AGENT); }
__device__ __forceinline__ unsigned xb_add(unsigned* q, unsigned v) { return __hip_atomic_fetch_add(q, v, __ATOMIC_RELAXED, __HIP_MEMORY_SCOPE_AGENT); }
__device__ __forceinline__ unsigned xb_xcc_id() { return (unsigned)__builtin_amdgcn_s_getreg((3 << 11) | 20) & 0xFu; }
#define XB_SPIN(cond, bar) do { unsigned _sp = 0; while (cond) { __builtin_amdgcn_s_sleep(1); \
    if ((++_sp & 255u) == 0u) { if (xb_ld(&(bar)[XB_TMO])) break; if (_sp > XB_SPIN_CAP) { atomicAdd(&(bar)[XB_TMO], 1u); break; } } } } while (0)
struct XcdBarrier { unsigned* bar; unsigned x; volatile LAS unsigned* st; };
__device__ __forceinline__ XcdBarrier xcd_barrier_post(unsigned* bar, volatile LAS unsigned* st) {
  XcdBarrier b; b.bar = bar; b.x = xb_xcc_id(); b.st = st;
  if (threadIdx.x == 0) (void)xb_add(&bar[XB_XCNT(b.x)], 1u);
  return b;
}
__device__ __forceinline__ void xcd_barrier_complete(unsigned* bar, unsigned x, unsigned& nloc, unsigned& nx) {
  const unsigned G = gridDim.x * gridDim.y * gridDim.z;
  unsigned sum, cnt, mine, sp = 0u;
  for (;;) {
    sum = 0u; cnt = 0u; mine = 0u;
#pragma unroll
    for (unsigned j = 0; j < 16; ++j) { const unsigned c = xb_ld(&bar[XB_XCNT(j)]); sum += c; cnt += (c > 0u) ? 1u : 0u; mine = (j == x) ? c : mine; }
    if (sum == G) break;
    __builtin_amdgcn_s_sleep(1);
    if ((++sp & 255u) == 0u) { if (xb_ld(&bar[XB_TMO])) break; if (sp > XB_SPIN_CAP) { atomicAdd(&bar[XB_TMO], 1u); break; } }
  }
  nloc = mine > 0u ? mine : 1u; nx = cnt > 0u ? cnt : 1u;
}
__device__ __forceinline__ void xcd_barrier(const XcdBarrier& b) {
  asm volatile("s_waitcnt vmcnt(0)" ::: "memory");
  __syncthreads();
  if (threadIdx.x == 0) {
    unsigned* bar = b.bar;
    __builtin_amdgcn_s_waitcnt(0);
    unsigned nloc = b.st[0], nx = b.st[1];
    if (nloc == 0u) { xcd_barrier_complete(bar, b.x, nloc, nx); b.st[0] = nloc; b.st[1] = nx; }
    const unsigned old = xb_add(&bar[XB_XSUB(b.x)], 1u);
    const unsigned gen = old / nloc;
    if (old + 1u == (gen + 1u) * nloc) {
      __builtin_amdgcn_fence(__ATOMIC_RELEASE, "agent");
      asm volatile("s_waitcnt vmcnt(0)" ::: "memory");
      const unsigned og = xb_add(&bar[XB_TOP], 1u);
      const unsigned tg = og / nx;
      if (og + 1u == (tg + 1u) * nx) xb_add(&bar[XB_TOPGEN], 1u);
      else XB_SPIN(xb_ld(&bar[XB_TOPGEN]) == tg, bar);
      __builtin_amdgcn_fence(__ATOMIC_ACQUIRE, "agent");
      xb_add(&bar[XB_XGEN(b.x)], 1u);
      asm volatile("s_waitcnt vmcnt(0)" ::: "memory");
    } else {
      XB_SPIN(xb_ld(&bar[XB_XGEN(b.x)]) == gen, bar);
      __builtin_amdgcn_fence(__ATOMIC_ACQUIRE, "agent");
      asm volatile("s_waitcnt vmcnt(0)" ::: "memory");
    }
  }
  __syncthreads();
}

namespace cg = cooperative_groups;
constexpr int LDS_BYTES = 163840 - 16;
static_assert(sizeof(GlaLds) <= LDS_BYTES && sizeof(MbLds) <= LDS_BYTES && sizeof(DnLds) <= LDS_BYTES && sizeof(FftLds) <= LDS_BYTES, "lds");
__global__ void __launch_bounds__(NT) mega(Params p_unused) {
  extern __shared__ __attribute__((aligned(16))) char smem[];
  cg::grid_group grid = cg::this_grid();
  int bid_s = blockIdx.x, nb_s = gridDim.x, tid_v = threadIdx.x;
  const __attribute__((address_space(4))) char* kb = (const __attribute__((address_space(4))) char*)__builtin_amdgcn_kernarg_segment_ptr();
#define p (*(CParams*)({ asm volatile("" : "+s"(kb)); kb; }))
#define BID ({ asm volatile("" : "+s"(bid_s)); bid_s; })
#define NBK ({ asm volatile("" : "+s"(nb_s)); nb_s; })
#define TID ({ asm volatile("" : "+v"(tid_v)); tid_v; })
#define LAYER ({ int l_ = l; asm volatile("" : "+s"(l_)); l_; })
#define GSYNC() do { XcdBarrier xb_; xb_.bar = p.bar; xb_.x = xb_xcc_id(); xb_.st = (volatile LAS unsigned*)(smem + LDS_BYTES); xcd_barrier(xb_); } while (0)
  volatile LAS unsigned* xst = (volatile LAS unsigned*)(smem + LDS_BYTES);
  if (threadIdx.x < 4) xst[threadIdx.x] = 0u;
  __syncthreads();
  (void)xcd_barrier_post(p.bar, xst);
  phase_conv_small(p, BID, NBK, TID, smem);
  phase_mod(p, BID, NBK, TID, smem);
  grid.sync();
  phase_prenorm0(p, BID, NBK, TID);
  GSYNC();
  for (int l = 0; l < DEPTH; ++l) {
    phase_gemm_in(p, LAYER, BID, NBK, TID, smem); GSYNC();
    phase_hy_prep(p, LAYER, BID, NBK, TID);
    phase_hy_prep_t(p, LAYER, BID, NBK, TID, smem);
    phase_hy_filt<true>(p, LAYER, SEQ, p.filt, BID, NBK, TID, smem);
    if (l == 0) phase_hy_filt<false>(p, LAYER, CTX, p.filtc, BID, NBK, TID, smem);
    GSYNC();
    phase_hy_fft(p, LAYER, BID, NBK, TID, smem);
    if (l == 0) phase_hy_conv(p, LAYER, 0, true, BID, NBK, TID);
    GSYNC();
    phase_hy_fin(p, BID, NBK, TID, smem);
    if (l == 0) phase_hy_conv(p, LAYER, 1, true, BID, NBK, TID);
    GSYNC();
    phase_mb_prep(p, LAYER, BID, NBK, TID); GSYNC();
    phase_mb_chunk<0>(p, LAYER, BID, NBK, TID, smem); GSYNC();
    phase_mb_state(p, BID, NBK, TID); GSYNC();
    phase_mb_chunk<1>(p, LAYER, BID, NBK, TID, smem); GSYNC();
    phase_dn_prep(p, LAYER, BID, NBK, TID);
    phase_gla_chunk<0>(p, LAYER, BID, NBK, TID, smem); GSYNC();
    phase_dn_chunk<0>(p, LAYER, BID, NBK, TID, smem);
    phase_gla_state(p, BID, NBK, TID); GSYNC();
    { const int b_ = BID, n_ = NBK;
      if (b_ < 32) phase_dn_state(p, b_, 32, TID, smem); else phase_gla_chunk<1>(p, LAYER, b_ - 32, n_ - 32, TID, smem); }
    GSYNC();
    phase_dn_chunk<1>(p, LAYER, BID, NBK, TID, smem); GSYNC();
    phase_gemm_out(p, LAYER, BID, NBK, TID, smem); GSYNC();
    phase_postmix(p, LAYER, BID, NBK, TID, smem); GSYNC();
    phase_topk(p, LAYER, BID, NBK, TID, smem);
    phase_conv_moe(p, LAYER, BID, NBK, TID, smem);
    GSYNC();
    phase_gemm_moe1(p, LAYER, BID, NBK, TID, smem); GSYNC();
    phase_gemm_moe2(p, LAYER, BID, NBK, TID, smem); GSYNC();
    phase_combine(p, LAYER, BID, NBK, TID);
    if (l + 1 < DEPTH) GSYNC();
  }
#undef p
}

extern "C" void kernel_launch(void* const* d_in, const int* in_sizes, int n_in, void* d_out, int out_size, void* d_ws, size_t ws_size, hipStream_t stream) {
  Params p{};
  const float** fp = (const float**)&p;
  for (int i = 0; i < 37; ++i) fp[i] = (const float*)d_in[i];
  p.out = (float*)d_out;
  char* ws = (char*)d_ws; size_t off = 0;
  auto alloc = [&](size_t bytes) { size_t o = off; off += (bytes + 255) & ~(size_t)255; return ws + o; };
  p.win_t = (bf16_t*)alloc((size_t)DEPTH * NUP * D * 2);
  p.wout_t = (bf16_t*)alloc((size_t)DEPTH * D * D * 2);
  p.mod = (float*)alloc((size_t)DEPTH * 5 * 6 * D * 4);
  p.xc = (float*)alloc((size_t)TC * D * 4);
  p.aff = (float*)alloc((size_t)TT * 16 * 4);
  p.slot_tok = (int*)alloc((size_t)NSLOT * 4);
  p.slot_w = (float*)alloc((size_t)NSLOT * 4);
  p.tok_slot = (int*)alloc((size_t)TT * 16 * 4);
  p.dt = (float*)alloc((size_t)TT * 8 * 4);
  p.bg = (float*)alloc((size_t)TT * 16 * 4);
  p.filt = (float*)alloc((size_t)SEQ * 1024 * 4);
  p.filtc = (float*)alloc((size_t)CTX * 1024 * 4);
  p.hb = (bf16_t*)alloc((size_t)TT * D * 2);
  p.prep = p.hb;
  char* R = alloc((size_t)NSLOT * D * 2 * 2);
  p.u = (bf16_t*)R; p.yo = (bf16_t*)R; p.act = (bf16_t*)R; p.ymoe = (bf16_t*)(R + (size_t)NSLOT * D * 2);
  p.y = (bf16_t*)alloc((size_t)TT * D * 2);
  char* W2 = alloc((size_t)NE * 3 * D * D * 2);
  p.wgu_t = (bf16_t*)W2; p.wdn_t = (bf16_t*)(W2 + (size_t)NE * 2 * D * D * 2);
  p.obuf = (float*)W2; p.zbuf = (float*)W2; p.yt = (float*)(W2 + (size_t)36 * 1024 * 1024);
  p.gla_l = (bf16_t*)(W2 + (size_t)72 * 1024 * 1024);
  p.gla_dec = (float*)alloc((size_t)32 * NCH * 32 * 4);
  p.bar = (unsigned*)alloc((size_t)XCD_BAR_WORDS * 4);
  p.specg = (float2*)alloc((size_t)256 * 16384 * 8);
  p.mb_l = (bf16_t*)W2;
  p.mb_dec = (float*)alloc((size_t)32 * NCH * 4);
  p.dn_m = (bf16_t*)W2; p.dn_l = (bf16_t*)(W2 + (size_t)32 * NCH * 4096 * 2);
  if (off > ws_size) { fprintf(stderr, "workspace too small: need %zu have %zu\n", off, ws_size); return; }

  static int grid_blocks = 0;
  if (!grid_blocks) {
    int dev = 0, cus = 0, per_cu = 0;
    hipGetDevice(&dev);
    hipDeviceGetAttribute(&cus, hipDeviceAttributeMultiprocessorCount, dev);
    hipFuncSetAttribute((const void*)mega, hipFuncAttributeMaxDynamicSharedMemorySize, LDS_BYTES + 16);
    hipOccupancyMaxActiveBlocksPerMultiprocessor(&per_cu, mega, NT, LDS_BYTES + 16);
    if (per_cu > 1) per_cu = 1;
    grid_blocks = cus * per_cu;
  }
  hipMemsetAsync(p.bar, 0, (size_t)XCD_BAR_WORDS * 4, stream);
  void* args[] = {&p};
  hipError_t e = hipLaunchCooperativeKernel((void*)mega, dim3(grid_blocks), dim3(NT), args, LDS_BYTES + 16, stream);
  if (e != hipSuccess) fprintf(stderr, "cooperative launch failed: %s (grid %d)\n", hipGetErrorString(e), grid_blocks);
}
```

```cpp
#include <hip/hip_runtime.h>
#include <hip/hip_cooperative_groups.h>
#include <stdint.h>
#include <stdio.h>

typedef unsigned short bf16_t;
using bf16x8 = __attribute__((ext_vector_type(8))) short;
using f32x4 = __attribute__((ext_vector_type(4))) float;

constexpr int D = 1024, NB = 4, SEQ = 8192, CTX = 256, DEPTH = 2;
constexpr int TL = NB * SEQ, TC = NB * CTX, TT = TL + TC;
constexpr int NUS = 3640, NU = 3840, NUP = 3840;
constexpr int NE = 16, CAP_L = 1024, CAP_C = 32, SLOTS_E = NB * CAP_L + 256, NSLOT = NE * SLOTS_E;
constexpr int NT = 512, NW = NT / 64;
constexpr int U_GLA = 0, U_HY = 800, U_MB = 1568, U_DN = 2600;

struct Params {
  const float *x, *c, *ctx, *c_ctx, *w_mod, *b_mod, *norm_g, *w_in, *w_out, *gla_w2, *gla_b, *gla_norm,
      *hy_conv_w, *hy_conv_b, *hy_w1, *hy_b1, *hy_w2, *hy_b2, *hy_w3, *hy_b3, *hy_w4, *hy_freq, *hy_d,
      *mb_conv_w, *mb_conv_b, *mb_a_log, *mb_dt_bias, *mb_d, *mb_norm, *dn_conv_w, *dn_a_log, *dn_dt_bias, *dn_norm,
      *moe_router, *moe_w_gate, *moe_w_up, *moe_w_down;
  float* out;
  bf16_t *win_t, *wout_t, *wgu_t, *wdn_t, *hb, *prep, *u, *y, *act, *ymoe;
  float *mod, *xc, *aff, *slot_w, *dt, *bg, *filt, *filtc, *obuf, *zbuf; bf16_t* yo;
  int *slot_tok, *tok_slot;
  bf16_t* gla_l; float* gla_dec;
  bf16_t* mb_l; float* mb_dec;
  bf16_t *dn_m, *dn_l;
  float* yt;
  unsigned* bar;
  float2* specg;
};

typedef const __attribute__((address_space(4))) Params CParams;

typedef float f32x2v __attribute__((ext_vector_type(2)));
typedef __bf16 bf16x2v __attribute__((ext_vector_type(2)));
__device__ __forceinline__ unsigned pack2(float a, float b) { const f32x2v v = {a, b}; return __builtin_bit_cast(unsigned, __builtin_convertvector(v, bf16x2v)); }
__device__ __forceinline__ bf16_t f2bf(float f) { return (bf16_t)(pack2(f, 0.f) & 0xffffu); }
__device__ __forceinline__ float bf2f(bf16_t h) { return __uint_as_float(((unsigned)h) << 16); }
__device__ __forceinline__ float siluf(float v) { return v * __builtin_amdgcn_rcpf(1.f + __expf(-v)); }
__device__ __forceinline__ float sigmoidf_(float v) { return __builtin_amdgcn_rcpf(1.f + __expf(-v)); }
__device__ __forceinline__ float softplusf_(float v) { const float e = __expf(v); return v > 15.f ? v : (v < -8.f ? e : __logf(1.f + e)); }
__device__ __forceinline__ float logsigmoidf_(float z) { return -softplusf_(-z); }
__device__ __forceinline__ float wave_sum(float v) {
#pragma unroll
  for (int o = 32; o > 0; o >>= 1) v += __shfl_xor(v, o);
  return v;
}
__device__ __forceinline__ float rdlane(float v, int l) { return __int_as_float(__builtin_amdgcn_readlane(__float_as_int(v), l)); }
__device__ __forceinline__ float* xrow_ptr(CParams& p, int row) { return row < TL ? p.out + (size_t)row * D : p.xc + (size_t)(row - TL) * D; }
__device__ __forceinline__ int mod_idx(int row) { return row < TL ? row / SEQ : 4; }

__device__ __forceinline__ int seq_nb(int row, int delta, bool mamba) {
  if (row < TL) {
    int b = row / SEQ, t = row % SEQ;
    if (mamba) { int pos = (t & 63) * 128 + (t >> 6) + delta; if (pos < 0 || pos >= SEQ) return -1; return b * SEQ + (pos & 127) * 64 + (pos >> 7); }
    int t2 = t + delta; if (t2 < 0 || t2 >= SEQ) return -1; return b * SEQ + t2;
  }
  int r = row - TL, b = r / CTX, t = r % CTX + delta; if (t < 0 || t >= CTX) return -1; return TL + b * CTX + t;
}

__device__ __forceinline__ void conv8(const bf16_t* u, int ucol, int row, int rm, int rp, const float* w, const float* bias, int c, float (&o)[8]) {
  const uint4 x1 = *(const uint4*)(u + (size_t)row * NU + ucol + c);
  uint4 x0 = make_uint4(0u, 0u, 0u, 0u), x2 = make_uint4(0u, 0u, 0u, 0u);
  if (rm >= 0) x0 = *(const uint4*)(u + (size_t)rm * NU + ucol + c);
  if (rp >= 0) x2 = *(const uint4*)(u + (size_t)rp * NU + ucol + c);
  const unsigned a0[4] = {x0.x, x0.y, x0.z, x0.w}, a1[4] = {x1.x, x1.y, x1.z, x1.w}, a2[4] = {x2.x, x2.y, x2.z, x2.w};
#pragma unroll
  for (int h = 0; h < 2; ++h) {
    const float4 w0 = *(const float4*)(w + c + h * 4), w1 = *(const float4*)(w + 768 + c + h * 4), w2 = *(const float4*)(w + 1536 + c + h * 4);
    const float4 bb = bias ? *(const float4*)(bias + c + h * 4) : make_float4(0.f, 0.f, 0.f, 0.f);
    const float ww0[4] = {w0.x, w0.y, w0.z, w0.w}, ww1[4] = {w1.x, w1.y, w1.z, w1.w}, ww2[4] = {w2.x, w2.y, w2.z, w2.w}, bv[4] = {bb.x, bb.y, bb.z, bb.w};
#pragma unroll
    for (int e = 0; e < 4; ++e) { const int wd = h * 2 + (e >> 1); const bool hi = e & 1;
      const float v0 = hi ? __uint_as_float(a0[wd] & 0xffff0000u) : __uint_as_float(a0[wd] << 16), v1 = hi ? __uint_as_float(a1[wd] & 0xffff0000u) : __uint_as_float(a1[wd] << 16), v2 = hi ? __uint_as_float(a2[wd] & 0xffff0000u) : __uint_as_float(a2[wd] << 16);
      o[h * 4 + e] = bv[e] + ww0[e] * v0 + ww1[e] * v1 + ww2[e] * v2; }
  }
}

template <int MAP>
__device__ __forceinline__ void conv_tile4(const float* src0, const float* src1, int ldsrc, int ncols, bf16_t* dst, int K, int k0, int n0, float* tile, int tid_) {
  const int t = tid_;
  {
    const int nn = t & 63, kk = t >> 6;
    float v[4][8];
#pragma unroll
    for (int q = 0; q < 4; ++q) { const int R = n0 + q * 64 + nn; const float* sp; int col;
      if (MAP == 0) { sp = src0; col = R < ncols ? R : -1; }
      else { int j = R >> 8, rem = R & 255; col = j * 128 + (rem & 127); sp = (rem >> 7) ? src1 : src0; }
#pragma unroll
      for (int i = 0; i < 8; ++i) { int k = i * 8 + kk; v[q][i] = col >= 0 ? sp[(size_t)(k0 + k) * ldsrc + col] : 0.f; } }
#pragma unroll
    for (int q = 0; q < 4; ++q)
#pragma unroll
      for (int i = 0; i < 8; ++i) tile[q * 64 * 65 + (i * 8 + kk) * 65 + nn] = v[q][i];
  }
  __syncthreads();
  {
    const int k2 = (t & 31) * 2, nn = t >> 5;
#pragma unroll
    for (int q = 0; q < 4; ++q)
#pragma unroll
      for (int i = 0; i < 4; ++i) { int n = i * 16 + nn; unsigned v = pack2(tile[q * 64 * 65 + k2 * 65 + n], tile[q * 64 * 65 + (k2 + 1) * 65 + n]);
        *(unsigned*)(dst + (size_t)(n0 + q * 64 + n) * K + k0 + k2) = v; }
  }
  __syncthreads();
}
__device__ __forceinline__ void phase_conv_small(CParams& p, int bid, int nb, int tid_, char* smem) {
  float* tile = (float*)smem;
  const int n_in = 16 * (NUP / 256), n_out = 16 * 4;
  for (int i = bid; i < DEPTH * (n_in + n_out); i += nb) {
    int l = i / (n_in + n_out), r = i % (n_in + n_out);
    if (r < n_in) { int kt = r % 16, nt = r / 16; conv_tile4<0>(p.w_in + (size_t)l * D * NUS, nullptr, NUS, NUS, p.win_t + (size_t)l * NUP * D, D, kt * 64, nt * 256, tile, tid_); }
    else { r -= n_in; int kt = r % 16, nt = r / 16; conv_tile4<0>(p.w_out + (size_t)l * D * D, nullptr, D, D, p.wout_t + (size_t)l * D * D, D, kt * 64, nt * 256, tile, tid_); }
  }
}
__device__ __forceinline__ void phase_conv_moe(CParams& p, int layer, int bid, int nb, int tid_, char* smem) {
  float* tile = (float*)smem;
  const int n_gu = 16 * 8, n_dn = 16 * 4;
  for (int i = bid; i < NE * (n_gu + n_dn); i += nb) {
    int e = i / (n_gu + n_dn), r = i % (n_gu + n_dn);
    size_t wo = ((size_t)layer * NE + e) * D * D;
    if (r < n_gu) { int kt = r % 16, nt = r / 16; conv_tile4<1>(p.moe_w_gate + wo, p.moe_w_up + wo, D, D, p.wgu_t + (size_t)e * 2048 * D, D, kt * 64, nt * 256, tile, tid_); }
    else { r -= n_gu; int kt = r % 16, nt = r / 16; conv_tile4<0>(p.moe_w_down + wo, nullptr, D, D, p.wdn_t + (size_t)e * D * D, D, kt * 64, nt * 256, tile, tid_); }
  }
}

__device__ __forceinline__ void phase_mod(CParams& p, int bid, int nb, int tid_, char* smem) {
  float* sc = (float*)smem;
  float* red = sc + 5 * D;
  const int lane = tid_ & 63, wv = tid_ >> 6;
  for (int i = tid_; i < 5 * D; i += NT) { int r = i / D, k = i % D; float v = r < 4 ? p.c[r * D + k] : p.c_ctx[k]; sc[i] = siluf(v); }
  __syncthreads();
  for (int blk = bid; blk < DEPTH * 6 * D / 64; blk += nb) {
    const int g = blk * 64 + lane, l = g / (6 * D), n = g % (6 * D);
    const float* w = p.w_mod + (size_t)l * D * 6 * D + n;
    float a0 = 0, a1 = 0, a2 = 0, a3 = 0, a4 = 0;
#pragma unroll 8
    for (int k = wv * 128; k < wv * 128 + 128; ++k) { float wvv = w[(size_t)k * 6 * D]; a0 += sc[k] * wvv; a1 += sc[D + k] * wvv; a2 += sc[2 * D + k] * wvv; a3 += sc[3 * D + k] * wvv; a4 += sc[4 * D + k] * wvv; }
    red[(wv * 5 + 0) * 64 + lane] = a0; red[(wv * 5 + 1) * 64 + lane] = a1; red[(wv * 5 + 2) * 64 + lane] = a2; red[(wv * 5 + 3) * 64 + lane] = a3; red[(wv * 5 + 4) * 64 + lane] = a4;
    __syncthreads();
    if (wv < 5) { float t = p.b_mod[l * 6 * D + n];
#pragma unroll
      for (int q = 0; q < 8; ++q) t += red[(q * 5 + wv) * 64 + lane];
      p.mod[((size_t)l * 5 + wv) * 6 * D + n] = t; }
    __syncthreads();
  }
}

__device__ __forceinline__ void row_modulate_store(const float (&xv)[16], const float* g, const float* sh, const float* sc, bf16_t* dst, int lane, float (&hv)[16]) {
  float ss = 0.f;
#pragma unroll
  for (int i = 0; i < 16; ++i) ss += xv[i] * xv[i];
  ss = wave_sum(ss);
  float rstd = rsqrtf(ss * (1.f / D) + 1e-6f);
#pragma unroll
  for (int i = 0; i < 4; ++i) {
    int k = i * 256 + lane * 4;
    float4 gv = *(const float4*)(g + k), shv = *(const float4*)(sh + k), scv = *(const float4*)(sc + k);
    hv[i * 4 + 0] = xv[i * 4 + 0] * rstd * gv.x * (1.f + scv.x) + shv.x;
    hv[i * 4 + 1] = xv[i * 4 + 1] * rstd * gv.y * (1.f + scv.y) + shv.y;
    hv[i * 4 + 2] = xv[i * 4 + 2] * rstd * gv.z * (1.f + scv.z) + shv.z;
    hv[i * 4 + 3] = xv[i * 4 + 3] * rstd * gv.w * (1.f + scv.w) + shv.w;
    uint2 pk; pk.x = pack2(hv[i * 4 + 0], hv[i * 4 + 1]); pk.y = pack2(hv[i * 4 + 2], hv[i * 4 + 3]);
    *(uint2*)(dst + k) = pk;
  }
}
__device__ __forceinline__ void phase_prenorm0(CParams& p, int bid, int nb, int tid_) {
  const int lane = tid_ & 63, wv = tid_ >> 6;
  for (int row0 = (bid * NW + wv) * 2; row0 < TT; row0 += nb * NW * 2) {
    float xv[2][16], hv[16];
#pragma unroll
    for (int r = 0; r < 2; ++r) { const int row = row0 + r; const float* src = row < TL ? p.x + (size_t)row * D : p.ctx + (size_t)(row - TL) * D;
#pragma unroll
      for (int i = 0; i < 4; ++i) { float4 v = *(const float4*)(src + i * 256 + lane * 4); xv[r][i * 4] = v.x; xv[r][i * 4 + 1] = v.y; xv[r][i * 4 + 2] = v.z; xv[r][i * 4 + 3] = v.w; } }
#pragma unroll
    for (int r = 0; r < 2; ++r) { const int row = row0 + r; const float* m = p.mod + (size_t)(0 * 5 + mod_idx(row)) * 6 * D;
      row_modulate_store(xv[r], p.norm_g + 0 * 4 * D + 0 * D, m + 0 * D, m + 1 * D, p.hb + (size_t)row * D, lane, hv); }
  }
}

#define LAS __attribute__((address_space(3)))
namespace g8 {
typedef unsigned u32x4 __attribute__((ext_vector_type(4)));
constexpr int BM = 256, BK = 64, HALF = 128, HTB = HALF * BK * 2, KD = 1024;
__device__ __forceinline__ int lds_byte(int r, int c) { const int st = (r >> 4) * 2 + (c >> 5), rr = r & 15, cc = c & 31, ob = rr * 64 + cc * 2; return st * 1024 + (ob ^ (((ob >> 9) & 1) << 5)); }
__device__ __forceinline__ void stage_rc(int b, int& R, int& C) { const int st = b / 1024, sb = b % 1024, swz = sb ^ (((sb >> 9) & 1) << 5); R = (st >> 1) * 16 + swz / 64; C = (st & 1) * 32 + (swz % 64) / 2; }
__device__ __forceinline__ int perm32(int rho) { const int n = rho >> 4, i = rho & 15; return 8 * (i >> 2) + 4 * n + (i & 3); }
__device__ __forceinline__ unsigned cvt_pk_bf16(float lo, float hi) { unsigned r; asm volatile("v_cvt_pk_bf16_f32 %0, %1, %2" : "=v"(r) : "v"(lo), "v"(hi)); return r; }
struct Unit { int ar0, br0, pn, e; };
struct SchedPlain {
  int nM, nN, nwg, G, c;
  __device__ __forceinline__ bool next(int i, Unit& u) const {
    const long Lx = (long)i * G + c; if (Lx >= nwg) return false;
    int wgid = (int)Lx; { const int q = nwg / 8, r = nwg % 8, xcd = wgid % 8, off = wgid / 8; wgid = (xcd < r ? xcd * (q + 1) : r * (q + 1) + (xcd - r) * q) + off; }
    const int nig = 8 * nN, gid = wgid / nig, fm = gid * 8, gsz = (nM - fm) < 8 ? (nM - fm) : 8;
    const int pm = fm + ((wgid % nig) % gsz), pn = (wgid % nig) / gsz;
    u.ar0 = pm * BM; u.br0 = pn * BM; u.pn = pn; u.e = 0; return true;
  }
};
struct SchedMoe {
  int mt_e, nN, G, c;
  __device__ __forceinline__ bool next(int i, Unit& u) const {
    const long Lx = (long)i * G + c; if (Lx >= (long)NE * mt_e * nN) return false;
    const int e = (int)Lx / (mt_e * nN), r = (int)Lx % (mt_e * nN);
    const int gid = r / (8 * nN), fm = gid * 8, gsz = (mt_e - fm) < 8 ? (mt_e - fm) : 8, rr = r - gid * 8 * nN, pm = fm + rr % gsz, pn = rr / gsz;
    u.ar0 = e * SLOTS_E + pm * BM; u.br0 = (e * nN + pn) * BM; u.pn = pn; u.e = e; return true;
  }
};
template <bool GATHER, class Epi, class Sched>
__device__ __forceinline__ void gemm8(LAS unsigned char* lds, const bf16_t* A, const int* aidx, const bf16_t* Bt, const Sched& S, const Epi& E, int tid) {
  const int wid = __builtin_amdgcn_readfirstlane(tid >> 6), lane = tid & 63, wr = wid >> 2, wc = wid & 3, fr = lane & 15, fq = lane >> 4;
  constexpr int K = KD, nt = K / BK;
  int Rr[2], Cc[2]; unsigned voffB[2];
#pragma unroll
  for (int i = 0; i < 2; ++i) { stage_rc(tid * 16 + i * 8192, Rr[i], Cc[i]); const int Rb = Epi::PERM ? ((Rr[i] & ~31) + perm32(Rr[i] & 31)) : Rr[i]; voffB[i] = (unsigned)(Rb * K + Cc[i]) * 2u; }
  const size_t kstep = (size_t)(BK * 2), hstep = (size_t)HALF * K * 2;
  const unsigned ldsw = (unsigned)wid * 1024u;
  const int aoff = lds_byte(wr * 64 + fr, fq * 8), boff = lds_byte(wc * 32 + fr, fq * 8);
#define G8_SA(b, h) (((b) * 2 + (h)) * HTB)
#define G8_SB(b, h) ((4 + (b) * 2 + (h)) * HTB)
#define G8_STAGE(bufoff, gbase, voff) do { _Pragma("unroll") for (int _i = 0; _i < 2; ++_i) \
    __builtin_amdgcn_global_load_lds((const unsigned*)((const char*)(gbase) + (voff)[_i]), (LAS unsigned*)(lds + (bufoff) + ldsw + _i * 8192), 16, 0, 0); } while (0)
#define G8_LDA(dst, b, h) do { _Pragma("unroll") for (int m = 0; m < 4; ++m) _Pragma("unroll") for (int k = 0; k < 2; ++k) dst[m][k] = *(const LAS bf16x8*)(lds + G8_SA(b, h) + aoff + m * 2048 + k * 1024); } while (0)
#define G8_LDB(dst, b, h) do { _Pragma("unroll") for (int n = 0; n < 2; ++n) _Pragma("unroll") for (int k = 0; k < 2; ++k) dst[n][k] = *(const LAS bf16x8*)(lds + G8_SB(b, h) + boff + n * 2048 + k * 1024); } while (0)
#define G8_MMA(ai, bj, At, Btf) do { __builtin_amdgcn_s_setprio(1); _Pragma("unroll") for (int m = 0; m < 4; ++m) _Pragma("unroll") for (int n = 0; n < 2; ++n) _Pragma("unroll") for (int k = 0; k < 2; ++k) \
    acc[ai][bj][m][n] = __builtin_amdgcn_mfma_f32_16x16x32_bf16(Btf[n][k], At[m][k], acc[ai][bj][m][n], 0, 0, 0); __builtin_amdgcn_s_setprio(0); } while (0)
#define G8_WAIT_V(n) asm volatile("s_waitcnt vmcnt(" #n ")" ::: "memory")
#define G8_WAIT_L(n) asm volatile("s_waitcnt lgkmcnt(" #n ")" ::: "memory")
#define G8_BAR __builtin_amdgcn_s_barrier()
#define G8_SCHED __builtin_amdgcn_sched_barrier(0)
#define G8_AOFF(dst, un) do { _Pragma("unroll") for (int h = 0; h < 2; ++h) _Pragma("unroll") for (int i = 0; i < 2; ++i) { const int r_ = (un).ar0 + h * HALF + Rr[i]; \
    const int g_ = GATHER ? aidx[r_] : r_; dst[h][i] = (unsigned)(g_ * K + Cc[i]) * 2u; } } while (0)
  Unit cur, nxt; int ui = 0;
  if (!S.next(0, cur)) return;
  f32x4 acc[2][2][4][2];
#pragma unroll
  for (int a = 0; a < 2; ++a)
#pragma unroll
    for (int b = 0; b < 2; ++b)
#pragma unroll
      for (int m = 0; m < 4; ++m)
#pragma unroll
        for (int n = 0; n < 2; ++n) acc[a][b][m][n] = (f32x4){0.f, 0.f, 0.f, 0.f};
  bf16x8 At[4][2], B0[2][2], B1[2][2];
  unsigned vA[2][2], vAn[2][2];
  G8_AOFF(vA, cur);
  const char* cA = (const char*)A; const char* cB = (const char*)Bt + (size_t)cur.br0 * K * 2;
  G8_STAGE(G8_SB(0, 0), cB, voffB); G8_STAGE(G8_SA(0, 0), cA, vA[0]); G8_STAGE(G8_SB(0, 1), cB + hstep, voffB); G8_STAGE(G8_SA(0, 1), cA, vA[1]);
  if (wr == 1) G8_BAR;
  G8_WAIT_V(4); G8_BAR;
  G8_STAGE(G8_SB(1, 0), cB + kstep, voffB); G8_STAGE(G8_SA(1, 0), cA + kstep, vA[0]); G8_STAGE(G8_SB(1, 1), cB + hstep + kstep, voffB);
  G8_WAIT_V(6); G8_BAR;
  for (;;) {
    const bool has_next = S.next(ui + 1, nxt);
    if (has_next) { G8_AOFF(vAn, nxt); } else {
#pragma unroll
      for (int h = 0; h < 2; ++h)
#pragma unroll
        for (int i = 0; i < 2; ++i) vAn[h][i] = vA[h][i]; }
    const char* nB = has_next ? (const char*)Bt + (size_t)nxt.br0 * K * 2 : cB;
    for (int t = 0; t < nt; t += 2) {
      const bool last = (t == nt - 2);
      const char* a1 = cA + (size_t)(t + 1) * kstep;
      const char* a2 = last ? cA : cA + (size_t)(t + 2) * kstep; const char* b2 = last ? nB : cB + (size_t)(t + 2) * kstep;
      const char* a3 = a2 + kstep; const char* b3 = b2 + kstep;
      unsigned v2[2][2];
#pragma unroll
      for (int h = 0; h < 2; ++h)
#pragma unroll
        for (int i = 0; i < 2; ++i) v2[h][i] = last ? vAn[h][i] : vA[h][i];
      G8_LDB(B0, 0, 0); G8_SCHED; G8_LDA(At, 0, 0); G8_STAGE(G8_SA(1, 1), a1, vA[1]);
      G8_WAIT_L(8); G8_BAR; G8_WAIT_L(0); G8_MMA(0, 0, At, B0); G8_BAR; G8_SCHED;
      G8_LDB(B1, 0, 1); G8_STAGE(G8_SB(0, 0), b2, voffB);
      G8_BAR; G8_WAIT_L(0); G8_MMA(0, 1, At, B1); G8_BAR;
      G8_LDA(At, 0, 1); G8_STAGE(G8_SA(0, 0), a2, v2[0]);
      G8_BAR; G8_WAIT_L(0); G8_MMA(1, 0, At, B0); G8_BAR; G8_SCHED;
      G8_STAGE(G8_SB(0, 1), b2 + hstep, voffB);
      G8_WAIT_V(6); G8_BAR; G8_MMA(1, 1, At, B1); G8_BAR;
      G8_LDB(B0, 1, 0); G8_SCHED; G8_LDA(At, 1, 0); G8_STAGE(G8_SA(0, 1), a2, v2[1]);
      G8_WAIT_L(8); G8_BAR; G8_WAIT_L(0); G8_MMA(0, 0, At, B0); G8_BAR; G8_SCHED;
      G8_LDB(B1, 1, 1); G8_STAGE(G8_SB(1, 0), b3, voffB);
      G8_BAR; G8_WAIT_L(0); G8_MMA(0, 1, At, B1); G8_BAR;
      G8_LDA(At, 1, 1); G8_STAGE(G8_SA(1, 0), a3, v2[0]);
      G8_BAR; G8_WAIT_L(0); G8_MMA(1, 0, At, B0); G8_BAR; G8_SCHED;
      G8_STAGE(G8_SB(1, 1), b3 + hstep, voffB);
      G8_WAIT_V(6); G8_BAR; G8_MMA(1, 1, At, B1); G8_BAR;
    }
    E(acc, cur, wr, wc, fr, fq);
    if (!has_next) break;
#pragma unroll
    for (int a = 0; a < 2; ++a)
#pragma unroll
      for (int b = 0; b < 2; ++b)
#pragma unroll
        for (int m = 0; m < 4; ++m)
#pragma unroll
          for (int n = 0; n < 2; ++n) acc[a][b][m][n] = (f32x4){0.f, 0.f, 0.f, 0.f};
    cur = nxt; cB = nB; ++ui;
#pragma unroll
    for (int h = 0; h < 2; ++h)
#pragma unroll
      for (int i = 0; i < 2; ++i) vA[h][i] = vAn[h][i];
  }
  G8_WAIT_V(0);
  if (wr == 0) G8_BAR;
  G8_BAR;
#undef G8_SA
#undef G8_SB
#undef G8_STAGE
#undef G8_LDA
#undef G8_LDB
#undef G8_MMA
#undef G8_WAIT_V
#undef G8_WAIT_L
#undef G8_BAR
#undef G8_SCHED
#undef G8_AOFF
}
struct EpiU {
  static constexpr bool PERM = true; bf16_t* u;
  __device__ __forceinline__ void operator()(const f32x4 (&acc)[2][2][4][2], const Unit& un, int wr, int wc, int fr, int fq) const {
#pragma unroll
    for (int ai = 0; ai < 2; ++ai)
#pragma unroll
      for (int m = 0; m < 4; ++m) { bf16_t* rowp = u + (size_t)(un.ar0 + ai * HALF + wr * 64 + m * 16 + fr) * NU;
#pragma unroll
        for (int bj = 0; bj < 2; ++bj) { const int c0 = un.pn * BM + bj * HALF + wc * 32 + 8 * fq;
          { u32x4 w; w.x = cvt_pk_bf16(acc[ai][bj][m][0][0], acc[ai][bj][m][0][1]); w.y = cvt_pk_bf16(acc[ai][bj][m][0][2], acc[ai][bj][m][0][3]);
            w.z = cvt_pk_bf16(acc[ai][bj][m][1][0], acc[ai][bj][m][1][1]); w.w = cvt_pk_bf16(acc[ai][bj][m][1][2], acc[ai][bj][m][1][3]); *(u32x4*)(rowp + c0) = w; } } }
  }
};
struct EpiYo {
  static constexpr bool PERM = true; bf16_t* yo;
  __device__ __forceinline__ void operator()(const f32x4 (&acc)[2][2][4][2], const Unit& un, int wr, int wc, int fr, int fq) const {
#pragma unroll
    for (int ai = 0; ai < 2; ++ai)
#pragma unroll
      for (int m = 0; m < 4; ++m) { bf16_t* rowp = yo + (size_t)(un.ar0 + ai * HALF + wr * 64 + m * 16 + fr) * D + un.pn * BM + wc * 32 + 8 * fq;
#pragma unroll
        for (int bj = 0; bj < 2; ++bj) { u32x4 w; w.x = cvt_pk_bf16(acc[ai][bj][m][0][0], acc[ai][bj][m][0][1]); w.y = cvt_pk_bf16(acc[ai][bj][m][0][2], acc[ai][bj][m][0][3]);
          w.z = cvt_pk_bf16(acc[ai][bj][m][1][0], acc[ai][bj][m][1][1]); w.w = cvt_pk_bf16(acc[ai][bj][m][1][2], acc[ai][bj][m][1][3]); *(u32x4*)(rowp + bj * HALF) = w; } }
  }
};
struct EpiAct {
  static constexpr bool PERM = true; bf16_t* act;
  __device__ __forceinline__ void operator()(const f32x4 (&acc)[2][2][4][2], const Unit& un, int wr, int wc, int fr, int fq) const {
#pragma unroll
    for (int ai = 0; ai < 2; ++ai)
#pragma unroll
      for (int m = 0; m < 4; ++m) { bf16_t* dst = act + (size_t)(un.ar0 + ai * HALF + wr * 64 + m * 16 + fr) * D + un.pn * HALF + wc * 32 + 8 * fq; float v[8];
#pragma unroll
        for (int n = 0; n < 2; ++n)
#pragma unroll
          for (int j = 0; j < 4; ++j) { const float g = acc[ai][0][m][n][j]; v[n * 4 + j] = g * __builtin_amdgcn_rcpf(1.f + __expf(-g)) * acc[ai][1][m][n][j]; }
        u32x4 w; w.x = cvt_pk_bf16(v[0], v[1]); w.y = cvt_pk_bf16(v[2], v[3]); w.z = cvt_pk_bf16(v[4], v[5]); w.w = cvt_pk_bf16(v[6], v[7]); *(u32x4*)dst = w; }
  }
};
struct EpiYm {
  static constexpr bool PERM = true; bf16_t* ym; const float* sw;
  __device__ __forceinline__ void operator()(const f32x4 (&acc)[2][2][4][2], const Unit& un, int wr, int wc, int fr, int fq) const {
#pragma unroll
    for (int ai = 0; ai < 2; ++ai)
#pragma unroll
      for (int m = 0; m < 4; ++m) { const int row = un.ar0 + ai * HALF + wr * 64 + m * 16 + fr; const float w8 = sw[row]; bf16_t* rowp = ym + (size_t)row * D + un.pn * BM + wc * 32 + 8 * fq;
#pragma unroll
        for (int bj = 0; bj < 2; ++bj) { u32x4 w; w.x = cvt_pk_bf16(acc[ai][bj][m][0][0] * w8, acc[ai][bj][m][0][1] * w8); w.y = cvt_pk_bf16(acc[ai][bj][m][0][2] * w8, acc[ai][bj][m][0][3] * w8);
          w.z = cvt_pk_bf16(acc[ai][bj][m][1][0] * w8, acc[ai][bj][m][1][1] * w8); w.w = cvt_pk_bf16(acc[ai][bj][m][1][2] * w8, acc[ai][bj][m][1][3] * w8); *(u32x4*)(rowp + bj * HALF) = w; } }
  }
};
}

__device__ __forceinline__ void phase_gemm_in(CParams& p, int layer, int bid, int nb, int tid_, char* smem) {
  g8::SchedPlain S; S.nM = TT / 256; S.nN = NUP / 256; S.nwg = S.nM * S.nN; S.G = nb; S.c = bid;
  g8::EpiU E; E.u = p.u;
  g8::gemm8<false>((LAS unsigned char*)smem, p.hb, nullptr, p.win_t + (size_t)layer * NUP * D, S, E, tid_);
}
__device__ __forceinline__ void phase_gemm_out(CParams& p, int layer, int bid, int nb, int tid_, char* smem) {
  g8::SchedPlain S; S.nM = (layer == 0 ? TT : TL) / 256; S.nN = D / 256; S.nwg = S.nM * S.nN; S.G = nb; S.c = bid;
  g8::EpiYo E; E.yo = p.yo;
  g8::gemm8<false>((LAS unsigned char*)smem, p.y, nullptr, p.wout_t + (size_t)layer * D * D, S, E, tid_);
}
__device__ __forceinline__ void phase_gemm_moe1(CParams& p, int layer, int bid, int nb, int tid_, char* smem) {
  g8::SchedMoe S; S.mt_e = layer == 0 ? 17 : 16; S.nN = 8; S.G = nb; S.c = bid;
  g8::EpiAct E; E.act = p.act;
  g8::gemm8<true>((LAS unsigned char*)smem, p.hb, p.slot_tok, p.wgu_t, S, E, tid_);
}
__device__ __forceinline__ void phase_gemm_moe2(CParams& p, int layer, int bid, int nb, int tid_, char* smem) {
  g8::SchedMoe S; S.mt_e = layer == 0 ? 17 : 16; S.nN = 4; S.G = nb; S.c = bid;
  g8::EpiYm E; E.ym = p.ymoe; E.sw = p.slot_w;
  g8::gemm8<false>((LAS unsigned char*)smem, p.act, nullptr, p.wdn_t, S, E, tid_);
}

template <int MT, int NTL, int KS, int LDA, int LDB>
__device__ __forceinline__ void wmm(f32x4 (&acc)[MT][NTL], const bf16_t* A, const bf16_t* B, int fr, int fq) {
#pragma unroll
  for (int ks = 0; ks < KS; ++ks) {
    bf16x8 a[MT], b[NTL];
#pragma unroll
    for (int m = 0; m < MT; ++m) a[m] = *(const bf16x8*)(A + (m * 16 + fr) * LDA + ks * 32 + fq * 8);
#pragma unroll
    for (int n = 0; n < NTL; ++n) b[n] = *(const bf16x8*)(B + (n * 16 + fr) * LDB + ks * 32 + fq * 8);
#pragma unroll
    for (int m = 0; m < MT; ++m)
#pragma unroll
      for (int n = 0; n < NTL; ++n) acc[m][n] = __builtin_amdgcn_mfma_f32_16x16x32_bf16(a[m], b[n], acc[m][n], 0, 0, 0);
  }
}
constexpr int NCH = 132;
__device__ __forceinline__ int chunk_row0(int b, int cpos) { return cpos < 4 ? TL + b * CTX + cpos * 64 : b * SEQ + (cpos - 4) * 64; }
__device__ __forceinline__ int scan_idx(int cpos, int dir) { return dir == 0 ? cpos : (cpos < 4 ? 3 - cpos : 135 - cpos); }

struct GlaLds {
  bf16_t rq[64][32], rk[64][32], rv[64][64], rog[64][64], rlr[64][32];
  float w2s[2][16][32]; float gbs[2][32]; float g[2][64][36]; float gt[2][32];
  bf16_t qg[2][64][40]; bf16_t kg[2][64][40];
  bf16_t vt[64][72]; bf16_t at[2][64][72]; float ox[64][65];
};
template <int PASS>
__device__ __forceinline__ void phase_gla_chunk(CParams& p, int layer, int bid, int nb, int tid_, char* smem) {
  GlaLds& L = *(GlaLds*)smem;
  const int c_lo = (PASS == 1 && layer == DEPTH - 1) ? 4 : 0, ncp = NCH - c_lo;
  uint4 r0 = make_uint4(0u, 0u, 0u, 0u), r1 = r0, r2 = r0, r3 = r0; float w2a = 0.f, w2b = 0.f, gbv = 0.f;
  auto gfetch = [&](int task_, int tid) { const int h_ = task_ & 3, cpos_ = c_lo + (task_ >> 2) % ncp, b_ = (task_ >> 2) / ncp; const bf16_t* U0_ = p.u + (size_t)chunk_row0(b_, cpos_) * NU;
    auto gsrc = [&](int i) -> const bf16_t* { const int f = (i * 2341) >> 16, c = i - f * 28;
      const int col = c < 4 ? h_ * 32 + c * 8 : (c < 8 ? 128 + h_ * 32 + (c - 4) * 8 : (c < 16 ? 256 + h_ * 64 + (c - 8) * 8 : (c < 24 ? 512 + h_ * 64 + (c - 16) * 8 : 768 + (c - 24) * 8)));
      return U0_ + (size_t)f * NU + col; };
    r0 = *(const uint4*)gsrc(tid); r1 = *(const uint4*)gsrc(tid + NT); r2 = *(const uint4*)gsrc(tid + 2 * NT);
    if (tid < 64 * 28 - 3 * NT) r3 = *(const uint4*)gsrc(tid + 3 * NT);
    const int i0 = tid, i1 = tid + NT;
    w2a = p.gla_w2[((size_t)(layer * 2 + (i0 >> 9)) * 16 + ((i0 >> 5) & 15)) * 128 + h_ * 32 + (i0 & 31)]; w2b = p.gla_w2[((size_t)(layer * 2 + (i1 >> 9)) * 16 + ((i1 >> 5) & 15)) * 128 + h_ * 32 + (i1 & 31)];
    if (tid < 64) gbv = p.gla_b[(layer * 2 + (tid >> 5)) * 128 + h_ * 32 + (tid & 31)]; };
  if (bid < NB * ncp * 4) gfetch(bid, tid_);
  for (int task = bid; task < NB * ncp * 4; task += nb) {
    int tid = tid_; asm volatile("" : "+v"(tid));
    const int lane = tid & 63, wv = tid >> 6, fr = lane & 15, fq = lane >> 4, dirw = wv >> 2, s4 = wv & 3;
    const int h = task & 3, cpos = c_lo + (task >> 2) % ncp, b = (task >> 2) / ncp;
    const int row0 = chunk_row0(b, cpos);
    const bf16_t* U0 = p.u + (size_t)row0 * NU;
    const int seq = (b * 4 + h) * 2 + dirw, nsc = scan_idx(cpos, dirw);
    bf16x8 sfrag[4];
    if (PASS == 1) { const bf16_t* sb = p.gla_l + ((size_t)seq * NCH + nsc) * 2048;
#pragma unroll
      for (int n = 0; n < 4; ++n) sfrag[n] = *(const bf16x8*)(sb + (n * 16 + fr) * 32 + fq * 8); }
    { auto ldst = [&](int i) -> bf16_t* { const int f = (i * 2341) >> 16, c = i - f * 28;
        return c < 4 ? &L.rq[f][c * 8] : (c < 8 ? &L.rk[f][(c - 4) * 8] : (c < 16 ? &L.rv[f][(c - 8) * 8] : (c < 24 ? &L.rog[f][(c - 16) * 8] : &L.rlr[f][(c - 24) * 8]))); };
      *(uint4*)ldst(tid) = r0; *(uint4*)ldst(tid + NT) = r1; *(uint4*)ldst(tid + 2 * NT) = r2;
      if (tid < 64 * 28 - 3 * NT) *(uint4*)ldst(tid + 3 * NT) = r3;
      (&L.w2s[0][0][0])[tid] = w2a; (&L.w2s[0][0][0])[tid + NT] = w2b;
      if (tid < 64) L.gbs[tid >> 5][tid & 31] = gbv; }
    if (task + nb < NB * ncp * 4) gfetch(task + nb, tid);
    __syncthreads();
    { const int dir = tid >> 8, f = (tid >> 2) & 63, d0 = (tid & 3) * 8;
      float z[8];
#pragma unroll
      for (int e = 0; e < 8; ++e) z[e] = L.gbs[dir][d0 + e];
      const uint4 l0 = *(const uint4*)&L.rlr[f][dir * 16], l1 = *(const uint4*)&L.rlr[f][dir * 16 + 8];
      const unsigned lw[8] = {l0.x, l0.y, l0.z, l0.w, l1.x, l1.y, l1.z, l1.w};
#pragma unroll
      for (int r = 0; r < 16; ++r) { const float lv = (r & 1) ? __uint_as_float(lw[r >> 1] & 0xffff0000u) : __uint_as_float(lw[r >> 1] << 16);
        const float4 wa = *(const float4*)&L.w2s[dir][r][d0], wb = *(const float4*)&L.w2s[dir][r][d0 + 4];
        z[0] += lv * wa.x; z[1] += lv * wa.y; z[2] += lv * wa.z; z[3] += lv * wa.w; z[4] += lv * wb.x; z[5] += lv * wb.y; z[6] += lv * wb.z; z[7] += lv * wb.w; }
#pragma unroll
      for (int e = 0; e < 8; ++e) z[e] = logsigmoidf_(z[e]) * (1.f / 16.f);
      *(float4*)&L.g[dir][f][d0] = make_float4(z[0], z[1], z[2], z[3]); *(float4*)&L.g[dir][f][d0 + 4] = make_float4(z[4], z[5], z[6], z[7]); }
    __syncthreads();
#pragma unroll
    for (int cc = 0; cc < 8; ++cc) { const int col = wv * 8 + cc, dir = col >> 5, d = col & 31, f = dir ? 63 - lane : lane;
      float v = L.g[dir][f][d];
#pragma unroll
      for (int o = 1; o < 64; o <<= 1) { const float t = __shfl_up(v, o); if (lane >= o) v += t; }
      L.g[dir][f][d] = v; if (lane == 63) L.gt[dir][d] = v; }
    __syncthreads();
    if (PASS == 1) {
      for (int i = tid; i < 2 * 64 * 16; i += NT) { int dir = i >> 10, f = (i >> 4) & 63, dp = i & 15;
        const unsigned qq = *(const unsigned*)&L.rq[f][2 * dp], kk = *(const unsigned*)&L.rk[f][2 * dp];
        const float2 cc = *(const float2*)&L.g[dir][f][2 * dp];
        const float e0 = __expf(cc.x), e1 = __expf(cc.y);
        *(unsigned*)&L.qg[dir][f][2 * dp] = pack2(__uint_as_float(qq << 16) * e0 * 0.17677669529663687f, __uint_as_float(qq & 0xffff0000u) * e1 * 0.17677669529663687f);
        *(unsigned*)&L.kg[dir][f][2 * dp] = pack2(__uint_as_float(kk << 16) * __builtin_amdgcn_rcpf(e0), __uint_as_float(kk & 0xffff0000u) * __builtin_amdgcn_rcpf(e1)); }
    } else {
      bf16_t (*ket)[32][72] = (bf16_t (*)[32][72])&L.kg[0][0][0];
      for (int i = tid; i < 2 * 32 * 16; i += NT) { int d = i & 31, f4 = (i >> 5) & 15, dir = i >> 9, f0 = f4 * 4; float v[4];
#pragma unroll
        for (int q = 0; q < 4; ++q) v[q] = bf2f(L.rk[f0 + q][d]) * __expf(L.gt[dir][d] - L.g[dir][f0 + q][d]);
        uint2 pk; pk.x = pack2(v[0], v[1]); pk.y = pack2(v[2], v[3]); *(uint2*)&ket[dir][d][f0] = pk; }
    }
    for (int i = tid; i < 64 * 16; i += NT) { int c = i & 63, f0 = (i >> 6) * 4;
      uint2 pk; pk.x = (unsigned)L.rv[f0][c] | ((unsigned)L.rv[f0 + 1][c] << 16); pk.y = (unsigned)L.rv[f0 + 2][c] | ((unsigned)L.rv[f0 + 3][c] << 16); *(uint2*)&L.vt[c][f0] = pk; }
    __syncthreads();
    if (PASS == 0) {
      const bf16_t (*ket)[32][72] = (const bf16_t (*)[32][72])&L.kg[0][0][0];
      f32x4 acc[2][1] = {{{0.f, 0.f, 0.f, 0.f}}, {{0.f, 0.f, 0.f, 0.f}}};
      wmm<2, 1, 2, 72, 72>(acc, &ket[dirw][0][0], &L.vt[s4 * 16][0], fr, fq);
      bf16_t* dst = p.gla_l + ((size_t)seq * NCH + nsc) * 2048 + (s4 * 16 + fr) * 32;
#pragma unroll
      for (int m = 0; m < 2; ++m) { uint2 pk; pk.x = pack2(acc[m][0][0], acc[m][0][1]); pk.y = pack2(acc[m][0][2], acc[m][0][3]); *(uint2*)(dst + m * 16 + fq * 4) = pk; }
      if (tid < 64) { int dir = tid >> 5, d = tid & 31; p.gla_dec[((size_t)((b * 4 + h) * 2 + dir) * NCH + scan_idx(cpos, dir)) * 32 + d] = __expf(L.gt[dir][d]); }
    } else {
      { f32x4 acc[4][1];
#pragma unroll
        for (int m = 0; m < 4; ++m) acc[m][0] = (f32x4){0.f, 0.f, 0.f, 0.f};
        wmm<4, 1, 1, 40, 40>(acc, &L.kg[dirw][0][0], &L.qg[dirw][s4 * 16][0], fr, fq);
        const int i = s4 * 16 + fr;
#pragma unroll
        for (int m = 0; m < 4; ++m) { float v[4];
#pragma unroll
          for (int q = 0; q < 4; ++q) { int j = m * 16 + fq * 4 + q; bool keep = dirw == 0 ? (j <= i) : (j >= i); v[q] = keep ? acc[m][0][q] : 0.f; }
          uint2 pk; pk.x = pack2(v[0], v[1]); pk.y = pack2(v[2], v[3]); *(uint2*)&L.at[dirw][i][m * 16 + fq * 4] = pk; } }
      f32x4 ao[1][4];
#pragma unroll
      for (int n = 0; n < 4; ++n) ao[0][n] = (f32x4){0.f, 0.f, 0.f, 0.f};
      wmm<1, 4, 2, 72, 72>(ao, &L.at[dirw][s4 * 16][0], &L.vt[0][0], fr, fq);
      { bf16x8 a = *(const bf16x8*)&L.qg[dirw][s4 * 16 + fr][fq * 8];
#pragma unroll
        for (int n = 0; n < 4; ++n) ao[0][n] = __builtin_amdgcn_mfma_f32_16x16x32_bf16(a, sfrag[n], ao[0][n], 0, 0, 0); }
      if (dirw == 1) {
#pragma unroll
        for (int n = 0; n < 4; ++n)
#pragma unroll
          for (int q = 0; q < 4; ++q) L.ox[s4 * 16 + fq * 4 + q][n * 16 + fr] = ao[0][n][q]; }
      __syncthreads();
      if (dirw == 0) {
        float ss[4] = {0.f, 0.f, 0.f, 0.f};
#pragma unroll
        for (int n = 0; n < 4; ++n)
#pragma unroll
          for (int q = 0; q < 4; ++q) { ao[0][n][q] += L.ox[s4 * 16 + fq * 4 + q][n * 16 + fr]; ss[q] += ao[0][n][q] * ao[0][n][q]; }
#pragma unroll
        for (int q = 0; q < 4; ++q) {
#pragma unroll
          for (int o = 1; o < 16; o <<= 1) ss[q] += __shfl_xor(ss[q], o);
          ss[q] = rsqrtf(ss[q] * (1.f / 64.f) + 1e-6f); }
#pragma unroll
        for (int n = 0; n < 4; ++n) { const int c = n * 16 + fr; const float nw = p.gla_norm[layer * 256 + h * 64 + c];
#pragma unroll
          for (int q = 0; q < 4; ++q) { const int f = s4 * 16 + fq * 4 + q; float og = bf2f(L.rog[f][c]);
            p.y[(size_t)(row0 + f) * D + h * 64 + c] = f2bf(ao[0][n][q] * ss[q] * nw * siluf(og)); } }
      }
    }
    __syncthreads();
  }
}
__device__ __forceinline__ void phase_gla_state(CParams& p, int bid, int nb, int tid_) {
  for (int i = bid * NT + tid_; i < 32 * 1024; i += nb * NT) {
    const int seq = i >> 10, e2 = (i & 1023) * 2;
    unsigned* lp = (unsigned*)(p.gla_l + (size_t)seq * NCH * 2048 + e2);
    const float* dp = p.gla_dec + (size_t)seq * NCH * 32 + (e2 & 31);
    float s0 = 0.f, s1 = 0.f;
    for (int n = 0; n < NCH; n += 12) {
      unsigned lv[12]; float2 dc[12];
#pragma unroll
      for (int q = 0; q < 12; ++q) { lv[q] = lp[(size_t)(n + q) * 1024]; dc[q] = *(const float2*)(dp + (n + q) * 32); }
#pragma unroll
      for (int q = 0; q < 12; ++q) { lp[(size_t)(n + q) * 1024] = pack2(s0, s1); s0 = s0 * dc[q].x + bf2f((bf16_t)(lv[q] & 0xffff)); s1 = s1 * dc[q].y + bf2f((bf16_t)(lv[q] >> 16)); }
    }
  }
}

__device__ __forceinline__ void phase_hy_prep(CParams& p, int layer, int bid, int nb, int tid_) {
  if (layer != 0) return;
  for (long i = (long)bid * NT + tid_; i < (long)TC * 768; i += (long)nb * NT) {
    int row = TL + (int)(i / 768), c = (int)(i % 768);
    int rm = seq_nb(row, -1, false), rp = seq_nb(row, 1, false);
    const float* w = p.hy_conv_w + (size_t)layer * 3 * 768;
    float a = p.hy_conv_b[layer * 768 + c] + w[768 + c] * bf2f(p.u[(size_t)row * NU + U_HY + c]);
    if (rm >= 0) a += w[c] * bf2f(p.u[(size_t)rm * NU + U_HY + c]);
    if (rp >= 0) a += w[2 * 768 + c] * bf2f(p.u[(size_t)rp * NU + U_HY + c]);
    p.prep[(size_t)row * 768 + c] = f2bf(a);
  }
}
template <bool TR>
__device__ __forceinline__ void phase_hy_filt(CParams& p, int layer, int L, float* filt, int bid, int nb, int tid_, char* smem) {
  constexpr int PP = 16;
  float* feats = (float*)smem;
  float* h1 = feats + PP * 36;
  float* h2 = h1 + PP * 64;
  float* h3 = h2 + PP * 64;
  float* w1s = h3 + PP * 64;
  float* w2s = w1s + 33 * 64; float* w3s = w2s + 64 * 64; float* bfs = w3s + 64 * 64;
  const int t = tid_;
  const float* w4 = p.hy_w4 + (size_t)layer * 64 * 1024;
  for (int i = t; i < 33 * 64; i += NT) w1s[i] = p.hy_w1[(size_t)layer * 33 * 64 + i];
  for (int i = t; i < 64 * 64; i += NT) { w2s[i] = p.hy_w2[(size_t)layer * 64 * 64 + i]; w3s[i] = p.hy_w3[(size_t)layer * 64 * 64 + i]; }
  if (t < 64) { bfs[t] = p.hy_b1[layer * 64 + t]; bfs[64 + t] = p.hy_b2[layer * 64 + t]; bfs[128 + t] = p.hy_b3[layer * 64 + t]; }
  if (t < 192) bfs[192 + t] = p.hy_freq[layer * 192 + t];
  __syncthreads();
  for (int blk = bid; blk < L / PP; blk += nb) {
    const int pos0 = blk * PP;
    for (int i = t; i < PP * 33; i += NT) {
      int pp = i / 33, f = i % 33; float pos = (float)(pos0 + pp); float v;
      if (f == 0) v = pos / (float)(L - 1);
      else { int j = (f - 1) & 15; float band = 1e-4f + (float)j * ((15.f - 1e-4f) / 15.f); float ang = (6.283185307179586f / (float)L) * pos * band; v = f <= 16 ? cosf(ang) : -sinf(ang); }
      feats[pp * 36 + f] = v;
    }
    __syncthreads();
    for (int i = t; i < PP * 64; i += NT) { int pp = i >> 6, j = i & 63; float a = bfs[j];
#pragma unroll
      for (int k = 0; k < 33; ++k) a += feats[pp * 36 + k] * w1s[k * 64 + j];
      h1[i] = sinf(bfs[192 + j] * a); }
    __syncthreads();
    for (int i = t; i < PP * 64; i += NT) { int pp = i >> 6, j = i & 63; float a = bfs[64 + j];
#pragma unroll 16
      for (int k = 0; k < 64; ++k) a += h1[pp * 64 + k] * w2s[k * 64 + j];
      h2[i] = sinf(bfs[256 + j] * a); }
    __syncthreads();
    for (int i = t; i < PP * 64; i += NT) { int pp = i >> 6, j = i & 63; float a = bfs[128 + j];
#pragma unroll 16
      for (int k = 0; k < 64; ++k) a += h2[pp * 64 + k] * w3s[k * 64 + j];
      h3[i] = sinf(bfs[320 + j] * a); }
    __syncthreads();
#pragma unroll 1
    for (int cc = 0; cc < 1024 / NT; ++cc) {
      int col = cc * NT + t, c = col & 255;
      float acc[PP];
#pragma unroll
      for (int pp = 0; pp < PP; ++pp) acc[pp] = 0.f;
#pragma unroll 1
      for (int k0 = 0; k0 < 64; k0 += 16) { float wv[16];
#pragma unroll
        for (int k = 0; k < 16; ++k) wv[k] = w4[(k0 + k) * 1024 + col];
#pragma unroll
        for (int k = 0; k < 16; ++k)
#pragma unroll
          for (int pp = 0; pp < PP; ++pp) acc[pp] += h3[pp * 64 + k0 + k] * wv[k]; }
      const float mind = -3.0701134573253945f, maxd = -15.350567286626973f;
      float delta = fabsf(mind + (float)c * ((maxd - mind) / 255.f));
#pragma unroll
      for (int pp = 0; pp < PP; ++pp) { float tn = (float)(pos0 + pp) / (float)(L - 1); float fv = acc[pp] * __expf(-tn * delta); if (TR) filt[(size_t)col * L + pos0 + pp] = fv; else filt[(size_t)(pos0 + pp) * 1024 + col] = fv; }
    }
    __syncthreads();
  }
}
__device__ __forceinline__ void phase_hy_conv(CParams& p, int layer, int stage, bool ctx, int bid, int nb, int tid_) {
  const int L = ctx ? CTX : SEQ, rbase = ctx ? TL : 0;
  const float* filt = ctx ? p.filtc : p.filt;
  const int ntt = L / 16;
  const int total = NB * ntt * 256;
  for (int i = bid * NT + tid_; i < total; i += nb * NT) {
    const int c = i & 255, tt = (i >> 8) % ntt, b = (i >> 8) / ntt, t0 = tt * 16;
    const float* ff = filt + stage * 512 + c;
    float acc[16], win[16];
#pragma unroll
    for (int k = 0; k < 16; ++k) acc[k] = 0.f;
#pragma unroll
    for (int k = 0; k < 16; ++k) win[k] = ff[(size_t)(t0 + k) * 1024];
    for (int s0 = 0; s0 < L; s0 += 16) {
#pragma unroll
      for (int ss = 0; ss < 16; ++ss) {
        const int s = s0 + ss; const int row = rbase + b * L + s;
        float uv = stage == 0 ? bf2f(p.prep[(size_t)row * 768 + c]) : p.zbuf[(size_t)row * 256 + c];
#pragma unroll
        for (int k = 0; k < 16; ++k) acc[k] += win[(k + 16 - ss) & 15] * uv;
        int dl = t0 - (s + 1);
        float nv = 0.f;
        if (s + 1 < L) nv = dl >= 0 ? ff[(size_t)dl * 1024] : ff[(size_t)(-dl) * 1024 + 256];
        win[(15 + 16 - ss) & 15] = nv;
      }
    }
    const float dsk = p.hy_d[(layer * 2 + stage) * 256 + c];
#pragma unroll
    for (int k = 0; k < 16; ++k) {
      const int row = rbase + b * L + t0 + k;
      if (stage == 0) { float vv = bf2f(p.prep[(size_t)row * 768 + c]); float x1 = bf2f(p.prep[(size_t)row * 768 + 256 + c]); p.zbuf[(size_t)row * 256 + c] = x1 * (acc[k] + dsk * vv); }
      else { float zz = p.zbuf[(size_t)row * 256 + c]; float x2 = bf2f(p.prep[(size_t)row * 768 + 512 + c]); p.y[(size_t)row * D + 256 + c] = f2bf(x2 * (acc[k] + dsk * zz)); }
    }
  }
}

__device__ __forceinline__ void phase_hy_prep_t(CParams& p, int layer, int bid, int nb, int tid_, char* smem) {
  bf16_t (*tl)[72] = (bf16_t (*)[72])smem;
  const float* w = p.hy_conv_w + (size_t)layer * 3 * 768; const float* bs = p.hy_conv_b + layer * 768;
  for (int task = bid; task < NB * (SEQ / 64); task += nb) {
    int tid = tid_; asm volatile("" : "+v"(tid));
    const int b = task / (SEQ / 64), t0 = (task % (SEQ / 64)) * 64;
#pragma unroll 4
    for (int i = tid; i < 64 * 96; i += NT) { const int c6 = i >> 6, cq = (c6 * 43) >> 9  , ck = (i & 7) + 8 * (c6 - cq * 12), tl_ = ((i >> 3) & 7) + 8 * cq, t = t0 + tl_; const int row = b * SEQ + t;
      float o[8]; conv8(p.u, U_HY, row, t > 0 ? row - 1 : -1, t < SEQ - 1 ? row + 1 : -1, w, bs, ck * 8, o);
#pragma unroll
      for (int e = 0; e < 8; ++e) tl[ck * 8 + e][tl_] = f2bf(o[e]); }
    __syncthreads();
    for (int i = tid; i < 768 * 8; i += NT) { const int c = i >> 3, ch = i & 7; *(uint4*)(p.prep + ((size_t)(b * 768 + c)) * SEQ + t0 + ch * 8) = *(const uint4*)&tl[c][ch * 8]; }
    __syncthreads();
  }
}
#define FPAD(i) ((i) + (((i) >> 5) << 1))
struct FftLds { float2 x[16384 + 1024]; float2 t1[128]; float2 t0[128]; };
__device__ __forceinline__ float2 cmulf(float2 a, float2 b) { return make_float2(a.x * b.x - a.y * b.y, a.x * b.y + a.y * b.x); }
__device__ __forceinline__ float2 cmulcf(float2 a, float2 w) { return make_float2(a.x * w.x + a.y * w.y, a.y * w.x - a.x * w.y); }
__device__ __forceinline__ float2 caddf(float2 a, float2 b) { return make_float2(a.x + b.x, a.y + b.y); }
__device__ __forceinline__ float2 csubf(float2 a, float2 b) { return make_float2(a.x - b.x, a.y - b.y); }
template <bool INV> __device__ __forceinline__ void r4bf(float2& a0, float2& a1, float2& a2, float2& a3) {
  const float2 s0 = caddf(a0, a2), s1 = csubf(a0, a2), s2 = caddf(a1, a3), d = csubf(a1, a3);
  const float2 s3 = INV ? make_float2(-d.y, d.x) : make_float2(d.y, -d.x);
  a0 = caddf(s0, s2); a1 = caddf(s1, s3); a2 = csubf(s0, s2); a3 = csubf(s1, s3);
}
__device__ __forceinline__ float2 w16c(int k) {
  constexpr float C1 = 0.92387953251128674f, S1 = 0.38268343236508977f, R2 = 0.70710678118654752f;
  return k == 1 ? make_float2(C1, -S1) : k == 2 ? make_float2(R2, -R2) : k == 3 ? make_float2(S1, -C1) : k == 4 ? make_float2(0.f, -1.f) : k == 6 ? make_float2(-R2, -R2) :   make_float2(-C1, S1);
}
template <bool INV, int LQ, bool HALF = false>
__device__ __forceinline__ void fft_pass16(FftLds& L, int tid) {
  constexpr int Q = 1 << LQ;
#pragma unroll
  for (int i = 0; i < 2; ++i) {
    const int bf = tid + 512 * i, j = bf & (Q - 1), base = ((bf >> LQ) << (LQ + 4)) + j, k = j << (10 - LQ);
    float2 v[16];
#pragma unroll
    for (int s2 = 0; s2 < 16; ++s2) v[s2] = (HALF && !INV && s2 >= 8) ? make_float2(0.f, 0.f) : L.x[FPAD(base + s2 * Q)];
    const float2 w1 = cmulf(L.t1[k >> 7], L.t0[k & 127]), w2 = cmulf(w1, w1), w3 = cmulf(w2, w1), w4 = cmulf(w2, w2), w8 = cmulf(w4, w4), w12 = cmulf(w8, w4);
    const float2 wm[4] = {make_float2(1.f, 0.f), w1, w2, w3}, wn[4] = {make_float2(1.f, 0.f), w4, w8, w12};
    if (!INV) {
#pragma unroll
      for (int q = 0; q < 4; ++q) {
        if (HALF) { const float2 a0 = v[q], a1 = v[q + 4];
          v[q] = caddf(a0, a1); v[q + 4] = make_float2(a0.x + a1.y, a0.y - a1.x); v[q + 8] = csubf(a0, a1); v[q + 12] = make_float2(a0.x - a1.y, a0.y + a1.x); }
        else r4bf<false>(v[q], v[q + 4], v[q + 8], v[q + 12]); }
#pragma unroll
      for (int m = 1; m < 4; ++m)
#pragma unroll
        for (int q = 0; q < 4; ++q) { float2 t = v[q + 4 * m]; if (q > 0) t = cmulf(t, w16c(q * m)); v[q + 4 * m] = cmulf(t, wm[m]); }
#pragma unroll
      for (int m = 0; m < 4; ++m) { r4bf<false>(v[4 * m], v[4 * m + 1], v[4 * m + 2], v[4 * m + 3]);
#pragma unroll
        for (int n = 1; n < 4; ++n) v[4 * m + n] = cmulf(v[4 * m + n], wn[n]); }
    } else {
#pragma unroll
      for (int m = 0; m < 4; ++m) {
#pragma unroll
        for (int n = 1; n < 4; ++n) v[4 * m + n] = cmulcf(v[4 * m + n], wn[n]);
        r4bf<true>(v[4 * m], v[4 * m + 1], v[4 * m + 2], v[4 * m + 3]); }
#pragma unroll
      for (int m = 1; m < 4; ++m)
#pragma unroll
        for (int q = 0; q < 4; ++q) { float2 t = cmulcf(v[q + 4 * m], wm[m]); if (q > 0) t = cmulcf(t, w16c(q * m)); v[q + 4 * m] = t; }
#pragma unroll
      for (int q = 0; q < 4; ++q) {
        if (HALF) { const float2 c0 = v[q], c1 = v[q + 4], c2 = v[q + 8], c3 = v[q + 12]; const float2 s0 = caddf(c0, c2), s1 = csubf(c0, c2), s2 = caddf(c1, c3), d = csubf(c1, c3);
          v[q] = caddf(s0, s2); v[q + 4] = make_float2(s1.x - d.y, s1.y + d.x); }
        else r4bf<true>(v[q], v[q + 4], v[q + 8], v[q + 12]); }
    }
#pragma unroll
    for (int s2 = 0; s2 < ((HALF && INV) ? 8 : 16); ++s2) L.x[FPAD(base + s2 * Q)] = v[s2];
  }
  __syncthreads();
}
template <bool INV> __device__ __forceinline__ void fft_pass4_last(FftLds& L, int tid) {
#pragma unroll 2
  for (int i = 0; i < 8; ++i) { const int p0 = FPAD(4 * (tid + 512 * i));
    float4 u0 = *(const float4*)&L.x[p0], u1 = *(const float4*)&L.x[p0 + 2];
    float2 a0 = make_float2(u0.x, u0.y), a1 = make_float2(u0.z, u0.w), a2 = make_float2(u1.x, u1.y), a3 = make_float2(u1.z, u1.w);
    r4bf<INV>(a0, a1, a2, a3);
    *(float4*)&L.x[p0] = make_float4(a0.x, a0.y, a1.x, a1.y); *(float4*)&L.x[p0 + 2] = make_float4(a2.x, a2.y, a3.x, a3.y); }
  __syncthreads();
}
template <bool INV, bool HALF = false>
__device__ __forceinline__ void fft16k(FftLds& L, int tid) {
  if (!INV) { fft_pass16<false, 10, HALF>(L, tid); fft_pass16<false, 6>(L, tid); fft_pass16<false, 2>(L, tid); fft_pass4_last<false>(L, tid); }
  else { fft_pass4_last<true>(L, tid); fft_pass16<true, 2>(L, tid); fft_pass16<true, 6>(L, tid); fft_pass16<true, 10, HALF>(L, tid); }
}
__device__ __forceinline__ void phase_hy_fft(CParams& p, int layer, int bid, int nb, int tid_, char* smem) {
  FftLds& L = *(FftLds*)smem;
  for (int c = bid; c < 256; c += nb) {
    int tid = tid_; asm volatile("" : "+v"(tid));
    if (tid < 128) { float sn, cs; sincospif(-(float)tid / 64.f, &sn, &cs); L.t1[tid] = make_float2(cs, sn);
      sincospif(-(float)tid / 8192.f, &sn, &cs); L.t0[tid] = make_float2(cs, sn); }
#pragma unroll 1
    for (int o = 0; o < 2; ++o) {
      asm volatile("" : "+v"(tid));
      const float* hf = p.filt + (size_t)(o * 512 + c) * SEQ; const float* hb = p.filt + (size_t)(o * 512 + 256 + c) * SEQ;
      __syncthreads();
      { float4 fw[4]; float bw[16];
#pragma unroll
        for (int k = 0; k < 4; ++k) fw[k] = *(const float4*)(hf + 4 * (tid + NT * k));
#pragma unroll
        for (int k = 0; k < 16; ++k) { const int m = tid + NT * k; bw[k] = m == 0 ? 0.f : hb[SEQ - m]; }
#pragma unroll
        for (int k = 0; k < 4; ++k) { const int n = 4 * (tid + NT * k); *(float4*)&L.x[FPAD(n)] = make_float4(fw[k].x, 0.f, fw[k].y, 0.f); *(float4*)&L.x[FPAD(n + 2)] = make_float4(fw[k].z, 0.f, fw[k].w, 0.f); }
#pragma unroll
        for (int k = 0; k < 16; ++k) L.x[FPAD(SEQ + tid + NT * k)] = make_float2(bw[k], 0.f); }
      __syncthreads();
      fft16k<false>(L, tid);
      float4* specg = (float4*)(p.specg + (size_t)c * 16384);
#pragma unroll
      for (int k = 0; k < 16; ++k) { const float4 v = *(const float4*)&L.x[FPAD(2 * (tid + NT * k))]; const float sc = 1.f / 16384.f; specg[tid + NT * k] = make_float4(v.x * sc, v.y * sc, v.z * sc, v.w * sc); }
      const float dsk = p.hy_d[(layer * 2 + o) * 256 + c];
#pragma unroll 1
      for (int pr = 0; pr < 2; ++pr) {
        const int b0 = pr * 2, b1 = pr * 2 + 1;
        asm volatile("" : "+v"(tid));
        __syncthreads();
        if (o == 0) {
          const bf16_t* u0 = p.prep + ((size_t)(b0 * 768 + c)) * SEQ; const bf16_t* u1 = p.prep + ((size_t)(b1 * 768 + c)) * SEQ;
          uint2 xa[4], xb[4];
#pragma unroll
          for (int k = 0; k < 4; ++k) { xa[k] = *(const uint2*)(u0 + 4 * (tid + NT * k)); xb[k] = *(const uint2*)(u1 + 4 * (tid + NT * k)); }
#pragma unroll
          for (int k = 0; k < 4; ++k) { const int n = 4 * (tid + NT * k);
            *(float4*)&L.x[FPAD(n)] = make_float4(__uint_as_float(xa[k].x << 16), __uint_as_float(xb[k].x << 16), __uint_as_float(xa[k].x & 0xffff0000u), __uint_as_float(xb[k].x & 0xffff0000u));
            *(float4*)&L.x[FPAD(n + 2)] = make_float4(__uint_as_float(xa[k].y << 16), __uint_as_float(xb[k].y << 16), __uint_as_float(xa[k].y & 0xffff0000u), __uint_as_float(xb[k].y & 0xffff0000u)); }
        } else {
          const float* u0 = p.zbuf + ((size_t)(b0 * 256 + c)) * SEQ; const float* u1 = p.zbuf + ((size_t)(b1 * 256 + c)) * SEQ;
          float4 xa[4], xb[4];
#pragma unroll
          for (int k = 0; k < 4; ++k) { xa[k] = *(const float4*)(u0 + 4 * (tid + NT * k)); xb[k] = *(const float4*)(u1 + 4 * (tid + NT * k)); }
#pragma unroll
          for (int k = 0; k < 4; ++k) { const int n = 4 * (tid + NT * k);
            *(float4*)&L.x[FPAD(n)] = make_float4(xa[k].x, xb[k].x, xa[k].y, xb[k].y); *(float4*)&L.x[FPAD(n + 2)] = make_float4(xa[k].z, xb[k].z, xa[k].w, xb[k].w); }
        }
        __syncthreads();
        fft16k<false, true>(L, tid);
        { float4 sp[16];
#pragma unroll
          for (int k = 0; k < 16; ++k) sp[k] = specg[tid + NT * k];
#pragma unroll
          for (int k = 0; k < 16; ++k) { float4* px = (float4*)&L.x[FPAD(2 * (tid + NT * k))]; const float4 v = *px;
            *px = make_float4(v.x * sp[k].x - v.y * sp[k].y, v.x * sp[k].y + v.y * sp[k].x, v.z * sp[k].z - v.w * sp[k].w, v.z * sp[k].w + v.w * sp[k].z); } }
        __syncthreads();
        fft16k<true, true>(L, tid);
        if (o == 0) {
          const bf16_t* v0 = p.prep + ((size_t)(b0 * 768 + c)) * SEQ; const bf16_t* v1 = p.prep + ((size_t)(b1 * 768 + c)) * SEQ;
          const bf16_t* g0 = p.prep + ((size_t)(b0 * 768 + 256 + c)) * SEQ; const bf16_t* g1 = p.prep + ((size_t)(b1 * 768 + 256 + c)) * SEQ;
          float* z0 = p.zbuf + ((size_t)(b0 * 256 + c)) * SEQ; float* z1 = p.zbuf + ((size_t)(b1 * 256 + c)) * SEQ;
          uint2 va[4], vb[4], ga[4], gb[4];
#pragma unroll
          for (int k = 0; k < 4; ++k) { const int n = 4 * (tid + NT * k); va[k] = *(const uint2*)(v0 + n); vb[k] = *(const uint2*)(v1 + n); ga[k] = *(const uint2*)(g0 + n); gb[k] = *(const uint2*)(g1 + n); }
#pragma unroll
          for (int k = 0; k < 4; ++k) { const int n = 4 * (tid + NT * k); const float4 ya = *(const float4*)&L.x[FPAD(n)], yb = *(const float4*)&L.x[FPAD(n + 2)];
            float4 oa, ob;
            oa.x = __uint_as_float(ga[k].x << 16) * (ya.x + dsk * __uint_as_float(va[k].x << 16)); oa.y = __uint_as_float(ga[k].x & 0xffff0000u) * (ya.z + dsk * __uint_as_float(va[k].x & 0xffff0000u));
            oa.z = __uint_as_float(ga[k].y << 16) * (yb.x + dsk * __uint_as_float(va[k].y << 16)); oa.w = __uint_as_float(ga[k].y & 0xffff0000u) * (yb.z + dsk * __uint_as_float(va[k].y & 0xffff0000u));
            ob.x = __uint_as_float(gb[k].x << 16) * (ya.y + dsk * __uint_as_float(vb[k].x << 16)); ob.y = __uint_as_float(gb[k].x & 0xffff0000u) * (ya.w + dsk * __uint_as_float(vb[k].x & 0xffff0000u));
            ob.z = __uint_as_float(gb[k].y << 16) * (yb.y + dsk * __uint_as_float(vb[k].y << 16)); ob.w = __uint_as_float(gb[k].y & 0xffff0000u) * (yb.w + dsk * __uint_as_float(vb[k].y & 0xffff0000u));
            *(float4*)(z0 + n) = oa; *(float4*)(z1 + n) = ob; }
        } else {
          const float* z0 = p.zbuf + ((size_t)(b0 * 256 + c)) * SEQ; const float* z1 = p.zbuf + ((size_t)(b1 * 256 + c)) * SEQ;
          float* y0 = p.yt + ((size_t)(b0 * 256 + c)) * SEQ; float* y1 = p.yt + ((size_t)(b1 * 256 + c)) * SEQ;
          float4 za[4], zb[4];
#pragma unroll
          for (int k = 0; k < 4; ++k) { const int n = 4 * (tid + NT * k); za[k] = *(const float4*)(z0 + n); zb[k] = *(const float4*)(z1 + n); }
#pragma unroll
          for (int k = 0; k < 4; ++k) { const int n = 4 * (tid + NT * k); const float4 ya = *(const float4*)&L.x[FPAD(n)], yb = *(const float4*)&L.x[FPAD(n + 2)];
            *(float4*)(y0 + n) = make_float4(ya.x + dsk * za[k].x, ya.z + dsk * za[k].y, yb.x + dsk * za[k].z, yb.z + dsk * za[k].w);
            *(float4*)(y1 + n) = make_float4(ya.y + dsk * zb[k].x, ya.w + dsk * zb[k].y, yb.y + dsk * zb[k].z, yb.w + dsk * zb[k].w); }
        }
      }
      asm volatile("s_waitcnt vmcnt(0)" ::: "memory"); __syncthreads();
    }
    __syncthreads();
  }
}
__device__ __forceinline__ void phase_hy_fin(CParams& p, int bid, int nb, int tid_, char* smem) {
  bf16_t (*tl)[264] = (bf16_t (*)[264])smem;
  for (int task = bid; task < NB * (SEQ / 64); task += nb) {
    int tid = tid_; asm volatile("" : "+v"(tid));
    const int b = task / (SEQ / 64), t0 = (task % (SEQ / 64)) * 64;
#pragma unroll 8
    for (int i = tid; i < 256 * 64; i += NT) { const int t = i & 63, c = i >> 6;
      float v = bf2f(p.prep[((size_t)(b * 768 + 512 + c)) * SEQ + t0 + t]) * p.yt[((size_t)(b * 256 + c)) * SEQ + t0 + t];
      tl[t][c] = f2bf(v); }
    __syncthreads();
    for (int i = tid; i < 64 * 32; i += NT) { const int t = i >> 5, ch = i & 31; *(uint4*)(p.y + ((size_t)b * SEQ + t0 + t) * D + 256 + ch * 8) = *(const uint4*)&tl[t][ch * 8]; }
    __syncthreads();
  }
}

__device__ __forceinline__ void phase_mb_prep(CParams& p, int layer, int bid, int nb, int tid_) {
  const int lane = tid_ & 63, wv = tid_ >> 6;
  const float* w = p.mb_conv_w + (size_t)layer * 3 * 768; const float* bs = p.mb_conv_b + layer * 768;
  for (int row0 = (bid * NW + wv) * 4; row0 < TT; row0 += nb * NW * 4) {
    float o[4][2][8];
#pragma unroll
    for (int r = 0; r < 4; ++r) { const int row = row0 + r; const int rm = seq_nb(row, -1, true), rp = seq_nb(row, 1, true);
#pragma unroll
      for (int j = 0; j < 2; ++j) { const int ck = lane + 64 * j; if (ck < 96) conv8(p.u, U_MB + 256, row, rm, rp, w, bs, ck * 8, o[r][j]); } }
#pragma unroll
    for (int r = 0; r < 4; ++r) { const int row = row0 + r;
#pragma unroll
      for (int j = 0; j < 2; ++j) { const int ck = lane + 64 * j; if (ck < 96) {
#pragma unroll
          for (int e = 0; e < 8; ++e) o[r][j][e] = siluf(o[r][j][e]);
          uint4 pk; pk.x = pack2(o[r][j][0], o[r][j][1]); pk.y = pack2(o[r][j][2], o[r][j][3]); pk.z = pack2(o[r][j][4], o[r][j][5]); pk.w = pack2(o[r][j][6], o[r][j][7]); *(uint4*)(p.prep + (size_t)row * 768 + ck * 8) = pk; } }
      if (lane < 8) p.dt[(size_t)row * 8 + lane] = softplusf_(bf2f(p.u[(size_t)row * NU + U_MB + 1024 + lane]) + p.mb_dt_bias[layer * 8 + lane]); }
  }
}
__device__ __forceinline__ int mb_row(int b, int cpos, int i) {
  if (cpos < 4) return TL + b * CTX + cpos * 64 + i;
  const int n = cpos - 4; return b * SEQ + ((n & 1) * 64 + i) * 64 + (n >> 1);
}
struct MbLds {
  bf16_t bimg[64][136]; bf16_t cimg[64][136];
  bf16_t bt[128][72];
  bf16_t xt[2][64][72];
  bf16_t pm[2][64][72];
  float ox[64][65];
  float dtv[2][64], cum[2][64], tot[2]; int rows[64];
};
template <int PASS>
__device__ __forceinline__ void phase_mb_chunk(CParams& p, int layer, int bid, int nb, int tid_, char* smem) {
  MbLds& L = *(MbLds*)smem;
  const int c_lo = (PASS == 1 && layer == DEPTH - 1) ? 4 : 0, ncp = NCH - c_lo;
  uint4 pbc[4]; float pdt = 0.f;
#pragma unroll
  for (int q = 0; q < 4; ++q) pbc[q] = make_uint4(0u, 0u, 0u, 0u);
  auto mfetch = [&](int task_, int tid) { const int h_ = task_ & 3, cpos_ = c_lo + (task_ >> 2) % ncp, b_ = (task_ >> 2) / ncp, g_ = h_ >> 1;
#pragma unroll
    for (int q = 0; q < 4; ++q) { const int i = tid + q * NT, which = i >> 10, t = (i >> 4) & 63, ch = i & 15;
      pbc[q] = *(const uint4*)(p.prep + (size_t)mb_row(b_, cpos_, t) * 768 + 256 + which * 256 + g_ * 128 + ch * 8); }
    if (tid < 128) pdt = p.dt[(size_t)mb_row(b_, cpos_, tid & 63) * 8 + (tid >> 6) * 4 + h_]; };
  if (bid < NB * ncp * 4) mfetch(bid, tid_);
  for (int task = bid; task < NB * ncp * 4; task += nb) {
    int tid = tid_; asm volatile("" : "+v"(tid));
    const int lane = tid & 63, wv = tid >> 6, fr = lane & 15, fq = lane >> 4, dirw = wv >> 2, s4 = wv & 3;
    const int h = task & 3, cpos = c_lo + (task >> 2) % ncp, b = (task >> 2) / ncp, g = h >> 1;
    bf16x8 sfo[4][4]; float xsv[4][4], zzv[4][4];
    if (PASS == 1) { const bf16_t* sb0 = p.mb_l + ((size_t)((b * 4 + h) * 2 + dirw) * NCH + scan_idx(cpos, dirw)) * 8192;
#pragma unroll
      for (int ks = 0; ks < 4; ++ks)
#pragma unroll
        for (int n = 0; n < 4; ++n) sfo[ks][n] = *(const bf16x8*)(sb0 + (n * 16 + fr) * 128 + ks * 32 + fq * 8);
      if (dirw == 0) {
#pragma unroll
        for (int n = 0; n < 4; ++n)
#pragma unroll
          for (int q = 0; q < 4; ++q) { const int row = mb_row(b, cpos, s4 * 16 + fq * 4 + q), pc = n * 16 + fr;
            xsv[n][q] = bf2f(p.prep[(size_t)row * 768 + h * 64 + pc]); zzv[n][q] = bf2f(p.u[(size_t)row * NU + U_MB + h * 64 + pc]); } } }
    if (tid < 64) L.rows[tid] = mb_row(b, cpos, tid);
    if (tid < 128) L.dtv[tid >> 6][tid & 63] = pdt;
#pragma unroll
    for (int q = 0; q < 4; ++q) { const int i = tid + q * NT, which = i >> 10, t = (i >> 4) & 63, ch = i & 15; *(uint4*)(which ? &L.cimg[t][ch * 8] : &L.bimg[t][ch * 8]) = pbc[q]; }
    if (task + nb < NB * ncp * 4) mfetch(task + nb, tid);
    __syncthreads();
    if (wv < 2) { const int dir = wv, i = dir ? 63 - lane : lane; const float a = -__expf(p.mb_a_log[layer * 8 + dir * 4 + h]);
      float v = L.dtv[dir][i] * a;
#pragma unroll
      for (int o = 1; o < 64; o <<= 1) { const float t = __shfl_up(v, o); if (lane >= o) v += t; }
      L.cum[dir][i] = v; if (lane == 63) L.tot[dir] = v; }
    __syncthreads();
    if (PASS == 0) {
      for (int i = tid; i < 128 * 16; i += NT) { int n = i & 127, f0 = (i >> 7) * 4; uint2 pk;
        pk.x = (unsigned)L.bimg[f0][n] | ((unsigned)L.bimg[f0 + 1][n] << 16); pk.y = (unsigned)L.bimg[f0 + 2][n] | ((unsigned)L.bimg[f0 + 3][n] << 16);
        *(uint2*)&L.bt[n][f0] = pk; }
#pragma unroll
      for (int i = tid; i < 2 * 64 * 16; i += NT) { int pc = i & 63, f0 = ((i >> 6) & 15) * 4, dir = i >> 10; float v[4];
#pragma unroll
        for (int q = 0; q < 4; ++q) v[q] = bf2f(p.prep[(size_t)L.rows[f0 + q] * 768 + h * 64 + pc]) * L.dtv[dir][f0 + q] * __expf(L.tot[dir] - L.cum[dir][f0 + q]);
        uint2 pk; pk.x = pack2(v[0], v[1]); pk.y = pack2(v[2], v[3]); *(uint2*)&L.xt[dir][pc][f0] = pk; }
      __syncthreads();
      const int seq = (b * 4 + h) * 2 + dirw, nsc = scan_idx(cpos, dirw);
      f32x4 acc[2][4];
#pragma unroll
      for (int m = 0; m < 2; ++m)
#pragma unroll
        for (int n = 0; n < 4; ++n) acc[m][n] = (f32x4){0.f, 0.f, 0.f, 0.f};
      wmm<2, 4, 2, 72, 72>(acc, &L.bt[s4 * 32][0], &L.xt[dirw][0][0], fr, fq);
      bf16_t* dst = p.mb_l + ((size_t)seq * NCH + nsc) * 8192;
#pragma unroll
      for (int m = 0; m < 2; ++m)
#pragma unroll
        for (int n = 0; n < 4; ++n) { uint2 pk; pk.x = pack2(acc[m][n][0], acc[m][n][1]); pk.y = pack2(acc[m][n][2], acc[m][n][3]);
          *(uint2*)(dst + (n * 16 + fr) * 128 + s4 * 32 + m * 16 + fq * 4) = pk; }
      if (tid < 2) p.mb_dec[(size_t)((b * 4 + h) * 2 + tid) * NCH + scan_idx(cpos, tid)] = __expf(L.tot[tid]);
    } else {
#pragma unroll
      for (int i = tid; i < 64 * 16; i += NT) { int pc = i & 63, f0 = (i >> 6) * 4; uint2 pk; unsigned short v[4];
#pragma unroll
        for (int q = 0; q < 4; ++q) v[q] = p.prep[(size_t)L.rows[f0 + q] * 768 + h * 64 + pc];
        pk.x = (unsigned)v[0] | ((unsigned)v[1] << 16); pk.y = (unsigned)v[2] | ((unsigned)v[3] << 16); *(uint2*)&L.xt[0][pc][f0] = pk; }
      { f32x4 acc[4][1];
#pragma unroll
        for (int m = 0; m < 4; ++m) acc[m][0] = (f32x4){0.f, 0.f, 0.f, 0.f};
        wmm<4, 1, 4, 136, 136>(acc, &L.bimg[0][0], &L.cimg[s4 * 16][0], fr, fq);
        const int i = s4 * 16 + fr; const float ci = L.cum[dirw][i];
#pragma unroll
        for (int m = 0; m < 4; ++m) { float v[4];
#pragma unroll
          for (int q = 0; q < 4; ++q) { int j = m * 16 + fq * 4 + q; bool keep = dirw == 0 ? (j <= i) : (j >= i);
            v[q] = keep ? acc[m][0][q] * __expf(ci - L.cum[dirw][j]) * L.dtv[dirw][j] : 0.f; }
          uint2 pk; pk.x = pack2(v[0], v[1]); pk.y = pack2(v[2], v[3]); *(uint2*)&L.pm[dirw][i][m * 16 + fq * 4] = pk; } }
      __syncthreads();
      f32x4 ao[1][4];
#pragma unroll
      for (int n = 0; n < 4; ++n) ao[0][n] = (f32x4){0.f, 0.f, 0.f, 0.f};
      {
#pragma unroll
        for (int ks = 0; ks < 4; ++ks) { bf16x8 a = *(const bf16x8*)&L.cimg[s4 * 16 + fr][ks * 32 + fq * 8];
#pragma unroll
          for (int n = 0; n < 4; ++n) ao[0][n] = __builtin_amdgcn_mfma_f32_16x16x32_bf16(a, sfo[ks][n], ao[0][n], 0, 0, 0); } }
#pragma unroll
      for (int q = 0; q < 4; ++q) { const float e = __expf(L.cum[dirw][s4 * 16 + fq * 4 + q]);
#pragma unroll
        for (int n = 0; n < 4; ++n) ao[0][n][q] *= e; }
      wmm<1, 4, 2, 72, 72>(ao, &L.pm[dirw][s4 * 16][0], &L.xt[0][0][0], fr, fq);
      if (dirw == 1) {
#pragma unroll
        for (int n = 0; n < 4; ++n)
#pragma unroll
          for (int q = 0; q < 4; ++q) L.ox[s4 * 16 + fq * 4 + q][n * 16 + fr] = ao[0][n][q]; }
      __syncthreads();
      if (dirw == 0) {
        const float dsk = p.mb_d[layer * 4 + h];
        float ss[4] = {0.f, 0.f, 0.f, 0.f};
#pragma unroll
        for (int n = 0; n < 4; ++n)
#pragma unroll
          for (int q = 0; q < 4; ++q) { const int i = s4 * 16 + fq * 4 + q, pc = n * 16 + fr;
            float v = (ao[0][n][q] + L.ox[i][pc] + xsv[n][q] * dsk) * siluf(zzv[n][q]); ao[0][n][q] = v; ss[q] += v * v; }
#pragma unroll
        for (int q = 0; q < 4; ++q) {
#pragma unroll
          for (int o = 1; o < 16; o <<= 1) ss[q] += __shfl_xor(ss[q], o);
          ss[q] = rsqrtf(ss[q] * (1.f / 64.f) + 1e-6f); }
#pragma unroll
        for (int n = 0; n < 4; ++n) { const int c = h * 64 + n * 16 + fr; const float nw = p.mb_norm[layer * 256 + c];
#pragma unroll
          for (int q = 0; q < 4; ++q) p.y[(size_t)L.rows[s4 * 16 + fq * 4 + q] * D + 512 + c] = f2bf(ao[0][n][q] * ss[q] * nw); }
      }
    }
    __syncthreads();
  }
}
__device__ __forceinline__ void phase_mb_state(CParams& p, int bid, int nb, int tid_) {
  for (int i = bid * NT + tid_; i < 32 * 4096; i += nb * NT) {
    const int seq = i >> 12, e2 = (i & 4095) * 2;
    unsigned* lp = (unsigned*)(p.mb_l + (size_t)seq * NCH * 8192 + e2);
    const float* dp = p.mb_dec + (size_t)seq * NCH;
    float s0 = 0.f, s1 = 0.f;
    for (int n = 0; n < NCH; n += 12) {
      unsigned lv[12]; float dc[12];
#pragma unroll
      for (int q = 0; q < 12; ++q) { lv[q] = lp[(size_t)(n + q) * 4096]; dc[q] = dp[n + q]; }
#pragma unroll
      for (int q = 0; q < 12; ++q) { lp[(size_t)(n + q) * 4096] = pack2(s0, s1); s0 = s0 * dc[q] + bf2f((bf16_t)(lv[q] & 0xffff)); s1 = s1 * dc[q] + bf2f((bf16_t)(lv[q] >> 16)); }
    }
  }
}

__device__ __forceinline__ void phase_dn_prep(CParams& p, int layer, int bid, int nb, int tid_) {
  const int lane = tid_ & 63, wv = tid_ >> 6;
  const float* w = p.dn_conv_w + (size_t)layer * 3 * 768;
  for (int row0 = (bid * NW + wv) * 4; row0 < TT; row0 += nb * NW * 4) {
   float oo[4][2][8];
#pragma unroll
   for (int r = 0; r < 4; ++r) { const int row = row0 + r; const int rm = seq_nb(row, -1, false), rp = seq_nb(row, 1, false);
#pragma unroll
     for (int j = 0; j < 2; ++j) { const int ck = lane + 64 * j; if (ck < 96) conv8(p.u, U_DN, row, rm, rp, w, nullptr, ck * 8, oo[r][j]); } }
#pragma unroll
   for (int r = 0; r < 4; ++r) { const int row = row0 + r;
#pragma unroll
    for (int j = 0; j < 2; ++j) { const int ck = lane + 64 * j;
      if (ck < 96) { float (&o)[8] = oo[r][j];
        float ss = 0.f;
#pragma unroll
        for (int e = 0; e < 8; ++e) { o[e] = siluf(o[e]); ss += o[e] * o[e]; }
        if (j == 0) { ss += __shfl_xor(ss, 1); ss += __shfl_xor(ss, 2); ss += __shfl_xor(ss, 4); const float r = rsqrtf(ss + 1e-6f) * (ck < 32 ? 0.125f : 1.f);
#pragma unroll
          for (int e = 0; e < 8; ++e) o[e] *= r; }
        uint4 pk; pk.x = pack2(o[0], o[1]); pk.y = pack2(o[2], o[3]); pk.z = pack2(o[4], o[5]); pk.w = pack2(o[6], o[7]); *(uint4*)(p.prep + (size_t)row * 768 + ck * 8) = pk; } }
    if (lane < 8) {
      float beta = sigmoidf_(bf2f(p.u[(size_t)row * NU + U_DN + 1024 + lane]));
      float g = -__expf(p.dn_a_log[layer * 8 + lane]) * softplusf_(bf2f(p.u[(size_t)row * NU + U_DN + 1032 + lane]) + p.dn_dt_bias[layer * 8 + lane]);
      p.bg[(size_t)row * 16 + lane * 2] = beta; p.bg[(size_t)row * 16 + lane * 2 + 1] = g;
    }
   }
  }
}
struct DnLds {
  bf16_t q[64][72], k[64][72], v[64][72];
  float md[2][4][16][17];
  bf16_t msb[2][64][72];
  bf16_t td[2][4][16][40];
  bf16_t tmp[8][32][40];
  bf16_t a1[2][64][72];
  bf16_t wq[2][64][72];
  bf16_t ut[2][64][72];
  float ox[64][65];
  float beta[2][64], gl[2][64], cum[2][64], tot[2];
};
template <int PASS>
__device__ __forceinline__ void phase_dn_chunk(CParams& p, int layer, int bid, int nb, int tid_, char* smem) {
  DnLds& L = *(DnLds*)smem;
  const int c_lo = (PASS == 1 && layer == DEPTH - 1) ? 4 : 0, ncp = NCH - c_lo;
  uint4 pq = make_uint4(0u, 0u, 0u, 0u), pk_ = pq, pv = pq; float2 pbg = make_float2(0.f, 0.f);
  auto fetch = [&](int task_, int tid) { const int h_ = task_ & 3, cpos_ = c_lo + (task_ >> 2) % ncp, b_ = (task_ >> 2) / ncp; const int r0_ = chunk_row0(b_, cpos_);
    if (tid < 128) pbg = *(const float2*)(p.bg + (size_t)(r0_ + (tid & 63)) * 16 + ((tid >> 6) * 4 + h_) * 2);
    const bf16_t* src = p.prep + (size_t)(r0_ + (tid >> 3)) * 768 + h_ * 64 + (tid & 7) * 8;
    if (PASS == 1) pq = *(const uint4*)src;
    pk_ = *(const uint4*)(src + 256); pv = *(const uint4*)(src + 512); };
  if (bid < NB * ncp * 4) fetch(bid, tid_);
  for (int task = bid; task < NB * ncp * 4; task += nb) {
    int tid = tid_; asm volatile("" : "+v"(tid));
    const int lane = tid & 63, wv = tid >> 6, fr = lane & 15, fq = lane >> 4, dirw = wv >> 2, s4 = wv & 3;
    const int h = task & 3, cpos = c_lo + (task >> 2) % ncp, b = (task >> 2) / ncp;
    const int row0 = chunk_row0(b, cpos);
    bf16x8 sfr[2], sfo[2][4]; float ogv[4][4];
    if (PASS == 1) { const bf16_t* sb0 = p.dn_l + ((size_t)((b * 4 + h) * 2 + dirw) * NCH + scan_idx(cpos, dirw)) * 4096;
#pragma unroll
      for (int ks = 0; ks < 2; ++ks) { sfr[ks] = *(const bf16x8*)(sb0 + (s4 * 16 + fr) * 64 + ks * 32 + fq * 8);
#pragma unroll
        for (int n = 0; n < 4; ++n) sfo[ks][n] = *(const bf16x8*)(sb0 + (n * 16 + fr) * 64 + ks * 32 + fq * 8); }
#pragma unroll
      for (int n = 0; n < 4; ++n)
#pragma unroll
        for (int qq = 0; qq < 4; ++qq) ogv[n][qq] = bf2f(p.u[(size_t)(row0 + s4 * 16 + fq * 4 + qq) * NU + U_DN + 768 + h * 64 + n * 16 + fr]); }
    if (tid < 128) { L.beta[tid >> 6][tid & 63] = pbg.x; L.gl[tid >> 6][tid & 63] = pbg.y; }
    { const int t = tid >> 3, ch = tid & 7;
      if (PASS == 1) *(uint4*)&L.q[t][ch * 8] = pq;
      *(uint4*)&L.k[t][ch * 8] = pk_; *(uint4*)&L.v[t][ch * 8] = pv; }
    if (task + nb < NB * ncp * 4) fetch(task + nb, tid);
    for (int i = tid; i < (int)(sizeof(L.td) / 16); i += NT) ((uint4*)&L.td[0][0][0][0])[i] = make_uint4(0u, 0u, 0u, 0u);
    for (int i = tid; i < (int)(sizeof(L.tmp) / 16); i += NT) ((uint4*)&L.tmp[0][0][0])[i] = make_uint4(0u, 0u, 0u, 0u);
    for (int i = tid; i < (int)(sizeof(L.ut) / 16); i += NT) { ((uint4*)&L.ut[0][0][0])[i] = make_uint4(0u, 0u, 0u, 0u); ((uint4*)&L.wq[0][0][0])[i] = make_uint4(0u, 0u, 0u, 0u); }
    __syncthreads();
    if (wv < 2) { const int dir = wv, f = dir ? 63 - lane : lane;
      float v = L.gl[dir][f];
#pragma unroll
      for (int o = 1; o < 64; o <<= 1) { const float t = __shfl_up(v, o); if (lane >= o) v += t; }
      L.cum[dir][f] = v; if (lane == 63) L.tot[dir] = v; }
    __syncthreads();
    { f32x4 acc[4][1];
#pragma unroll
      for (int m = 0; m < 4; ++m) acc[m][0] = (f32x4){0.f, 0.f, 0.f, 0.f};
      wmm<4, 1, 2, 72, 72>(acc, &L.k[0][0], &L.k[s4 * 16][0], fr, fq);
      const int j = s4 * 16 + fr; const float cj = L.cum[dirw][j]; const int sj = dirw ? 63 - j : j;
#pragma unroll
      for (int m = 0; m < 4; ++m)
#pragma unroll
        for (int qq = 0; qq < 4; ++qq) { const int i = m * 16 + fq * 4 + qq, si = dirw ? 63 - i : i; const bool keep = sj < si;
          const float v = keep ? L.beta[dirw][i] * acc[m][0][qq] * __expf(L.cum[dirw][i] - cj) : 0.f;
          L.msb[dirw][si][sj] = f2bf(v);
          if ((si >> 4) == (sj >> 4)) L.md[dirw][si >> 4][sj & 15][si & 15] = v; } }
    __syncthreads();
    if (wv < 2) { const int dir = wv, d = lane >> 4, c = lane & 15;
      float x[16];
#pragma unroll
      for (int s = 0; s < 16; ++s) x[s] = s == c ? 1.f : 0.f;
#pragma unroll
      for (int t = 0; t < 15; ++t) { const float xt = x[t];
#pragma unroll
        for (int s = t + 1; s < 16; ++s) x[s] -= L.md[dir][d][t][s] * xt; }
#pragma unroll
      for (int s = 0; s < 16; ++s) L.td[dir][d][s][c] = f2bf(x[s]); }
    __syncthreads();
    { bf16_t* xb = s4 < 2 ? &L.ut[dirw][s4 * 32][0] : &L.wq[dirw][(s4 - 2) * 32][0];
      const bf16_t (*src)[72] = s4 < 2 ? L.v : L.k; const int cb = (s4 & 1) * 32;
#pragma unroll
      for (int I = 0; I < 4; ++I) {
        f32x4 acc[1][2];
#pragma unroll
        for (int nt = 0; nt < 2; ++nt)
#pragma unroll
          for (int qq = 0; qq < 4; ++qq) { const int s = I * 16 + fq * 4 + qq, f = dirw ? 63 - s : s; const float sc = s4 < 2 ? L.beta[dirw][f] : L.beta[dirw][f] * __expf(L.cum[dirw][f]);
            acc[0][nt][qq] = sc * bf2f(src[f][cb + nt * 16 + fr]); }
        if (I > 0) { f32x4 pr[1][2] = {{{0.f, 0.f, 0.f, 0.f}, {0.f, 0.f, 0.f, 0.f}}};
          wmm<1, 2, 2, 72, 72>(pr, &L.msb[dirw][I * 16][0], xb, fr, fq);
#pragma unroll
          for (int nt = 0; nt < 2; ++nt) acc[0][nt] -= pr[0][nt]; }
#pragma unroll
        for (int nt = 0; nt < 2; ++nt) { uint2 pk; pk.x = pack2(acc[0][nt][0], acc[0][nt][1]); pk.y = pack2(acc[0][nt][2], acc[0][nt][3]); *(uint2*)&L.tmp[wv][nt * 16 + fr][fq * 4] = pk; }
        asm volatile("" ::: "memory");
        f32x4 xs[1][2] = {{{0.f, 0.f, 0.f, 0.f}, {0.f, 0.f, 0.f, 0.f}}};
        wmm<1, 2, 1, 40, 40>(xs, &L.td[dirw][I][0][0], &L.tmp[wv][0][0], fr, fq);
#pragma unroll
        for (int nt = 0; nt < 2; ++nt) { uint2 pk; pk.x = pack2(xs[0][nt][0], xs[0][nt][1]); pk.y = pack2(xs[0][nt][2], xs[0][nt][3]); *(uint2*)(xb + (nt * 16 + fr) * 72 + I * 16 + fq * 4) = pk; }
        asm volatile("" ::: "memory");
      } }
    if (PASS == 0) {
      for (int i = tid; i < 2 * 64 * 16; i += NT) { int d = i & 63, f0 = ((i >> 6) & 15) * 4, dir = i >> 10; float v[4];
#pragma unroll
        for (int qq = 0; qq < 4; ++qq) v[qq] = bf2f(L.k[f0 + qq][d]) * __expf(L.tot[dir] - L.cum[dir][f0 + qq]);
        uint2 pk;
        if (dir == 0) { pk.x = pack2(v[0], v[1]); pk.y = pack2(v[2], v[3]); *(uint2*)&L.a1[0][d][f0] = pk; }
        else { pk.x = pack2(v[3], v[2]); pk.y = pack2(v[1], v[0]); *(uint2*)&L.a1[1][d][60 - f0] = pk; } }
      __syncthreads();
      const int seq = (b * 4 + h) * 2 + dirw, nsc = scan_idx(cpos, dirw); const float dec = __expf(L.tot[dirw]);
      { f32x4 acc[4][1];
#pragma unroll
        for (int m = 0; m < 4; ++m) acc[m][0] = (f32x4){0.f, 0.f, 0.f, 0.f};
        wmm<4, 1, 2, 72, 72>(acc, &L.wq[dirw][0][0], &L.a1[dirw][s4 * 16][0], fr, fq);
        const int d = s4 * 16 + fr; bf16_t* dst = p.dn_m + ((size_t)seq * NCH + nsc) * 4096 + d * 64;
#pragma unroll
        for (int m = 0; m < 4; ++m) { float v[4];
#pragma unroll
          for (int qq = 0; qq < 4; ++qq) { int d2 = m * 16 + fq * 4 + qq; v[qq] = (d2 == d ? dec : 0.f) - acc[m][0][qq]; }
          uint2 pk; pk.x = pack2(v[0], v[1]); pk.y = pack2(v[2], v[3]); *(uint2*)(dst + m * 16 + fq * 4) = pk; } }
      { f32x4 acc[4][1];
#pragma unroll
        for (int m = 0; m < 4; ++m) acc[m][0] = (f32x4){0.f, 0.f, 0.f, 0.f};
        wmm<4, 1, 2, 72, 72>(acc, &L.a1[dirw][0][0], &L.ut[dirw][s4 * 16][0], fr, fq);
        bf16_t* dst = p.dn_l + ((size_t)seq * NCH + nsc) * 4096 + (s4 * 16 + fr) * 64;
#pragma unroll
        for (int m = 0; m < 4; ++m) { uint2 pk; pk.x = pack2(acc[m][0][0], acc[m][0][1]); pk.y = pack2(acc[m][0][2], acc[m][0][3]); *(uint2*)(dst + m * 16 + fq * 4) = pk; } }
    } else {
      __syncthreads();
      for (int i = tid; i < 2 * 64 * 16; i += NT) { int d = i & 63, s0 = ((i >> 6) & 15) * 4, dir = i >> 10; const uint2 wv2 = *(const uint2*)&L.wq[dir][d][s0];
        L.a1[dir][s0][d] = (bf16_t)(wv2.x & 0xffff); L.a1[dir][s0 + 1][d] = (bf16_t)(wv2.x >> 16); L.a1[dir][s0 + 2][d] = (bf16_t)(wv2.y & 0xffff); L.a1[dir][s0 + 3][d] = (bf16_t)(wv2.y >> 16); }
      __syncthreads();
      { f32x4 acc[4][1];
#pragma unroll
        for (int m = 0; m < 4; ++m) acc[m][0] = (f32x4){0.f, 0.f, 0.f, 0.f};
#pragma unroll
        for (int ks = 0; ks < 2; ++ks)
#pragma unroll
          for (int m = 0; m < 4; ++m) { bf16x8 a = *(const bf16x8*)&L.a1[dirw][m * 16 + fr][ks * 32 + fq * 8]; acc[m][0] = __builtin_amdgcn_mfma_f32_16x16x32_bf16(a, sfr[ks], acc[m][0], 0, 0, 0); }
        const int c = s4 * 16 + fr;
#pragma unroll
        for (int m = 0; m < 4; ++m) { uint2 uu = *(const uint2*)&L.ut[dirw][c][m * 16 + fq * 4];
          float v0 = bf2f((bf16_t)(uu.x & 0xffff)) - acc[m][0][0], v1 = bf2f((bf16_t)(uu.x >> 16)) - acc[m][0][1], v2 = bf2f((bf16_t)(uu.y & 0xffff)) - acc[m][0][2], v3 = bf2f((bf16_t)(uu.y >> 16)) - acc[m][0][3];
          uint2 pk; pk.x = pack2(v0, v1); pk.y = pack2(v2, v3); *(uint2*)&L.ut[dirw][c][m * 16 + fq * 4] = pk; } }
      { f32x4 acc[4][1];
#pragma unroll
        for (int m = 0; m < 4; ++m) acc[m][0] = (f32x4){0.f, 0.f, 0.f, 0.f};
        wmm<4, 1, 2, 72, 72>(acc, &L.k[0][0], &L.q[s4 * 16][0], fr, fq);
        const int i = s4 * 16 + fr; const float ci = L.cum[dirw][i];
#pragma unroll
        for (int m = 0; m < 4; ++m) { float v[4];
#pragma unroll
          for (int qq = 0; qq < 4; ++qq) { int j = m * 16 + fq * 4 + qq; bool keep = dirw == 0 ? (j <= i) : (j >= i); v[qq] = keep ? acc[m][0][qq] * __expf(ci - L.cum[dirw][j]) : 0.f; }
          uint2 pk;
          if (dirw == 0) { pk.x = pack2(v[0], v[1]); pk.y = pack2(v[2], v[3]); *(uint2*)&L.wq[0][i][m * 16 + fq * 4] = pk; }
          else { pk.x = pack2(v[3], v[2]); pk.y = pack2(v[1], v[0]); *(uint2*)&L.wq[1][i][60 - m * 16 - fq * 4] = pk; } } }
      __syncthreads();
      f32x4 ao[1][4];
#pragma unroll
      for (int n = 0; n < 4; ++n) ao[0][n] = (f32x4){0.f, 0.f, 0.f, 0.f};
#pragma unroll
      for (int ks = 0; ks < 2; ++ks) { bf16x8 a = *(const bf16x8*)&L.q[s4 * 16 + fr][ks * 32 + fq * 8];
#pragma unroll
        for (int n = 0; n < 4; ++n) ao[0][n] = __builtin_amdgcn_mfma_f32_16x16x32_bf16(a, sfo[ks][n], ao[0][n], 0, 0, 0); }
#pragma unroll
      for (int qq = 0; qq < 4; ++qq) { const float e = __expf(L.cum[dirw][s4 * 16 + fq * 4 + qq]);
#pragma unroll
        for (int n = 0; n < 4; ++n) ao[0][n][qq] *= e; }
      wmm<1, 4, 2, 72, 72>(ao, &L.wq[dirw][s4 * 16][0], &L.ut[dirw][0][0], fr, fq);
      if (dirw == 1) {
#pragma unroll
        for (int n = 0; n < 4; ++n)
#pragma unroll
          for (int qq = 0; qq < 4; ++qq) L.ox[s4 * 16 + fq * 4 + qq][n * 16 + fr] = ao[0][n][qq]; }
      __syncthreads();
      if (dirw == 0) {
        float ss[4] = {0.f, 0.f, 0.f, 0.f};
#pragma unroll
        for (int n = 0; n < 4; ++n)
#pragma unroll
          for (int qq = 0; qq < 4; ++qq) { ao[0][n][qq] += L.ox[s4 * 16 + fq * 4 + qq][n * 16 + fr]; ss[qq] += ao[0][n][qq] * ao[0][n][qq]; }
#pragma unroll
        for (int qq = 0; qq < 4; ++qq) {
#pragma unroll
          for (int o = 1; o < 16; o <<= 1) ss[qq] += __shfl_xor(ss[qq], o);
          ss[qq] = rsqrtf(ss[qq] * (1.f / 64.f) + 1e-6f); }
#pragma unroll
        for (int n = 0; n < 4; ++n) { const int c = h * 64 + n * 16 + fr; const float nw = p.dn_norm[layer * 256 + c];
#pragma unroll
          for (int qq = 0; qq < 4; ++qq) { const int f = s4 * 16 + fq * 4 + qq;
            p.y[(size_t)(row0 + f) * D + 768 + c] = f2bf(ao[0][n][qq] * ss[qq] * nw * siluf(ogv[n][qq])); } }
      }
    }
    __syncthreads();
  }
}
struct DnBLds { bf16_t sh[2][64][72]; bf16_t sl[2][64][72]; };
__device__ __forceinline__ void phase_dn_state(CParams& p, int bid, int nb, int tid_, char* smem) {
  DnBLds& L = *(DnBLds*)smem;
  const int tid = tid_, lane = tid & 63, wv = tid >> 6, fr = lane & 15, fq = lane >> 4, mt = wv >> 1, ntb = (wv & 1) * 2;
  for (int seq = bid; seq < 32; seq += nb) {
    for (int i = tid; i < 64 * 72 / 2; i += NT) { ((unsigned*)&L.sh[0][0][0])[i] = 0u; ((unsigned*)&L.sl[0][0][0])[i] = 0u; }
    __syncthreads();
    f32x4 S[2] = {{0.f, 0.f, 0.f, 0.f}, {0.f, 0.f, 0.f, 0.f}};
    const bf16_t* mb = p.dn_m + (size_t)seq * NCH * 4096 + (mt * 16 + fr) * 64 + fq * 8;
    bf16x8 a[2]; a[0] = *(const bf16x8*)mb; a[1] = *(const bf16x8*)(mb + 32);
    uint2* lbase[2]; uint2 lvn[2];
#pragma unroll
    for (int t = 0; t < 2; ++t) { lbase[t] = (uint2*)(p.dn_l + (size_t)seq * NCH * 4096 + ((ntb + t) * 16 + fr) * 64 + mt * 16 + fq * 4); lvn[t] = *lbase[t]; }
    for (int n = 0; n < NCH; ++n) {
      const int cur = n & 1;
      f32x4 acc[2];
#pragma unroll
      for (int t = 0; t < 2; ++t) { uint2* lp = lbase[t] + (size_t)n * 1024;
        const uint2 lv = lvn[t]; uint2 sv; sv.x = pack2(S[t][0], S[t][1]); sv.y = pack2(S[t][2], S[t][3]); *lp = sv;
        acc[t] = (f32x4){bf2f((bf16_t)(lv.x & 0xffff)), bf2f((bf16_t)(lv.x >> 16)), bf2f((bf16_t)(lv.y & 0xffff)), bf2f((bf16_t)(lv.y >> 16))}; }
      bf16x8 an[2] = {a[0], a[1]};
      if (n + 1 < NCH) { an[0] = *(const bf16x8*)(mb + (size_t)(n + 1) * 4096); an[1] = *(const bf16x8*)(mb + (size_t)(n + 1) * 4096 + 32);
#pragma unroll
        for (int t = 0; t < 2; ++t) lvn[t] = *(lbase[t] + (size_t)(n + 1) * 1024); }
#pragma unroll
      for (int ks = 0; ks < 2; ++ks)
#pragma unroll
        for (int t = 0; t < 2; ++t) { bf16x8 bh = *(const bf16x8*)&L.sh[cur][(ntb + t) * 16 + fr][ks * 32 + fq * 8], bl = *(const bf16x8*)&L.sl[cur][(ntb + t) * 16 + fr][ks * 32 + fq * 8];
          acc[t] = __builtin_amdgcn_mfma_f32_16x16x32_bf16(a[ks], bh, acc[t], 0, 0, 0); acc[t] = __builtin_amdgcn_mfma_f32_16x16x32_bf16(a[ks], bl, acc[t], 0, 0, 0); }
#pragma unroll
      for (int t = 0; t < 2; ++t) { S[t] = acc[t]; float hi[4], lo[4];
#pragma unroll
        for (int q = 0; q < 4; ++q) { hi[q] = bf2f(f2bf(acc[t][q])); lo[q] = acc[t][q] - hi[q]; }
        uint2 ph, pl; ph.x = pack2(hi[0], hi[1]); ph.y = pack2(hi[2], hi[3]); pl.x = pack2(lo[0], lo[1]); pl.y = pack2(lo[2], lo[3]);
        *(uint2*)&L.sh[cur ^ 1][(ntb + t) * 16 + fr][mt * 16 + fq * 4] = ph; *(uint2*)&L.sl[cur ^ 1][(ntb + t) * 16 + fr][mt * 16 + fq * 4] = pl; }
      a[0] = an[0]; a[1] = an[1];
      asm volatile("s_waitcnt lgkmcnt(0)" ::: "memory"); __builtin_amdgcn_s_barrier();
    }
    __syncthreads();
  }
}

__device__ __forceinline__ void row_router(CParams& p, const float4* rts, const float (&hv)[16], int lane, int row) {
  float lg[16];
#pragma unroll
  for (int e = 0; e < 16; ++e) lg[e] = 0.f;
#pragma unroll
  for (int i = 0; i < 4; ++i)
#pragma unroll
    for (int j = 0; j < 4; ++j) { float hvv = hv[i * 4 + j];
#pragma unroll
      for (int q = 0; q < 4; ++q) { float4 r4 = rts[((i * 4 + j) * 4 + q) * 64 + lane]; lg[q * 4] += hvv * r4.x; lg[q * 4 + 1] += hvv * r4.y; lg[q * 4 + 2] += hvv * r4.z; lg[q * 4 + 3] += hvv * r4.w; }
      if (j & 1) asm volatile("" ::: "memory"); }
  float mx = -1e30f;
#pragma unroll
  for (int e = 0; e < 16; ++e) { lg[e] = wave_sum(lg[e]); mx = fmaxf(mx, lg[e]); }
  float den = 0.f;
#pragma unroll
  for (int e = 0; e < 16; ++e) { lg[e] = __expf(lg[e] - mx); den += lg[e]; }
  float inv = 1.f / den;
  if (lane < 16) { float v = 0.f;
#pragma unroll
    for (int e = 0; e < 16; ++e) v = lane == e ? lg[e] * inv : v;
    p.aff[(size_t)row * 16 + lane] = v; }
}
__device__ __forceinline__ void phase_postmix(CParams& p, int layer, int bid, int nb, int tid_, char* smem) {
  const int lane = tid_ & 63, wv = tid_ >> 6;
  float4* rts = (float4*)smem;
  for (int x = tid_; x < D * 4; x += NT) { const int ln = x & 63, q = (x >> 6) & 3, ij = x >> 8, k = (ij >> 2) * 256 + ln * 4 + (ij & 3); rts[x] = *(const float4*)(p.moe_router + ((size_t)layer * D + k) * 16 + q * 4); }
  __syncthreads();
  const int nrows = layer == 0 ? TT : TL, stride = nb * NW;
  const float* ng1 = p.norm_g + (size_t)layer * 4 * D + 1 * D;
  for (int row0 = bid * NW + wv; row0 < nrows; row0 += 2 * stride) {
    int rows[2] = {row0, row0 + stride}; const bool val1 = rows[1] < nrows; if (!val1) rows[1] = row0;
    uint2 yr[2][4]; float4 xr[2][4];
#pragma unroll
    for (int r = 0; r < 2; ++r) { const int row = rows[r];
      const float* xsrc = layer == 0 ? (row < TL ? p.x + (size_t)row * D : p.ctx + (size_t)(row - TL) * D) : xrow_ptr(p, row);
#pragma unroll
      for (int i = 0; i < 4; ++i) { yr[r][i] = *(const uint2*)(p.yo + (size_t)row * D + i * 256 + lane * 4); xr[r][i] = *(const float4*)(xsrc + i * 256 + lane * 4); } }
#pragma unroll
    for (int r = 0; r < 2; ++r) { if (r == 1 && !val1) break;
      const int row = rows[r]; float* xs = xrow_ptr(p, row);
      const float* m = p.mod + (size_t)(layer * 5 + mod_idx(row)) * 6 * D;
      float yv[16], xv[16], hv[16]; float ss = 0.f;
#pragma unroll
      for (int i = 0; i < 4; ++i) { const uint2 v = yr[r][i]; yv[i * 4] = __uint_as_float(v.x << 16); yv[i * 4 + 1] = __uint_as_float(v.x & 0xffff0000u); yv[i * 4 + 2] = __uint_as_float(v.y << 16); yv[i * 4 + 3] = __uint_as_float(v.y & 0xffff0000u); }
#pragma unroll
      for (int i = 0; i < 16; ++i) ss += yv[i] * yv[i];
      ss = wave_sum(ss);
      const float rstd = rsqrtf(ss * (1.f / D) + 1e-6f);
#pragma unroll
      for (int i = 0; i < 4; ++i) { const int k = i * 256 + lane * 4; const float4 xo = xr[r][i]; const float4 gg = *(const float4*)(ng1 + k); const float4 g1 = *(const float4*)(m + 2 * D + k);
        xv[i * 4] = xo.x + g1.x * yv[i * 4] * rstd * gg.x; xv[i * 4 + 1] = xo.y + g1.y * yv[i * 4 + 1] * rstd * gg.y; xv[i * 4 + 2] = xo.z + g1.z * yv[i * 4 + 2] * rstd * gg.z; xv[i * 4 + 3] = xo.w + g1.w * yv[i * 4 + 3] * rstd * gg.w;
        *(float4*)(xs + k) = make_float4(xv[i * 4], xv[i * 4 + 1], xv[i * 4 + 2], xv[i * 4 + 3]); }
      row_modulate_store(xv, p.norm_g + (size_t)layer * 4 * D + 2 * D, m + 3 * D, m + 4 * D, p.hb + (size_t)row * D, lane, hv);
      row_router(p, rts, hv, lane, row);
    }
  }
}
struct TkLds { unsigned key[SEQ]; unsigned hist[NW][256]; unsigned part[NT]; unsigned sh[4]; };
__device__ __forceinline__ void phase_topk(CParams& p, int layer, int bid, int nb, int tid_, char* smem) {
  TkLds& L = *(TkLds*)smem;
  if (layer == 0) for (int i = bid * NT + tid_; i < NE * 128; i += nb * NT) { const int sl = (i >> 7) * SLOTS_E + NB * CAP_L + NB * CAP_C + (i & 127); p.slot_tok[sl] = 0; p.slot_w[sl] = 0.f; }
  const int nlat = NB * NE, nctx = layer == 0 ? NB * NE : 0;
  for (int task = bid; task < nlat + nctx; task += nb) {
    int tid = tid_; asm volatile("" : "+v"(tid));
    int b, e, n, cap, rbase, sbase;
    if (task < nlat) { b = task / NE; e = task % NE; n = SEQ; cap = CAP_L; rbase = b * SEQ; sbase = e * SLOTS_E + b * CAP_L; }
    else { int j = task - nlat; b = j / NE; e = j % NE; n = CTX; cap = CAP_C; rbase = TL + b * CTX; sbase = e * SLOTS_E + NB * CAP_L + b * CAP_C; }
    __syncthreads();
#pragma unroll 16
    for (int s2 = tid; s2 < n; s2 += NT) L.key[s2] = __float_as_uint(p.aff[(size_t)(rbase + s2) * 16 + e]);
    unsigned prefix = 0u, remaining = (unsigned)cap;
#pragma unroll 1
    for (int pass = 0; pass < 4; ++pass) {
      const int shift = 24 - 8 * pass;
      for (int i = tid; i < NW * 256; i += NT) (&L.hist[0][0])[i] = 0u;
      __syncthreads();
      for (int s2 = tid; s2 < n; s2 += NT) { const unsigned k = L.key[s2]; if (pass == 0 || (k >> (shift + 8)) == (prefix >> (shift + 8))) atomicAdd(&L.hist[tid >> 6][(k >> shift) & 255u], 1u); }
      __syncthreads();
      if (tid < 256) { unsigned t = 0u;
#pragma unroll
        for (int w = 0; w < NW; ++w) t += L.hist[w][tid];
        L.hist[0][tid] = t; }
      __syncthreads();
      if (tid < 64) {
        unsigned c4[4]; unsigned loc = 0u;
#pragma unroll
        for (int e = 0; e < 4; ++e) { c4[e] = L.hist[0][255 - 4 * tid - e]; loc += c4[e]; }
        unsigned inc = loc;
#pragma unroll
        for (int o = 1; o < 64; o <<= 1) { const unsigned t = __shfl_up(inc, o); if (tid >= o) inc += t; }
        unsigned cum = inc - loc;
        const bool hit = inc >= remaining;
        const unsigned long long mk = __ballot(hit);
        const int first = mk ? __builtin_ctzll(mk) : 63;
        if (tid == first) { int e = 0;
#pragma unroll
          for (; e < 3; ++e) { if (cum + c4[e] >= remaining) break; cum += c4[e]; }
          const int d = 255 - 4 * tid - e; L.sh[0] = prefix | ((unsigned)d << shift); L.sh[1] = remaining - cum; } }
      __syncthreads();
      prefix = L.sh[0]; remaining = L.sh[1];
    }
    const int per = n / NT > 0 ? n / NT : 1, t0 = tid * per;
    unsigned cg = 0u, ce = 0u;
    if (t0 < n) for (int q = 0; q < per; ++q) { const unsigned k = L.key[t0 + q]; cg += k > prefix ? 1u : 0u; ce += k == prefix ? 1u : 0u; }
    L.part[tid] = cg | (ce << 16);
    __syncthreads();
    unsigned og = 0u, oe = 0u;
    for (int j = 0; j < NT; ++j) { const unsigned v = L.part[j]; if (j < tid) { og += v & 0xffffu; oe += v >> 16; } }
    if (t0 < n) for (int q = 0; q < per; ++q) {
      const unsigned k = L.key[t0 + q]; const int row = rbase + t0 + q;
      const bool sel = k > prefix || (k == prefix && oe < remaining);
      if (sel) { const int slot = sbase + (int)(og + (oe < remaining ? oe : remaining)); p.slot_tok[slot] = row; p.slot_w[slot] = __uint_as_float(k); p.tok_slot[(size_t)row * 16 + e] = slot; }
      else p.tok_slot[(size_t)row * 16 + e] = -1;
      og += k > prefix ? 1u : 0u; oe += k == prefix ? 1u : 0u;
    }
    __syncthreads();
  }
}
__device__ __forceinline__ void phase_combine(CParams& p, int layer, int bid, int nb, int tid_) {
  const int lane = tid_ & 63, wv = tid_ >> 6;
  const int nrows = layer == 0 ? TT : TL, stride = nb * NW;
  const float* ng3 = p.norm_g + (size_t)layer * 4 * D + 3 * D;
  for (int row0 = bid * NW + wv; row0 < nrows; row0 += 2 * stride) {
    int rows[2] = {row0, row0 + stride}; const bool val1 = rows[1] < nrows; if (!val1) rows[1] = row0;
    int sk[2][4]; unsigned long long rest[2]; int slotv[2];
#pragma unroll
    for (int r = 0; r < 2; ++r) { slotv[r] = lane < 16 ? p.tok_slot[(size_t)rows[r] * 16 + lane] : -1; }
#pragma unroll
    for (int r = 0; r < 2; ++r) { unsigned long long mk = __ballot(slotv[r] >= 0);
#pragma unroll
      for (int k = 0; k < 4; ++k) { if (mk) { const int bit = __builtin_ctzll(mk); sk[r][k] = __builtin_amdgcn_readlane(slotv[r], bit); mk &= mk - 1; } else sk[r][k] = -1; }
      rest[r] = mk; }
    uint2 pk[2][4][4]; float4 xr[2][4];
#pragma unroll
    for (int r = 0; r < 2; ++r) { const float* xs = xrow_ptr(p, rows[r]);
#pragma unroll
      for (int i = 0; i < 4; ++i) xr[r][i] = *(const float4*)(xs + i * 256 + lane * 4);
#pragma unroll
      for (int k = 0; k < 4; ++k) { const int sl = sk[r][k] >= 0 ? sk[r][k] : 0;
#pragma unroll
        for (int i = 0; i < 4; ++i) pk[r][k][i] = *(const uint2*)(p.ymoe + (size_t)sl * D + i * 256 + lane * 4); } }
#pragma unroll
    for (int r = 0; r < 2; ++r) { if (r == 1 && !val1) break;
      const int row = rows[r]; float* xs = xrow_ptr(p, row);
      float mv[16];
#pragma unroll
      for (int i = 0; i < 16; ++i) mv[i] = 0.f;
#pragma unroll
      for (int k = 0; k < 4; ++k) { const float wk = sk[r][k] >= 0 ? 1.f : 0.f;
#pragma unroll
        for (int i = 0; i < 4; ++i) { const uint2 q = pk[r][k][i];
          mv[i * 4] += wk * __uint_as_float(q.x << 16); mv[i * 4 + 1] += wk * __uint_as_float(q.x & 0xffff0000u); mv[i * 4 + 2] += wk * __uint_as_float(q.y << 16); mv[i * 4 + 3] += wk * __uint_as_float(q.y & 0xffff0000u); } }
      for (unsigned long long mk = rest[r]; mk; mk &= mk - 1) { const int slot = __builtin_amdgcn_readlane(slotv[r], __builtin_ctzll(mk));
#pragma unroll
        for (int i = 0; i < 4; ++i) { const uint2 q = *(const uint2*)(p.ymoe + (size_t)slot * D + i * 256 + lane * 4);
          mv[i * 4] += __uint_as_float(q.x << 16); mv[i * 4 + 1] += __uint_as_float(q.x & 0xffff0000u); mv[i * 4 + 2] += __uint_as_float(q.y << 16); mv[i * 4 + 3] += __uint_as_float(q.y & 0xffff0000u); } }
      float ss = 0.f;
#pragma unroll
      for (int i = 0; i < 16; ++i) ss += mv[i] * mv[i];
      ss = wave_sum(ss);
      const float rstd = rsqrtf(ss * (1.f / D) + 1e-6f);
      const float* m = p.mod + (size_t)(layer * 5 + mod_idx(row)) * 6 * D;
      float xv[16], hv[16];
#pragma unroll
      for (int i = 0; i < 4; ++i) { const int k = i * 256 + lane * 4; const float4 xo = xr[r][i]; const float4 gg = *(const float4*)(ng3 + k); const float4 g2 = *(const float4*)(m + 5 * D + k);
        xv[i * 4] = xo.x + g2.x * mv[i * 4] * rstd * gg.x; xv[i * 4 + 1] = xo.y + g2.y * mv[i * 4 + 1] * rstd * gg.y; xv[i * 4 + 2] = xo.z + g2.z * mv[i * 4 + 2] * rstd * gg.z; xv[i * 4 + 3] = xo.w + g2.w * mv[i * 4 + 3] * rstd * gg.w;
        *(float4*)(xs + k) = make_float4(xv[i * 4], xv[i * 4 + 1], xv[i * 4 + 2], xv[i * 4 + 3]); }
      if (layer + 1 < DEPTH) {
        const float* m2 = p.mod + (size_t)((layer + 1) * 5 + mod_idx(row)) * 6 * D;
        row_modulate_store(xv, p.norm_g + (size_t)(layer + 1) * 4 * D, m2, m2 + D, p.hb + (size_t)row * D, lane, hv);
      }
    }
  }
}

#define XB_TMO      128
#define XB_XCNT(j)  (256  + 64 * (j))
#define XB_XSUB(j)  (1280 + 64 * (j))
#define XB_XGEN(j)  (2304 + 64 * (j))
#define XB_TOP      3328
#define XB_TOPGEN   3392
#define XCD_BAR_WORDS 3456
#define XB_SPIN_CAP (1u << 22)
__device__ __forceinline__ unsigned xb_ld(unsigned* q)              { return __hip_atomic_load(q, __ATOMIC_RELAXED, __HIP_MEMORY_SCOPE_AGENT); }
__device__ __forceinline__ unsigned xb_add(unsigned* q, unsigned v) { return __hip_atomic_fetch_add(q, v, __ATOMIC_RELAXED, __HIP_MEMORY_SCOPE_AGENT); }
__device__ __forceinline__ unsigned xb_xcc_id() { return (unsigned)__builtin_amdgcn_s_getreg((3 << 11) | 20) & 0xFu; }
#define XB_SPIN(cond, bar) do { unsigned _sp = 0; while (cond) { __builtin_amdgcn_s_sleep(1); \
    if ((++_sp & 255u) == 0u) { if (xb_ld(&(bar)[XB_TMO])) break; if (_sp > XB_SPIN_CAP) { atomicAdd(&(bar)[XB_TMO], 1u); break; } } } } while (0)
struct XcdBarrier { unsigned* bar; unsigned x; volatile LAS unsigned* st; };
__device__ __forceinline__ XcdBarrier xcd_barrier_post(unsigned* bar, volatile LAS unsigned* st) {
  XcdBarrier b; b.bar = bar; b.x = xb_xcc_id(); b.st = st;
  if (threadIdx.x == 0) (void)xb_add(&bar[XB_XCNT(b.x)], 1u);
  return b;
}
__device__ __forceinline__ void xcd_barrier_complete(unsigned* bar, unsigned x, unsigned& nloc, unsigned& nx) {
  const unsigned G = gridDim.x * gridDim.y * gridDim.z;
  unsigned sum, cnt, mine, sp = 0u;
  for (;;) {
    sum = 0u; cnt = 0u; mine = 0u;
#pragma unroll
    for (unsigned j = 0; j < 16; ++j) { const unsigned c = xb_ld(&bar[XB_XCNT(j)]); sum += c; cnt += (c > 0u) ? 1u : 0u; mine = (j == x) ? c : mine; }
    if (sum == G) break;
    __builtin_amdgcn_s_sleep(1);
    if ((++sp & 255u) == 0u) { if (xb_ld(&bar[XB_TMO])) break; if (sp > XB_SPIN_CAP) { atomicAdd(&bar[XB_TMO], 1u); break; } }
  }
  nloc = mine > 0u ? mine : 1u; nx = cnt > 0u ? cnt : 1u;
}
__device__ __forceinline__ void xcd_barrier(const XcdBarrier& b) {
  asm volatile("s_waitcnt vmcnt(0)" ::: "memory");
  __syncthreads();
  if (threadIdx.x == 0) {
    unsigned* bar = b.bar;
    __builtin_amdgcn_s_waitcnt(0);
    unsigned nloc = b.st[0], nx = b.st[1];
    if (nloc == 0u) { xcd_barrier_complete(bar, b.x, nloc, nx); b.st[0] = nloc; b.st[1] = nx; }
    const unsigned old = xb_add(&bar[XB_XSUB(b.x)], 1u);
    const unsigned gen = old / nloc;
    if (old + 1u == (gen + 1u) * nloc) {
      __builtin_amdgcn_fence(__ATOMIC_RELEASE, "agent");
      asm volatile("s_waitcnt vmcnt(0)" ::: "memory");
      const unsigned og = xb_add(&bar[XB_TOP], 1u);
      const unsigned tg = og / nx;
      if (og + 1u == (tg + 1u) * nx) xb_add(&bar[XB_TOPGEN], 1u);
      else XB_SPIN(xb_ld(&bar[XB_TOPGEN]) == tg, bar);
      __builtin_amdgcn_fence(__ATOMIC_ACQUIRE, "agent");
      xb_add(&bar[XB_XGEN(b.x)], 1u);
      asm volatile("s_waitcnt vmcnt(0)" ::: "memory");
    } else {
      XB_SPIN(xb_ld(&bar[XB_XGEN(b.x)]) == gen, bar);
      __builtin_amdgcn_fence(__ATOMIC_ACQUIRE, "agent");
      asm volatile("s_waitcnt vmcnt(0)" ::: "memory");
    }
  }
  __syncthreads();
}

namespace cg = cooperative_groups;
constexpr int LDS_BYTES = 163840 - 16;
static_assert(sizeof(GlaLds) <= LDS_BYTES && sizeof(MbLds) <= LDS_BYTES && sizeof(DnLds) <= LDS_BYTES && sizeof(FftLds) <= LDS_BYTES, "lds");
__global__ void __launch_bounds__(NT) mega(Params p_unused) {
  extern __shared__ __attribute__((aligned(16))) char smem[];
  cg::grid_group grid = cg::this_grid();
  int bid_s = blockIdx.x, nb_s = gridDim.x, tid_v = threadIdx.x;
  const __attribute__((address_space(4))) char* kb = (const __attribute__((address_space(4))) char*)__builtin_amdgcn_kernarg_segment_ptr();
#define p (*(CParams*)({ asm volatile("" : "+s"(kb)); kb; }))
#define BID ({ asm volatile("" : "+s"(bid_s)); bid_s; })
#define NBK ({ asm volatile("" : "+s"(nb_s)); nb_s; })
#define TID ({ asm volatile("" : "+v"(tid_v)); tid_v; })
#define LAYER ({ int l_ = l; asm volatile("" : "+s"(l_)); l_; })
#define GSYNC() do { XcdBarrier xb_; xb_.bar = p.bar; xb_.x = xb_xcc_id(); xb_.st = (volatile LAS unsigned*)(smem + LDS_BYTES); xcd_barrier(xb_); } while (0)
  volatile LAS unsigned* xst = (volatile LAS unsigned*)(smem + LDS_BYTES);
  if (threadIdx.x < 4) xst[threadIdx.x] = 0u;
  __syncthreads();
  (void)xcd_barrier_post(p.bar, xst);
  phase_conv_small(p, BID, NBK, TID, smem);
  phase_mod(p, BID, NBK, TID, smem);
  grid.sync();
  phase_prenorm0(p, BID, NBK, TID);
  GSYNC();
  for (int l = 0; l < DEPTH; ++l) {
    phase_gemm_in(p, LAYER, BID, NBK, TID, smem); GSYNC();
    phase_hy_prep(p, LAYER, BID, NBK, TID);
    phase_hy_prep_t(p, LAYER, BID, NBK, TID, smem);
    phase_hy_filt<true>(p, LAYER, SEQ, p.filt, BID, NBK, TID, smem);
    if (l == 0) phase_hy_filt<false>(p, LAYER, CTX, p.filtc, BID, NBK, TID, smem);
    GSYNC();
    phase_hy_fft(p, LAYER, BID, NBK, TID, smem);
    if (l == 0) phase_hy_conv(p, LAYER, 0, true, BID, NBK, TID);
    GSYNC();
    phase_hy_fin(p, BID, NBK, TID, smem);
    if (l == 0) phase_hy_conv(p, LAYER, 1, true, BID, NBK, TID);
    GSYNC();
    phase_mb_prep(p, LAYER, BID, NBK, TID); GSYNC();
    phase_mb_chunk<0>(p, LAYER, BID, NBK, TID, smem); GSYNC();
    phase_mb_state(p, BID, NBK, TID); GSYNC();
    phase_mb_chunk<1>(p, LAYER, BID, NBK, TID, smem); GSYNC();
    phase_dn_prep(p, LAYER, BID, NBK, TID);
    phase_gla_chunk<0>(p, LAYER, BID, NBK, TID, smem); GSYNC();
    phase_dn_chunk<0>(p, LAYER, BID, NBK, TID, smem);
    phase_gla_state(p, BID, NBK, TID); GSYNC();
    { const int b_ = BID, n_ = NBK;
      if (b_ < 32) phase_dn_state(p, b_, 32, TID, smem); else phase_gla_chunk<1>(p, LAYER, b_ - 32, n_ - 32, TID, smem); }
    GSYNC();
    phase_dn_chunk<1>(p, LAYER, BID, NBK, TID, smem); GSYNC();
    phase_gemm_out(p, LAYER, BID, NBK, TID, smem); GSYNC();
    phase_postmix(p, LAYER, BID, NBK, TID, smem); GSYNC();
    phase_topk(p, LAYER, BID, NBK, TID, smem);
    phase_conv_moe(p, LAYER, BID, NBK, TID, smem);
    GSYNC();
    phase_gemm_moe1(p, LAYER, BID, NBK, TID, smem); GSYNC();
    phase_gemm_moe2(p, LAYER, BID, NBK, TID, smem); GSYNC();
    phase_combine(p, LAYER, BID, NBK, TID);
    if (l + 1 < DEPTH) GSYNC();
  }
#undef p
}

extern "C" void kernel_launch(void* const* d_in, const int* in_sizes, int n_in, void* d_out, int out_size, void* d_ws, size_t ws_size, hipStream_t stream) {
  Params p{};
  const float** fp = (const float**)&p;
  for (int i = 0; i < 37; ++i) fp[i] = (const float*)d_in[i];
  p.out = (float*)d_out;
  char* ws = (char*)d_ws; size_t off = 0;
  auto alloc = [&](size_t bytes) { size_t o = off; off += (bytes + 255) & ~(size_t)255; return ws + o; };
  p.win_t = (bf16_t*)alloc((size_t)DEPTH * NUP * D * 2);
  p.wout_t = (bf16_t*)alloc((size_t)DEPTH * D * D * 2);
  p.mod = (float*)alloc((size_t)DEPTH * 5 * 6 * D * 4);
  p.xc = (float*)alloc((size_t)TC * D * 4);
  p.aff = (float*)alloc((size_t)TT * 16 * 4);
  p.slot_tok = (int*)alloc((size_t)NSLOT * 4);
  p.slot_w = (float*)alloc((size_t)NSLOT * 4);
  p.tok_slot = (int*)alloc((size_t)TT * 16 * 4);
  p.dt = (float*)alloc((size_t)TT * 8 * 4);
  p.bg = (float*)alloc((size_t)TT * 16 * 4);
  p.filt = (float*)alloc((size_t)SEQ * 1024 * 4);
  p.filtc = (float*)alloc((size_t)CTX * 1024 * 4);
  p.hb = (bf16_t*)alloc((size_t)TT * D * 2);
  p.prep = p.hb;
  char* R = alloc((size_t)NSLOT * D * 2 * 2);
  p.u = (bf16_t*)R; p.yo = (bf16_t*)R; p.act = (bf16_t*)R; p.ymoe = (bf16_t*)(R + (size_t)NSLOT * D * 2);
  p.y = (bf16_t*)alloc((size_t)TT * D * 2);
  char* W2 = alloc((size_t)NE * 3 * D * D * 2);
  p.wgu_t = (bf16_t*)W2; p.wdn_t = (bf16_t*)(W2 + (size_t)NE * 2 * D * D * 2);
  p.obuf = (float*)W2; p.zbuf = (float*)W2; p.yt = (float*)(W2 + (size_t)36 * 1024 * 1024);
  p.gla_l = (bf16_t*)(W2 + (size_t)72 * 1024 * 1024);
  p.gla_dec = (float*)alloc((size_t)32 * NCH * 32 * 4);
  p.bar = (unsigned*)alloc((size_t)XCD_BAR_WORDS * 4);
  p.specg = (float2*)alloc((size_t)256 * 16384 * 8);
  p.mb_l = (bf16_t*)W2;
  p.mb_dec = (float*)alloc((size_t)32 * NCH * 4);
  p.dn_m = (bf16_t*)W2; p.dn_l = (bf16_t*)(W2 + (size_t)32 * NCH * 4096 * 2);
  if (off > ws_size) { fprintf(stderr, "workspace too small: need %zu have %zu\n", off, ws_size); return; }

  static int grid_blocks = 0;
  if (!grid_blocks) {
    int dev = 0, cus = 0, per_cu = 0;
    hipGetDevice(&dev);
    hipDeviceGetAttribute(&cus, hipDeviceAttributeMultiprocessorCount, dev);
    hipFuncSetAttribute((const void*)mega, hipFuncAttributeMaxDynamicSharedMemorySize, LDS_BYTES + 16);
    hipOccupancyMaxActiveBlocksPerMultiprocessor(&per_cu, mega, NT, LDS_BYTES + 16);
    if (per_cu > 1) per_cu = 1;
    grid_blocks = cus * per_cu;
  }
  hipMemsetAsync(p.bar, 0, (size_t)XCD_BAR_WORDS * 4, stream);
  void* args[] = {&p};
  hipError_t e = hipLaunchCooperativeKernel((void*)mega, dim3(grid_blocks), dim3(NT), args, LDS_BYTES + 16, stream);
  if (e != hipSuccess) fprintf(stderr, "cooperative launch failed: %s (grid %d)\n", hipGetErrorString(e), grid_blocks);
}
```

```cpp
#include <hip/hip_runtime.h>
#include <hip/hip_cooperative_groups.h>
#include <stdint.h>
#include <stdio.h>

typedef unsigned short bf16_t;
using bf16x8 = __attribute__((ext_vector_type(8))) short;
using f32x4 = __attribute__((ext_vector_type(4))) float;

constexpr int D = 1024, NB = 4, SEQ = 8192, CTX = 256, DEPTH = 2;
constexpr int TL = NB * SEQ, TC = NB * CTX, TT = TL + TC;
constexpr int NUS = 3640, NU = 3840, NUP = 3840;
constexpr int NE = 16, CAP_L = 1024, CAP_C = 32, SLOTS_E = NB * CAP_L + 256, NSLOT = NE * SLOTS_E;
constexpr int NT = 512, NW = NT / 64;
constexpr int U_GLA = 0, U_HY = 800, U_MB = 1568, U_DN = 2600;

struct Params {
  const float *x, *c, *ctx, *c_ctx, *w_mod, *b_mod, *norm_g, *w_in, *w_out, *gla_w2, *gla_b, *gla_norm,
      *hy_conv_w, *hy_conv_b, *hy_w1, *hy_b1, *hy_w2, *hy_b2, *hy_w3, *hy_b3, *hy_w4, *hy_freq, *hy_d,
      *mb_conv_w, *mb_conv_b, *mb_a_log, *mb_dt_bias, *mb_d, *mb_norm, *dn_conv_w, *dn_a_log, *dn_dt_bias, *dn_norm,
      *moe_router, *moe_w_gate, *moe_w_up, *moe_w_down;
  float* out;
  bf16_t *win_t, *wout_t, *wgu_t, *wdn_t, *hb, *prep, *u, *y, *act, *ymoe;
  float *mod, *xc, *aff, *slot_w, *dt, *bg, *filt, *filtc, *obuf, *zbuf; bf16_t* yo;
  int *slot_tok, *tok_slot;
  bf16_t* gla_l; float* gla_dec;
  bf16_t* mb_l; float* mb_dec;
  bf16_t *dn_m, *dn_l;
  float* yt;
  unsigned* bar;
  float2* specg;
  bf16_t* dn_wuc;
};

typedef const __attribute__((address_space(4))) Params CParams;

typedef float f32x2v __attribute__((ext_vector_type(2)));
typedef __bf16 bf16x2v __attribute__((ext_vector_type(2)));
__device__ __forceinline__ unsigned pack2(float a, float b) { const f32x2v v = {a, b}; return __builtin_bit_cast(unsigned, __builtin_convertvector(v, bf16x2v)); }
__device__ __forceinline__ bf16_t f2bf(float f) { return (bf16_t)(pack2(f, 0.f) & 0xffffu); }
__device__ __forceinline__ float bf2f(bf16_t h) { return __uint_as_float(((unsigned)h) << 16); }
__device__ __forceinline__ float siluf(float v) { return v * __builtin_amdgcn_rcpf(1.f + __expf(-v)); }
__device__ __forceinline__ float sigmoidf_(float v) { return __builtin_amdgcn_rcpf(1.f + __expf(-v)); }
__device__ __forceinline__ float softplusf_(float v) { const float e = __expf(v); return v > 15.f ? v : (v < -8.f ? e : __logf(1.f + e)); }
__device__ __forceinline__ float logsigmoidf_(float z) { return -softplusf_(-z); }
template <int CTRL, int RM> __device__ __forceinline__ float dppz(float v) { return __int_as_float(__builtin_amdgcn_update_dpp(0, __float_as_int(v), CTRL, RM, 0xf, true)); }
__device__ __forceinline__ float wave_sum(float v) {
  v += dppz<0x111, 0xf>(v); v += dppz<0x112, 0xf>(v); v += dppz<0x114, 0xf>(v); v += dppz<0x118, 0xf>(v);
  v += dppz<0x142, 0xa>(v); v += dppz<0x143, 0xc>(v);
  return __int_as_float(__builtin_amdgcn_readlane(__float_as_int(v), 63));
}
__device__ __forceinline__ float wave_scan(float v) {
  v += dppz<0x111, 0xf>(v); v += dppz<0x112, 0xf>(v); v += dppz<0x114, 0xf>(v); v += dppz<0x118, 0xf>(v);
  v += dppz<0x142, 0xa>(v); v += dppz<0x143, 0xc>(v);
  return v;
}
__device__ __forceinline__ float wave_max(float v) {
#define WMX_(CTRL, RM) v = fmaxf(v, __int_as_float(__builtin_amdgcn_update_dpp(__float_as_int(v), __float_as_int(v), CTRL, RM, 0xf, false)))
  WMX_(0x111, 0xf); WMX_(0x112, 0xf); WMX_(0x114, 0xf); WMX_(0x118, 0xf); WMX_(0x142, 0xa); WMX_(0x143, 0xc);
#undef WMX_
  return __int_as_float(__builtin_amdgcn_readlane(__float_as_int(v), 63));
}
__device__ __forceinline__ float xsum32(float x, float y) { const auto r = __builtin_amdgcn_permlane32_swap(__float_as_uint(x), __float_as_uint(y), false, false); return __uint_as_float(r[0]) + __uint_as_float(r[1]); }
__device__ __forceinline__ float xsum16(float x, float y) { const auto r = __builtin_amdgcn_permlane16_swap(__float_as_uint(x), __float_as_uint(y), false, false); return __uint_as_float(r[0]) + __uint_as_float(r[1]); }
__device__ __forceinline__ float half8_sum(float v) {
  v += dppz<0xB1, 0xf>(v); v += dppz<0x4E, 0xf>(v); v += dppz<0x141, 0xf>(v); return v;
}
__device__ __forceinline__ float row16_sum(float v) {
  v = half8_sum(v); v += dppz<0x140, 0xf>(v); return v;
}
#define LBAR() do { asm volatile("s_waitcnt lgkmcnt(0)" ::: "memory"); __builtin_amdgcn_s_barrier(); asm volatile("" ::: "memory"); } while (0)
__device__ __forceinline__ float4 ld4pin(const float* q) { float4 v = *(const float4*)q; asm volatile("" : "+v"(v.x), "+v"(v.y), "+v"(v.z), "+v"(v.w)); return v; }
__device__ __forceinline__ float shfl_idx(float v, int src) { return __int_as_float(__builtin_amdgcn_ds_bpermute(src << 2, __float_as_int(v))); }
__device__ __forceinline__ float rdlane(float v, int l) { return __int_as_float(__builtin_amdgcn_readlane(__float_as_int(v), l)); }
__device__ __forceinline__ float* xrow_ptr(CParams& p, int row) { return row < TL ? p.out + (size_t)row * D : p.xc + (size_t)(row - TL) * D; }
__device__ __forceinline__ int mod_idx(int row) { return row < TL ? row / SEQ : 4; }

__device__ __forceinline__ int seq_nb(int row, int delta, bool mamba) {
  if (row < TL) {
    int b = row / SEQ, t = row % SEQ;
    if (mamba) { int pos = (t & 63) * 128 + (t >> 6) + delta; if (pos < 0 || pos >= SEQ) return -1; return b * SEQ + (pos & 127) * 64 + (pos >> 7); }
    int t2 = t + delta; if (t2 < 0 || t2 >= SEQ) return -1; return b * SEQ + t2;
  }
  int r = row - TL, b = r / CTX, t = r % CTX + delta; if (t < 0 || t >= CTX) return -1; return TL + b * CTX + t;
}

struct Conv8W { float w0[8], w1[8], w2[8], b[8]; };
__device__ __forceinline__ void conv8w_load(Conv8W& W, const float* w, const float* bias, int c) {
#pragma unroll
  for (int h = 0; h < 2; ++h) { const float4 a = *(const float4*)(w + c + h * 4), b = *(const float4*)(w + 768 + c + h * 4), d = *(const float4*)(w + 1536 + c + h * 4);
    const float4 bb = bias ? *(const float4*)(bias + c + h * 4) : make_float4(0.f, 0.f, 0.f, 0.f);
    W.w0[h * 4] = a.x; W.w0[h * 4 + 1] = a.y; W.w0[h * 4 + 2] = a.z; W.w0[h * 4 + 3] = a.w; W.w1[h * 4] = b.x; W.w1[h * 4 + 1] = b.y; W.w1[h * 4 + 2] = b.z; W.w1[h * 4 + 3] = b.w;
    W.w2[h * 4] = d.x; W.w2[h * 4 + 1] = d.y; W.w2[h * 4 + 2] = d.z; W.w2[h * 4 + 3] = d.w; W.b[h * 4] = bb.x; W.b[h * 4 + 1] = bb.y; W.b[h * 4 + 2] = bb.z; W.b[h * 4 + 3] = bb.w; }
}
__device__ __forceinline__ void conv8w(const bf16_t* u, int ucol, int row, int rm, int rp, const Conv8W& W, int c, float (&o)[8]) {
  const uint4 x1 = *(const uint4*)(u + (size_t)row * NU + ucol + c);
  uint4 x0 = make_uint4(0u, 0u, 0u, 0u), x2 = make_uint4(0u, 0u, 0u, 0u);
  if (rm >= 0) x0 = *(const uint4*)(u + (size_t)rm * NU + ucol + c);
  if (rp >= 0) x2 = *(const uint4*)(u + (size_t)rp * NU + ucol + c);
  const unsigned a0[4] = {x0.x, x0.y, x0.z, x0.w}, a1[4] = {x1.x, x1.y, x1.z, x1.w}, a2[4] = {x2.x, x2.y, x2.z, x2.w};
#pragma unroll
  for (int e = 0; e < 8; ++e) { const int wd = e >> 1; const bool hi = e & 1;
    const float v0 = hi ? __uint_as_float(a0[wd] & 0xffff0000u) : __uint_as_float(a0[wd] << 16), v1 = hi ? __uint_as_float(a1[wd] & 0xffff0000u) : __uint_as_float(a1[wd] << 16), v2 = hi ? __uint_as_float(a2[wd] & 0xffff0000u) : __uint_as_float(a2[wd] << 16);
    o[e] = W.b[e] + W.w0[e] * v0 + W.w1[e] * v1 + W.w2[e] * v2; }
}
__device__ __forceinline__ void conv8w4(const bf16_t* u, int ucol, const int (&rw)[6], const Conv8W& W, int c, float (&o)[4][8]) {
  uint4 xw[6];
#pragma unroll
  for (int k = 0; k < 6; ++k) { xw[k] = make_uint4(0u, 0u, 0u, 0u); if (rw[k] >= 0) xw[k] = *(const uint4*)(u + (size_t)rw[k] * NU + ucol + c); }
#pragma unroll
  for (int r = 0; r < 4; ++r) {
    const unsigned a0[4] = {xw[r].x, xw[r].y, xw[r].z, xw[r].w}, a1[4] = {xw[r + 1].x, xw[r + 1].y, xw[r + 1].z, xw[r + 1].w}, a2[4] = {xw[r + 2].x, xw[r + 2].y, xw[r + 2].z, xw[r + 2].w};
#pragma unroll
    for (int e = 0; e < 8; ++e) { const int wd = e >> 1; const bool hi = e & 1;
      const float v0 = hi ? __uint_as_float(a0[wd] & 0xffff0000u) : __uint_as_float(a0[wd] << 16), v1 = hi ? __uint_as_float(a1[wd] & 0xffff0000u) : __uint_as_float(a1[wd] << 16), v2 = hi ? __uint_as_float(a2[wd] & 0xffff0000u) : __uint_as_float(a2[wd] << 16);
      o[r][e] = W.b[e] + W.w0[e] * v0 + W.w1[e] * v1 + W.w2[e] * v2; } }
}
__device__ __forceinline__ void conv8(const bf16_t* u, int ucol, int row, int rm, int rp, const float* w, const float* bias, int c, float (&o)[8]) {
  const uint4 x1 = *(const uint4*)(u + (size_t)row * NU + ucol + c);
  uint4 x0 = make_uint4(0u, 0u, 0u, 0u), x2 = make_uint4(0u, 0u, 0u, 0u);
  if (rm >= 0) x0 = *(const uint4*)(u + (size_t)rm * NU + ucol + c);
  if (rp >= 0) x2 = *(const uint4*)(u + (size_t)rp * NU + ucol + c);
  const unsigned a0[4] = {x0.x, x0.y, x0.z, x0.w}, a1[4] = {x1.x, x1.y, x1.z, x1.w}, a2[4] = {x2.x, x2.y, x2.z, x2.w};
#pragma unroll
  for (int h = 0; h < 2; ++h) {
    const float4 w0 = *(const float4*)(w + c + h * 4), w1 = *(const float4*)(w + 768 + c + h * 4), w2 = *(const float4*)(w + 1536 + c + h * 4);
    const float4 bb = bias ? *(const float4*)(bias + c + h * 4) : make_float4(0.f, 0.f, 0.f, 0.f);
    const float ww0[4] = {w0.x, w0.y, w0.z, w0.w}, ww1[4] = {w1.x, w1.y, w1.z, w1.w}, ww2[4] = {w2.x, w2.y, w2.z, w2.w}, bv[4] = {bb.x, bb.y, bb.z, bb.w};
#pragma unroll
    for (int e = 0; e < 4; ++e) { const int wd = h * 2 + (e >> 1); const bool hi = e & 1;
      const float v0 = hi ? __uint_as_float(a0[wd] & 0xffff0000u) : __uint_as_float(a0[wd] << 16), v1 = hi ? __uint_as_float(a1[wd] & 0xffff0000u) : __uint_as_float(a1[wd] << 16), v2 = hi ? __uint_as_float(a2[wd] & 0xffff0000u) : __uint_as_float(a2[wd] << 16);
      o[h * 4 + e] = bv[e] + ww0[e] * v0 + ww1[e] * v1 + ww2[e] * v2; }
  }
}

template <int MAP>
__device__ __forceinline__ void conv_tile4(const float* src0, const float* src1, int ldsrc, int ncols, bf16_t* dst, int K, int k0, int n0, float* tile, int tid_) {
  const int t = tid_;
  {
    const int nn = t & 63, kk = t >> 6;
    float v[4][8];
#pragma unroll
    for (int q = 0; q < 4; ++q) { const int R = n0 + q * 64 + nn; const float* sp; int col;
      if (MAP == 0) { sp = src0; col = R < ncols ? R : -1; }
      else { int j = R >> 8, rem = R & 255; col = j * 128 + (rem & 127); sp = (rem >> 7) ? src1 : src0; }
#pragma unroll
      for (int i = 0; i < 8; ++i) { int k = i * 8 + kk; v[q][i] = col >= 0 ? sp[(size_t)(k0 + k) * ldsrc + col] : 0.f; } }
#pragma unroll
    for (int q = 0; q < 4; ++q)
#pragma unroll
      for (int i = 0; i < 8; ++i) tile[q * 64 * 65 + (i * 8 + kk) * 65 + nn] = v[q][i];
  }
  __syncthreads();
  {
    const int k2 = (t & 31) * 2, nn = t >> 5;
#pragma unroll
    for (int q = 0; q < 4; ++q)
#pragma unroll
      for (int i = 0; i < 4; ++i) { int n = i * 16 + nn; unsigned v = pack2(tile[q * 64 * 65 + k2 * 65 + n], tile[q * 64 * 65 + (k2 + 1) * 65 + n]);
        *(unsigned*)(dst + (size_t)(n0 + q * 64 + n) * K + k0 + k2) = v; }
  }
  __syncthreads();
}
__device__ __forceinline__ void phase_conv_small(CParams& p, int bid, int nb, int tid_, char* smem) {
  float* tile = (float*)smem;
  const int n_in = 16 * (NUP / 256), n_out = 16 * 4;
  for (int i = bid; i < DEPTH * (n_in + n_out); i += nb) {
    int l = i / (n_in + n_out), r = i % (n_in + n_out);
    if (r < n_in) { int kt = r % 16, nt = r / 16; conv_tile4<0>(p.w_in + (size_t)l * D * NUS, nullptr, NUS, NUS, p.win_t + (size_t)l * NUP * D, D, kt * 64, nt * 256, tile, tid_); }
    else { r -= n_in; int kt = r % 16, nt = r / 16; conv_tile4<0>(p.w_out + (size_t)l * D * D, nullptr, D, D, p.wout_t + (size_t)l * D * D, D, kt * 64, nt * 256, tile, tid_); }
  }
}
__device__ __forceinline__ void phase_conv_moe(CParams& p, int layer, int bid, int nb, int tid_, char* smem, int lo, int hi) {
  float* tile = (float*)smem;
  const int n_gu = 16 * 8, n_dn = 16 * 4;
  for (int i = lo + bid; i < hi; i += nb) {
    int e = i / (n_gu + n_dn), r = i % (n_gu + n_dn);
    size_t wo = ((size_t)layer * NE + e) * D * D;
    if (r < n_gu) { int kt = r % 16, nt = r / 16; conv_tile4<1>(p.moe_w_gate + wo, p.moe_w_up + wo, D, D, p.wgu_t + (size_t)e * 2048 * D, D, kt * 64, nt * 256, tile, tid_); }
    else { r -= n_gu; int kt = r % 16, nt = r / 16; conv_tile4<0>(p.moe_w_down + wo, nullptr, D, D, p.wdn_t + (size_t)e * D * D, D, kt * 64, nt * 256, tile, tid_); }
  }
}

__device__ __forceinline__ void phase_mod(CParams& p, int bid, int nb, int tid_, char* smem) {
  float* sc = (float*)smem;
  float* red = sc + 5 * D;
  const int lane = tid_ & 63, wv = tid_ >> 6;
  for (int i = tid_; i < 5 * D; i += NT) { int r = i / D, k = i % D; float v = r < 4 ? p.c[r * D + k] : p.c_ctx[k]; sc[i] = siluf(v); }
  __syncthreads();
  for (int blk = bid; blk < DEPTH * 6 * D / 64; blk += nb) {
    const int g = blk * 64 + lane, l = g / (6 * D), n = g % (6 * D);
    const float* w = p.w_mod + (size_t)l * D * 6 * D + n;
    float a0 = 0, a1 = 0, a2 = 0, a3 = 0, a4 = 0;
#pragma unroll 8
    for (int k = wv * 128; k < wv * 128 + 128; ++k) { float wvv = w[(size_t)k * 6 * D]; a0 += sc[k] * wvv; a1 += sc[D + k] * wvv; a2 += sc[2 * D + k] * wvv; a3 += sc[3 * D + k] * wvv; a4 += sc[4 * D + k] * wvv; }
    red[(wv * 5 + 0) * 64 + lane] = a0; red[(wv * 5 + 1) * 64 + lane] = a1; red[(wv * 5 + 2) * 64 + lane] = a2; red[(wv * 5 + 3) * 64 + lane] = a3; red[(wv * 5 + 4) * 64 + lane] = a4;
    __syncthreads();
    if (wv < 5) { float t = p.b_mod[l * 6 * D + n];
#pragma unroll
      for (int q = 0; q < 8; ++q) t += red[(q * 5 + wv) * 64 + lane];
      p.mod[((size_t)l * 5 + wv) * 6 * D + n] = t; }
    __syncthreads();
  }
}

__device__ __forceinline__ void row_modulate_store(const float (&xv)[16], const float* g, const float* sh, const float* sc, bf16_t* dst, int lane, float (&hv)[16]) {
  float ss = 0.f;
#pragma unroll
  for (int i = 0; i < 16; ++i) ss += xv[i] * xv[i];
  ss = wave_sum(ss);
  float rstd = rsqrtf(ss * (1.f / D) + 1e-6f);
#pragma unroll
  for (int i = 0; i < 4; ++i) {
    int k = i * 256 + lane * 4;
    float4 gv = *(const float4*)(g + k), shv = *(const float4*)(sh + k), scv = *(const float4*)(sc + k);
    hv[i * 4 + 0] = xv[i * 4 + 0] * rstd * gv.x * (1.f + scv.x) + shv.x;
    hv[i * 4 + 1] = xv[i * 4 + 1] * rstd * gv.y * (1.f + scv.y) + shv.y;
    hv[i * 4 + 2] = xv[i * 4 + 2] * rstd * gv.z * (1.f + scv.z) + shv.z;
    hv[i * 4 + 3] = xv[i * 4 + 3] * rstd * gv.w * (1.f + scv.w) + shv.w;
    uint2 pk; pk.x = pack2(hv[i * 4 + 0], hv[i * 4 + 1]); pk.y = pack2(hv[i * 4 + 2], hv[i * 4 + 3]);
    *(uint2*)(dst + k) = pk;
  }
}
__device__ __forceinline__ void phase_prenorm0(CParams& p, int bid, int nb, int tid_) {
  const int lane = tid_ & 63, wv = tid_ >> 6;
  for (int row0 = (bid * NW + wv) * 2; row0 < TT; row0 += nb * NW * 2) {
    float xv[2][16], hv[16];
#pragma unroll
    for (int r = 0; r < 2; ++r) { const int row = row0 + r; const float* src = row < TL ? p.x + (size_t)row * D : p.ctx + (size_t)(row - TL) * D;
#pragma unroll
      for (int i = 0; i < 4; ++i) { float4 v = *(const float4*)(src + i * 256 + lane * 4); xv[r][i * 4] = v.x; xv[r][i * 4 + 1] = v.y; xv[r][i * 4 + 2] = v.z; xv[r][i * 4 + 3] = v.w; } }
#pragma unroll
    for (int r = 0; r < 2; ++r) { const int row = row0 + r; const float* m = p.mod + (size_t)(0 * 5 + mod_idx(row)) * 6 * D;
      row_modulate_store(xv[r], p.norm_g + 0 * 4 * D + 0 * D, m + 0 * D, m + 1 * D, p.hb + (size_t)row * D, lane, hv); }
  }
}

#define LAS __attribute__((address_space(3)))
namespace g8 {
typedef unsigned u32x4 __attribute__((ext_vector_type(4)));
constexpr int BM = 256, BK = 64, HALF = 128, HTB = HALF * BK * 2, KD = 1024;
__device__ __forceinline__ int lds_byte(int r, int c) { const int st = (r >> 4) * 2 + (c >> 5), rr = r & 15, cc = c & 31, ob = rr * 64 + cc * 2; return st * 1024 + (ob ^ (((ob >> 9) & 1) << 5)); }
__device__ __forceinline__ void stage_rc(int b, int& R, int& C) { const int st = b / 1024, sb = b % 1024, swz = sb ^ (((sb >> 9) & 1) << 5); R = (st >> 1) * 16 + swz / 64; C = (st & 1) * 32 + (swz % 64) / 2; }
__device__ __forceinline__ int perm32(int rho) { const int n = rho >> 4, i = rho & 15; return 8 * (i >> 2) + 4 * n + (i & 3); }
__device__ __forceinline__ unsigned cvt_pk_bf16(float lo, float hi) { unsigned r; asm volatile("v_cvt_pk_bf16_f32 %0, %1, %2" : "=v"(r) : "v"(lo), "v"(hi)); return r; }
struct Unit { int ar0, br0, pn, e; };
struct SchedPlain {
  int nM, nN, nwg, G, c;
  __device__ __forceinline__ bool next(int i, Unit& u) const {
    const long Lx = (long)i * G + c; if (Lx >= nwg) return false;
    int wgid = (int)Lx; { const int q = nwg / 8, r = nwg % 8, xcd = wgid % 8, off = wgid / 8; wgid = (xcd < r ? xcd * (q + 1) : r * (q + 1) + (xcd - r) * q) + off; }
    const int nig = 8 * nN, gid = wgid / nig, fm = gid * 8, gsz = (nM - fm) < 8 ? (nM - fm) : 8;
    const int pm = fm + ((wgid % nig) % gsz), pn = (wgid % nig) / gsz;
    u.ar0 = pm * BM; u.br0 = pn * BM; u.pn = pn; u.e = 0; return true;
  }
};
struct SchedMoe {
  int mt_e, nN, G, c;
  __device__ __forceinline__ bool next(int i, Unit& u) const {
    const long Lx = (long)i * G + c; if (Lx >= (long)NE * mt_e * nN) return false;
    const int e = (int)Lx / (mt_e * nN), r = (int)Lx % (mt_e * nN);
    const int gid = r / (8 * nN), fm = gid * 8, gsz = (mt_e - fm) < 8 ? (mt_e - fm) : 8, rr = r - gid * 8 * nN, pm = fm + rr % gsz, pn = rr / gsz;
    u.ar0 = e * SLOTS_E + pm * BM; u.br0 = (e * nN + pn) * BM; u.pn = pn; u.e = e; return true;
  }
};
template <bool GATHER, class Epi, class Sched>
__device__ __forceinline__ void gemm8(LAS unsigned char* lds, const bf16_t* A, const int* aidx, const bf16_t* Bt, const Sched& S, const Epi& E, int tid) {
  const int wid = __builtin_amdgcn_readfirstlane(tid >> 6), lane = tid & 63, wr = wid >> 2, wc = wid & 3, fr = lane & 15, fq = lane >> 4;
  constexpr int K = KD, nt = K / BK;
  int Rr[2], Cc[2]; unsigned voffB[2];
#pragma unroll
  for (int i = 0; i < 2; ++i) { stage_rc(tid * 16 + i * 8192, Rr[i], Cc[i]); const int Rb = Epi::PERM ? ((Rr[i] & ~31) + perm32(Rr[i] & 31)) : Rr[i]; voffB[i] = (unsigned)(Rb * K + Cc[i]) * 2u; }
  const size_t kstep = (size_t)(BK * 2), hstep = (size_t)HALF * K * 2;
  const unsigned ldsw = (unsigned)wid * 1024u;
  const int aoff = lds_byte(wr * 64 + fr, fq * 8), boff = lds_byte(wc * 32 + fr, fq * 8);
#define G8_SA(b, h) (((b) * 2 + (h)) * HTB)
#define G8_SB(b, h) ((4 + (b) * 2 + (h)) * HTB)
#define G8_STAGE(bufoff, gbase, voff) do { _Pragma("unroll") for (int _i = 0; _i < 2; ++_i) \
    __builtin_amdgcn_global_load_lds((const unsigned*)((const char*)(gbase) + (voff)[_i]), (LAS unsigned*)(lds + (bufoff) + ldsw + _i * 8192), 16, 0, 0); } while (0)
#define G8_LDA(dst, b, h) do { _Pragma("unroll") for (int m = 0; m < 4; ++m) _Pragma("unroll") for (int k = 0; k < 2; ++k) dst[m][k] = *(const LAS bf16x8*)(lds + G8_SA(b, h) + aoff + m * 2048 + k * 1024); } while (0)
#define G8_LDB(dst, b, h) do { _Pragma("unroll") for (int n = 0; n < 2; ++n) _Pragma("unroll") for (int k = 0; k < 2; ++k) dst[n][k] = *(const LAS bf16x8*)(lds + G8_SB(b, h) + boff + n * 2048 + k * 1024); } while (0)
#define G8_MMA(ai, bj, At, Btf) do { __builtin_amdgcn_s_setprio(1); _Pragma("unroll") for (int m = 0; m < 4; ++m) _Pragma("unroll") for (int n = 0; n < 2; ++n) _Pragma("unroll") for (int k = 0; k < 2; ++k) \
    acc[ai][bj][m][n] = __builtin_amdgcn_mfma_f32_16x16x32_bf16(Btf[n][k], At[m][k], acc[ai][bj][m][n], 0, 0, 0); __builtin_amdgcn_s_setprio(0); } while (0)
#define G8_WAIT_V(n) asm volatile("s_waitcnt vmcnt(" #n ")" ::: "memory")
#define G8_WAIT_L(n) asm volatile("s_waitcnt lgkmcnt(" #n ")" ::: "memory")
#define G8_BAR __builtin_amdgcn_s_barrier()
#define G8_SCHED __builtin_amdgcn_sched_barrier(0)
#define G8_AOFF(dst, un) do { _Pragma("unroll") for (int h = 0; h < 2; ++h) _Pragma("unroll") for (int i = 0; i < 2; ++i) { const int r_ = (un).ar0 + h * HALF + Rr[i]; \
    const int g_ = GATHER ? aidx[r_] : r_; dst[h][i] = (unsigned)(g_ * K + Cc[i]) * 2u; } } while (0)
  Unit cur, nxt; int ui = 0;
  if (!S.next(0, cur)) return;
  f32x4 acc[2][2][4][2];
#pragma unroll
  for (int a = 0; a < 2; ++a)
#pragma unroll
    for (int b = 0; b < 2; ++b)
#pragma unroll
      for (int m = 0; m < 4; ++m)
#pragma unroll
        for (int n = 0; n < 2; ++n) acc[a][b][m][n] = (f32x4){0.f, 0.f, 0.f, 0.f};
  bf16x8 At[4][2], B0[2][2], B1[2][2];
  unsigned vA[2][2], vAn[2][2];
  G8_AOFF(vA, cur);
  const char* cA = (const char*)A; const char* cB = (const char*)Bt + (size_t)cur.br0 * K * 2;
  G8_STAGE(G8_SB(0, 0), cB, voffB); G8_STAGE(G8_SA(0, 0), cA, vA[0]); G8_STAGE(G8_SB(0, 1), cB + hstep, voffB); G8_STAGE(G8_SA(0, 1), cA, vA[1]);
  if (wr == 1) G8_BAR;
  G8_WAIT_V(4); G8_BAR;
  G8_STAGE(G8_SB(1, 0), cB + kstep, voffB); G8_STAGE(G8_SA(1, 0), cA + kstep, vA[0]); G8_STAGE(G8_SB(1, 1), cB + hstep + kstep, voffB);
  G8_WAIT_V(6); G8_BAR;
  for (;;) {
    const bool has_next = S.next(ui + 1, nxt);
    if (has_next) { G8_AOFF(vAn, nxt); } else {
#pragma unroll
      for (int h = 0; h < 2; ++h)
#pragma unroll
        for (int i = 0; i < 2; ++i) vAn[h][i] = vA[h][i]; }
    const char* nB = has_next ? (const char*)Bt + (size_t)nxt.br0 * K * 2 : cB;
    for (int t = 0; t < nt; t += 2) {
      const bool last = (t == nt - 2);
      const char* a1 = cA + (size_t)(t + 1) * kstep;
      const char* a2 = last ? cA : cA + (size_t)(t + 2) * kstep; const char* b2 = last ? nB : cB + (size_t)(t + 2) * kstep;
      const char* a3 = a2 + kstep; const char* b3 = b2 + kstep;
      unsigned v2[2][2];
#pragma unroll
      for (int h = 0; h < 2; ++h)
#pragma unroll
        for (int i = 0; i < 2; ++i) v2[h][i] = last ? vAn[h][i] : vA[h][i];
      G8_LDB(B0, 0, 0); G8_SCHED; G8_LDA(At, 0, 0); G8_STAGE(G8_SA(1, 1), a1, vA[1]);
      G8_WAIT_L(8); G8_BAR; G8_WAIT_L(0); G8_MMA(0, 0, At, B0); G8_BAR; G8_SCHED;
      G8_LDB(B1, 0, 1); G8_STAGE(G8_SB(0, 0), b2, voffB);
      G8_BAR; G8_WAIT_L(0); G8_MMA(0, 1, At, B1); G8_BAR;
      G8_LDA(At, 0, 1); G8_STAGE(G8_SA(0, 0), a2, v2[0]);
      G8_BAR; G8_WAIT_L(0); G8_MMA(1, 0, At, B0); G8_BAR; G8_SCHED;
      G8_STAGE(G8_SB(0, 1), b2 + hstep, voffB);
      G8_WAIT_V(6); G8_BAR; G8_MMA(1, 1, At, B1); G8_BAR;
      G8_LDB(B0, 1, 0); G8_SCHED; G8_LDA(At, 1, 0); G8_STAGE(G8_SA(0, 1), a2, v2[1]);
      G8_WAIT_L(8); G8_BAR; G8_WAIT_L(0); G8_MMA(0, 0, At, B0); G8_BAR; G8_SCHED;
      G8_LDB(B1, 1, 1); G8_STAGE(G8_SB(1, 0), b3, voffB);
      G8_BAR; G8_WAIT_L(0); G8_MMA(0, 1, At, B1); G8_BAR;
      G8_LDA(At, 1, 1); G8_STAGE(G8_SA(1, 0), a3, v2[0]);
      G8_BAR; G8_WAIT_L(0); G8_MMA(1, 0, At, B0); G8_BAR; G8_SCHED;
      G8_STAGE(G8_SB(1, 1), b3 + hstep, voffB);
      G8_WAIT_V(6); G8_BAR; G8_MMA(1, 1, At, B1); G8_BAR;
    }
    E(acc, cur, wr, wc, fr, fq);
    if (!has_next) break;
#pragma unroll
    for (int a = 0; a < 2; ++a)
#pragma unroll
      for (int b = 0; b < 2; ++b)
#pragma unroll
        for (int m = 0; m < 4; ++m)
#pragma unroll
          for (int n = 0; n < 2; ++n) acc[a][b][m][n] = (f32x4){0.f, 0.f, 0.f, 0.f};
    cur = nxt; cB = nB; ++ui;
#pragma unroll
    for (int h = 0; h < 2; ++h)
#pragma unroll
      for (int i = 0; i < 2; ++i) vA[h][i] = vAn[h][i];
  }
  G8_WAIT_V(0);
  if (wr == 0) G8_BAR;
  G8_BAR;
#undef G8_SA
#undef G8_SB
#undef G8_STAGE
#undef G8_LDA
#undef G8_LDB
#undef G8_MMA
#undef G8_WAIT_V
#undef G8_WAIT_L
#undef G8_BAR
#undef G8_SCHED
#undef G8_AOFF
}
struct EpiU {
  static constexpr bool PERM = true; bf16_t* u;
  __device__ __forceinline__ void operator()(const f32x4 (&acc)[2][2][4][2], const Unit& un, int wr, int wc, int fr, int fq) const {
#pragma unroll
    for (int ai = 0; ai < 2; ++ai)
#pragma unroll
      for (int m = 0; m < 4; ++m) { bf16_t* rowp = u + (size_t)(un.ar0 + ai * HALF + wr * 64 + m * 16 + fr) * NU;
#pragma unroll
        for (int bj = 0; bj < 2; ++bj) { const int c0 = un.pn * BM + bj * HALF + wc * 32 + 8 * fq;
          { u32x4 w; w.x = cvt_pk_bf16(acc[ai][bj][m][0][0], acc[ai][bj][m][0][1]); w.y = cvt_pk_bf16(acc[ai][bj][m][0][2], acc[ai][bj][m][0][3]);
            w.z = cvt_pk_bf16(acc[ai][bj][m][1][0], acc[ai][bj][m][1][1]); w.w = cvt_pk_bf16(acc[ai][bj][m][1][2], acc[ai][bj][m][1][3]); *(u32x4*)(rowp + c0) = w; } } }
  }
};
struct EpiYo {
  static constexpr bool PERM = true; bf16_t* yo;
  __device__ __forceinline__ void operator()(const f32x4 (&acc)[2][2][4][2], const Unit& un, int wr, int wc, int fr, int fq) const {
#pragma unroll
    for (int ai = 0; ai < 2; ++ai)
#pragma unroll
      for (int m = 0; m < 4; ++m) { bf16_t* rowp = yo + (size_t)(un.ar0 + ai * HALF + wr * 64 + m * 16 + fr) * D + un.pn * BM + wc * 32 + 8 * fq;
#pragma unroll
        for (int bj = 0; bj < 2; ++bj) { u32x4 w; w.x = cvt_pk_bf16(acc[ai][bj][m][0][0], acc[ai][bj][m][0][1]); w.y = cvt_pk_bf16(acc[ai][bj][m][0][2], acc[ai][bj][m][0][3]);
          w.z = cvt_pk_bf16(acc[ai][bj][m][1][0], acc[ai][bj][m][1][1]); w.w = cvt_pk_bf16(acc[ai][bj][m][1][2], acc[ai][bj][m][1][3]); *(u32x4*)(rowp + bj * HALF) = w; } }
  }
};
struct EpiAct {
  static constexpr bool PERM = true; bf16_t* act;
  __device__ __forceinline__ void operator()(const f32x4 (&acc)[2][2][4][2], const Unit& un, int wr, int wc, int fr, int fq) const {
#pragma unroll
    for (int ai = 0; ai < 2; ++ai)
#pragma unroll
      for (int m = 0; m < 4; ++m) { bf16_t* dst = act + (size_t)(un.ar0 + ai * HALF + wr * 64 + m * 16 + fr) * D + un.pn * HALF + wc * 32 + 8 * fq; float v[8];
#pragma unroll
        for (int n = 0; n < 2; ++n)
#pragma unroll
          for (int j = 0; j < 4; ++j) { const float g = acc[ai][0][m][n][j]; v[n * 4 + j] = g * __builtin_amdgcn_rcpf(1.f + __expf(-g)) * acc[ai][1][m][n][j]; }
        u32x4 w; w.x = cvt_pk_bf16(v[0], v[1]); w.y = cvt_pk_bf16(v[2], v[3]); w.z = cvt_pk_bf16(v[4], v[5]); w.w = cvt_pk_bf16(v[6], v[7]); *(u32x4*)dst = w; }
  }
};
struct EpiYm {
  static constexpr bool PERM = true; bf16_t* ym; const float* sw;
  __device__ __forceinline__ void operator()(const f32x4 (&acc)[2][2][4][2], const Unit& un, int wr, int wc, int fr, int fq) const {
#pragma unroll
    for (int ai = 0; ai < 2; ++ai)
#pragma unroll
      for (int m = 0; m < 4; ++m) { const int row = un.ar0 + ai * HALF + wr * 64 + m * 16 + fr; const float w8 = sw[row]; bf16_t* rowp = ym + (size_t)row * D + un.pn * BM + wc * 32 + 8 * fq;
#pragma unroll
        for (int bj = 0; bj < 2; ++bj) { u32x4 w; w.x = cvt_pk_bf16(acc[ai][bj][m][0][0] * w8, acc[ai][bj][m][0][1] * w8); w.y = cvt_pk_bf16(acc[ai][bj][m][0][2] * w8, acc[ai][bj][m][0][3] * w8);
          w.z = cvt_pk_bf16(acc[ai][bj][m][1][0] * w8, acc[ai][bj][m][1][1] * w8); w.w = cvt_pk_bf16(acc[ai][bj][m][1][2] * w8, acc[ai][bj][m][1][3] * w8); *(u32x4*)(rowp + bj * HALF) = w; } }
  }
};
}

__device__ __forceinline__ void phase_gemm_in(CParams& p, int layer, int bid, int nb, int tid_, char* smem) {
  g8::SchedPlain S; S.nM = TT / 256; S.nN = NUP / 256; S.nwg = S.nM * S.nN; S.G = nb; S.c = bid;
  g8::EpiU E; E.u = p.u;
  g8::gemm8<false>((LAS unsigned char*)smem, p.hb, nullptr, p.win_t + (size_t)layer * NUP * D, S, E, tid_);
}
__device__ __forceinline__ void phase_gemm_out(CParams& p, int layer, int bid, int nb, int tid_, char* smem) {
  g8::SchedPlain S; S.nM = (layer == 0 ? TT : TL) / 256; S.nN = D / 256; S.nwg = S.nM * S.nN; S.G = nb; S.c = bid;
  g8::EpiYo E; E.yo = p.yo;
  g8::gemm8<false>((LAS unsigned char*)smem, p.y, nullptr, p.wout_t + (size_t)layer * D * D, S, E, tid_);
}
__device__ __forceinline__ void phase_gemm_moe1(CParams& p, int layer, int bid, int nb, int tid_, char* smem) {
  g8::SchedMoe S; S.mt_e = layer == 0 ? 17 : 16; S.nN = 8; S.G = nb; S.c = bid;
  g8::EpiAct E; E.act = p.act;
  g8::gemm8<true>((LAS unsigned char*)smem, p.hb, p.slot_tok, p.wgu_t, S, E, tid_);
}
__device__ __forceinline__ void phase_gemm_moe2(CParams& p, int layer, int bid, int nb, int tid_, char* smem) {
  g8::SchedMoe S; S.mt_e = layer == 0 ? 17 : 16; S.nN = 4; S.G = nb; S.c = bid;
  g8::EpiYm E; E.ym = p.ymoe; E.sw = p.slot_w;
  g8::gemm8<false>((LAS unsigned char*)smem, p.act, nullptr, p.wdn_t, S, E, tid_);
}

template <int MT, int NTL, int KS, int LDA, int LDB>
__device__ __forceinline__ void wmm(f32x4 (&acc)[MT][NTL], const bf16_t* A, const bf16_t* B, int fr, int fq) {
#pragma unroll
  for (int ks = 0; ks < KS; ++ks) {
    bf16x8 a[MT], b[NTL];
#pragma unroll
    for (int m = 0; m < MT; ++m) a[m] = *(const bf16x8*)(A + (m * 16 + fr) * LDA + ks * 32 + fq * 8);
#pragma unroll
    for (int n = 0; n < NTL; ++n) b[n] = *(const bf16x8*)(B + (n * 16 + fr) * LDB + ks * 32 + fq * 8);
#pragma unroll
    for (int m = 0; m < MT; ++m)
#pragma unroll
      for (int n = 0; n < NTL; ++n) acc[m][n] = __builtin_amdgcn_mfma_f32_16x16x32_bf16(a[m], b[n], acc[m][n], 0, 0, 0);
  }
}
constexpr int NCH = 132;
__device__ __forceinline__ int chunk_row0(int b, int cpos) { return cpos < 4 ? TL + b * CTX + cpos * 64 : b * SEQ + (cpos - 4) * 64; }
__device__ __forceinline__ int scan_idx(int cpos, int dir) { return dir == 0 ? cpos : (cpos < 4 ? 3 - cpos : 135 - cpos); }

struct GlaLds {
  bf16_t rq[64][32], rk[64][32], rv[64][64], rog[64][64], rlr[64][32];
  float w2s[2][16][32]; float gbs[2][32]; float g[2][64][36]; float gt[2][32];
  bf16_t qg[2][64][40]; bf16_t kg[2][64][40];
  bf16_t vt[64][72]; bf16_t at[2][64][72]; float ox[64][65];
};
template <int PASS>
__device__ __forceinline__ void phase_gla_chunk(CParams& p, int layer, int bid, int nb, int tid_, char* smem) {
  GlaLds& L = *(GlaLds*)smem;
  const int c_lo = (PASS == 1 && layer == DEPTH - 1) ? 4 : 0, ncp = NCH - c_lo;
  uint4 r0 = make_uint4(0u, 0u, 0u, 0u), r1 = r0, r2 = r0, r3 = r0; float w2a = 0.f, w2b = 0.f, gbv = 0.f;
  auto gfetch = [&](int task_, int tid) { const int h_ = task_ & 3, cpos_ = c_lo + (task_ >> 2) % ncp, b_ = (task_ >> 2) / ncp; const bf16_t* U0_ = p.u + (size_t)chunk_row0(b_, cpos_) * NU;
    auto gsrc = [&](int i) -> const bf16_t* { const int f = (i * 2341) >> 16, c = i - f * 28;
      const int col = c < 4 ? h_ * 32 + c * 8 : (c < 8 ? 128 + h_ * 32 + (c - 4) * 8 : (c < 16 ? 256 + h_ * 64 + (c - 8) * 8 : (c < 24 ? 512 + h_ * 64 + (c - 16) * 8 : 768 + (c - 24) * 8)));
      return U0_ + (size_t)f * NU + col; };
    r0 = *(const uint4*)gsrc(tid); r1 = *(const uint4*)gsrc(tid + NT); r2 = *(const uint4*)gsrc(tid + 2 * NT);
    if (tid < 64 * 28 - 3 * NT) r3 = *(const uint4*)gsrc(tid + 3 * NT);
    const int i0 = tid, i1 = tid + NT;
    w2a = p.gla_w2[((size_t)(layer * 2 + (i0 >> 9)) * 16 + ((i0 >> 5) & 15)) * 128 + h_ * 32 + (i0 & 31)]; w2b = p.gla_w2[((size_t)(layer * 2 + (i1 >> 9)) * 16 + ((i1 >> 5) & 15)) * 128 + h_ * 32 + (i1 & 31)];
    if (tid < 64) gbv = p.gla_b[(layer * 2 + (tid >> 5)) * 128 + h_ * 32 + (tid & 31)]; };
  if (bid < NB * ncp * 4) gfetch(bid, tid_);
  for (int task = bid; task < NB * ncp * 4; task += nb) {
    int tid = tid_; asm volatile("" : "+v"(tid));
    const int lane = tid & 63, wv = tid >> 6, fr = lane & 15, fq = lane >> 4, dirw = wv >> 2, s4 = wv & 3;
    const int h = task & 3, cpos = c_lo + (task >> 2) % ncp, b = (task >> 2) / ncp;
    const int row0 = chunk_row0(b, cpos);
    const bf16_t* U0 = p.u + (size_t)row0 * NU;
    const int seq = (b * 4 + h) * 2 + dirw, nsc = scan_idx(cpos, dirw);
    bf16x8 sfrag[4];
    float nwv[4] = {0.f, 0.f, 0.f, 0.f};
    if (PASS == 1) {
#pragma unroll
      for (int n = 0; n < 4; ++n) nwv[n] = p.gla_norm[layer * 256 + h * 64 + n * 16 + fr]; }
    if (PASS == 1) { const bf16_t* sb = p.gla_l + ((size_t)seq * NCH + nsc) * 2048;
#pragma unroll
      for (int n = 0; n < 4; ++n) sfrag[n] = *(const bf16x8*)(sb + (n * 16 + fr) * 32 + fq * 8); }
    { auto ldst = [&](int i) -> bf16_t* { const int f = (i * 2341) >> 16, c = i - f * 28;
        return c < 4 ? &L.rq[f][c * 8] : (c < 8 ? &L.rk[f][(c - 4) * 8] : (c < 16 ? &L.rv[f][(c - 8) * 8] : (c < 24 ? &L.rog[f][(c - 16) * 8] : &L.rlr[f][(c - 24) * 8]))); };
      *(uint4*)ldst(tid) = r0; *(uint4*)ldst(tid + NT) = r1; *(uint4*)ldst(tid + 2 * NT) = r2;
      if (tid < 64 * 28 - 3 * NT) *(uint4*)ldst(tid + 3 * NT) = r3;
      (&L.w2s[0][0][0])[tid] = w2a; (&L.w2s[0][0][0])[tid + NT] = w2b;
      if (tid < 64) L.gbs[tid >> 5][tid & 31] = gbv; }
    if (task + nb < NB * ncp * 4) gfetch(task + nb, tid);
    LBAR();
    { const int dir = tid >> 8, f = (tid >> 2) & 63, d0 = (tid & 3) * 8;
      float z[8];
#pragma unroll
      for (int e = 0; e < 8; ++e) z[e] = L.gbs[dir][d0 + e];
      const uint4 l0 = *(const uint4*)&L.rlr[f][dir * 16], l1 = *(const uint4*)&L.rlr[f][dir * 16 + 8];
      const unsigned lw[8] = {l0.x, l0.y, l0.z, l0.w, l1.x, l1.y, l1.z, l1.w};
#pragma unroll
      for (int r = 0; r < 16; ++r) { const float lv = (r & 1) ? __uint_as_float(lw[r >> 1] & 0xffff0000u) : __uint_as_float(lw[r >> 1] << 16);
        const float4 wa = *(const float4*)&L.w2s[dir][r][d0], wb = *(const float4*)&L.w2s[dir][r][d0 + 4];
        z[0] += lv * wa.x; z[1] += lv * wa.y; z[2] += lv * wa.z; z[3] += lv * wa.w; z[4] += lv * wb.x; z[5] += lv * wb.y; z[6] += lv * wb.z; z[7] += lv * wb.w; }
#pragma unroll
      for (int e = 0; e < 8; ++e) z[e] = logsigmoidf_(z[e]) * (1.f / 16.f);
      *(float4*)&L.g[dir][f][d0] = make_float4(z[0], z[1], z[2], z[3]); *(float4*)&L.g[dir][f][d0 + 4] = make_float4(z[4], z[5], z[6], z[7]); }
    LBAR();
#pragma unroll
    for (int cc = 0; cc < 8; ++cc) { const int col = wv * 8 + cc, dir = col >> 5, d = col & 31, f = dir ? 63 - lane : lane;
      float v = L.g[dir][f][d];
      v = wave_scan(v);
      L.g[dir][f][d] = v; if (lane == 63) L.gt[dir][d] = v; }
    LBAR();
    if (PASS == 1) {
      for (int i = tid; i < 2 * 64 * 16; i += NT) { int dir = i >> 10, f = (i >> 4) & 63, dp = i & 15;
        const unsigned qq = *(const unsigned*)&L.rq[f][2 * dp], kk = *(const unsigned*)&L.rk[f][2 * dp];
        const float2 cc = *(const float2*)&L.g[dir][f][2 * dp];
        const float e0 = __expf(cc.x), e1 = __expf(cc.y);
        *(unsigned*)&L.qg[dir][f][2 * dp] = pack2(__uint_as_float(qq << 16) * e0 * 0.17677669529663687f, __uint_as_float(qq & 0xffff0000u) * e1 * 0.17677669529663687f);
        *(unsigned*)&L.kg[dir][f][2 * dp] = pack2(__uint_as_float(kk << 16) * __builtin_amdgcn_rcpf(e0), __uint_as_float(kk & 0xffff0000u) * __builtin_amdgcn_rcpf(e1)); }
    } else {
      bf16_t (*ket)[32][72] = (bf16_t (*)[32][72])&L.kg[0][0][0];
      for (int i = tid; i < 2 * 32 * 16; i += NT) { int d = i & 31, f4 = (i >> 5) & 15, dir = i >> 9, f0 = f4 * 4; float v[4];
#pragma unroll
        for (int q = 0; q < 4; ++q) v[q] = bf2f(L.rk[f0 + q][d]) * __expf(L.gt[dir][d] - L.g[dir][f0 + q][d]);
        uint2 pk; pk.x = pack2(v[0], v[1]); pk.y = pack2(v[2], v[3]); *(uint2*)&ket[dir][d][f0] = pk; }
    }
    for (int i = tid; i < 64 * 16; i += NT) { int c = i & 63, f0 = (i >> 6) * 4;
      uint2 pk; pk.x = (unsigned)L.rv[f0][c] | ((unsigned)L.rv[f0 + 1][c] << 16); pk.y = (unsigned)L.rv[f0 + 2][c] | ((unsigned)L.rv[f0 + 3][c] << 16); *(uint2*)&L.vt[c][f0] = pk; }
    LBAR();
    if (PASS == 0) {
      const bf16_t (*ket)[32][72] = (const bf16_t (*)[32][72])&L.kg[0][0][0];
      f32x4 acc[2][1] = {{{0.f, 0.f, 0.f, 0.f}}, {{0.f, 0.f, 0.f, 0.f}}};
      wmm<2, 1, 2, 72, 72>(acc, &ket[dirw][0][0], &L.vt[s4 * 16][0], fr, fq);
      bf16_t* dst = p.gla_l + ((size_t)seq * NCH + nsc) * 2048 + (s4 * 16 + fr) * 32;
#pragma unroll
      for (int m = 0; m < 2; ++m) { uint2 pk; pk.x = pack2(acc[m][0][0], acc[m][0][1]); pk.y = pack2(acc[m][0][2], acc[m][0][3]); *(uint2*)(dst + m * 16 + fq * 4) = pk; }
      if (tid < 64) { int dir = tid >> 5, d = tid & 31; p.gla_dec[((size_t)((b * 4 + h) * 2 + dir) * NCH + scan_idx(cpos, dir)) * 32 + d] = __expf(L.gt[dir][d]); }
    } else {
      { f32x4 acc[4][1];
#pragma unroll
        for (int m = 0; m < 4; ++m) acc[m][0] = (f32x4){0.f, 0.f, 0.f, 0.f};
        wmm<4, 1, 1, 40, 40>(acc, &L.kg[dirw][0][0], &L.qg[dirw][s4 * 16][0], fr, fq);
        const int i = s4 * 16 + fr;
#pragma unroll
        for (int m = 0; m < 4; ++m) { float v[4];
#pragma unroll
          for (int q = 0; q < 4; ++q) { int j = m * 16 + fq * 4 + q; bool keep = dirw == 0 ? (j <= i) : (j >= i); v[q] = keep ? acc[m][0][q] : 0.f; }
          uint2 pk; pk.x = pack2(v[0], v[1]); pk.y = pack2(v[2], v[3]); *(uint2*)&L.at[dirw][i][m * 16 + fq * 4] = pk; } }
      f32x4 ao[1][4];
#pragma unroll
      for (int n = 0; n < 4; ++n) ao[0][n] = (f32x4){0.f, 0.f, 0.f, 0.f};
      wmm<1, 4, 2, 72, 72>(ao, &L.at[dirw][s4 * 16][0], &L.vt[0][0], fr, fq);
      { bf16x8 a = *(const bf16x8*)&L.qg[dirw][s4 * 16 + fr][fq * 8];
#pragma unroll
        for (int n = 0; n < 4; ++n) ao[0][n] = __builtin_amdgcn_mfma_f32_16x16x32_bf16(a, sfrag[n], ao[0][n], 0, 0, 0); }
      if (dirw == 1) {
#pragma unroll
        for (int n = 0; n < 4; ++n)
#pragma unroll
          for (int q = 0; q < 4; ++q) L.ox[s4 * 16 + fq * 4 + q][n * 16 + fr] = ao[0][n][q]; }
      LBAR();
      if (dirw == 0) {
        float ss[4] = {0.f, 0.f, 0.f, 0.f};
#pragma unroll
        for (int n = 0; n < 4; ++n)
#pragma unroll
          for (int q = 0; q < 4; ++q) { ao[0][n][q] += L.ox[s4 * 16 + fq * 4 + q][n * 16 + fr]; ss[q] += ao[0][n][q] * ao[0][n][q]; }
#pragma unroll
        for (int q = 0; q < 4; ++q) {
          ss[q] = row16_sum(ss[q]);
          ss[q] = rsqrtf(ss[q] * (1.f / 64.f) + 1e-6f); }
#pragma unroll
        for (int n = 0; n < 4; ++n) { const int c = n * 16 + fr; const float nw = nwv[n];
#pragma unroll
          for (int q = 0; q < 4; ++q) { const int f = s4 * 16 + fq * 4 + q; float og = bf2f(L.rog[f][c]);
            p.y[(size_t)(row0 + f) * D + h * 64 + c] = f2bf(ao[0][n][q] * ss[q] * nw * siluf(og)); } }
      }
    }
    LBAR();
  }
}
__device__ __forceinline__ void phase_gla_state(CParams& p, int bid, int nb, int tid_) {
  for (int i = bid * NT + tid_; i < 32 * 1024; i += nb * NT) {
    const int seq = i >> 10, e2 = (i & 1023) * 2;
    unsigned* lp = (unsigned*)(p.gla_l + (size_t)seq * NCH * 2048 + e2);
    const float* dp = p.gla_dec + (size_t)seq * NCH * 32 + (e2 & 31);
    float s0 = 0.f, s1 = 0.f;
    for (int n = 0; n < NCH; n += 12) {
      unsigned lv[12]; float2 dc[12];
#pragma unroll
      for (int q = 0; q < 12; ++q) { lv[q] = lp[(size_t)(n + q) * 1024]; dc[q] = *(const float2*)(dp + (n + q) * 32); }
#pragma unroll
      for (int q = 0; q < 12; ++q) { lp[(size_t)(n + q) * 1024] = pack2(s0, s1); s0 = s0 * dc[q].x + bf2f((bf16_t)(lv[q] & 0xffff)); s1 = s1 * dc[q].y + bf2f((bf16_t)(lv[q] >> 16)); }
    }
  }
}

__device__ __forceinline__ void phase_hy_prep(CParams& p, int layer, int bid, int nb, int tid_) {
  if (layer != 0) return;
  for (long i = (long)bid * NT + tid_; i < (long)TC * 768; i += (long)nb * NT) {
    int row = TL + (int)(i / 768), c = (int)(i % 768);
    int rm = seq_nb(row, -1, false), rp = seq_nb(row, 1, false);
    const float* w = p.hy_conv_w + (size_t)layer * 3 * 768;
    float a = p.hy_conv_b[layer * 768 + c] + w[768 + c] * bf2f(p.u[(size_t)row * NU + U_HY + c]);
    if (rm >= 0) a += w[c] * bf2f(p.u[(size_t)rm * NU + U_HY + c]);
    if (rp >= 0) a += w[2 * 768 + c] * bf2f(p.u[(size_t)rp * NU + U_HY + c]);
    p.prep[(size_t)row * 768 + c] = f2bf(a);
  }
}
template <bool TR>
__device__ __forceinline__ void phase_hy_filt(CParams& p, int layer, int L, float* filt, int bid, int nb, int tid_, char* smem) {
  constexpr int PP = 16;
  float* feats = (float*)smem;
  float* h1 = feats + PP * 36;
  float* h2 = h1 + PP * 64;
  float* h3 = h2 + PP * 64;
  float* w1s = h3 + PP * 64;
  float* w2s = w1s + 33 * 64; float* w3s = w2s + 64 * 64; float* bfs = w3s + 64 * 64;
  const int t = tid_;
  const float* w4 = p.hy_w4 + (size_t)layer * 64 * 1024;
  for (int i = t; i < 33 * 64; i += NT) w1s[i] = p.hy_w1[(size_t)layer * 33 * 64 + i];
  for (int i = t; i < 64 * 64; i += NT) { w2s[i] = p.hy_w2[(size_t)layer * 64 * 64 + i]; w3s[i] = p.hy_w3[(size_t)layer * 64 * 64 + i]; }
  if (t < 64) { bfs[t] = p.hy_b1[layer * 64 + t]; bfs[64 + t] = p.hy_b2[layer * 64 + t]; bfs[128 + t] = p.hy_b3[layer * 64 + t]; }
  if (t < 192) bfs[192 + t] = p.hy_freq[layer * 192 + t];
  __syncthreads();
  for (int blk = bid; blk < L / PP; blk += nb) {
    const int pos0 = blk * PP;
    for (int i = t; i < PP * 33; i += NT) {
      int pp = i / 33, f = i % 33; float pos = (float)(pos0 + pp); float v;
      if (f == 0) v = pos / (float)(L - 1);
      else { int j = (f - 1) & 15; float band = 1e-4f + (float)j * ((15.f - 1e-4f) / 15.f); float ang = (6.283185307179586f / (float)L) * pos * band; v = f <= 16 ? cosf(ang) : -sinf(ang); }
      feats[pp * 36 + f] = v;
    }
    __syncthreads();
    for (int i = t; i < PP * 64; i += NT) { int pp = i >> 6, j = i & 63; float a = bfs[j];
#pragma unroll
      for (int k = 0; k < 33; ++k) a += feats[pp * 36 + k] * w1s[k * 64 + j];
      h1[i] = sinf(bfs[192 + j] * a); }
    __syncthreads();
    for (int i = t; i < PP * 64; i += NT) { int pp = i >> 6, j = i & 63; float a = bfs[64 + j];
#pragma unroll 16
      for (int k = 0; k < 64; ++k) a += h1[pp * 64 + k] * w2s[k * 64 + j];
      h2[i] = sinf(bfs[256 + j] * a); }
    __syncthreads();
    for (int i = t; i < PP * 64; i += NT) { int pp = i >> 6, j = i & 63; float a = bfs[128 + j];
#pragma unroll 16
      for (int k = 0; k < 64; ++k) a += h2[pp * 64 + k] * w3s[k * 64 + j];
      h3[i] = sinf(bfs[320 + j] * a); }
    __syncthreads();
    { const int lane = t & 63, wv = t >> 6, r16 = lane & 15, kq = lane >> 4;
      float af[16];
#pragma unroll
      for (int ks = 0; ks < 16; ++ks) af[ks] = h3[r16 * 64 + ks * 4 + kq];
      const float mind = -3.0701134573253945f, maxd = -15.350567286626973f;
#pragma unroll 2
      for (int ct = 0; ct < 8; ++ct) { const int col = wv * 128 + ct * 16 + r16, c = col & 255;
        float bfr[16];
#pragma unroll
        for (int ks = 0; ks < 16; ++ks) bfr[ks] = w4[(size_t)(ks * 4 + kq) * 1024 + col];
        f32x4 acc = {0.f, 0.f, 0.f, 0.f};
#pragma unroll
        for (int ks = 0; ks < 16; ++ks) acc = __builtin_amdgcn_mfma_f32_16x16x4f32(af[ks], bfr[ks], acc, 0, 0, 0);
        const float delta = fabsf(mind + (float)c * ((maxd - mind) / 255.f));
        float fv[4];
#pragma unroll
        for (int j = 0; j < 4; ++j) { const float tn = (float)(pos0 + kq * 4 + j) / (float)(L - 1); fv[j] = acc[j] * __expf(-tn * delta); }
        if (TR) *(float4*)(filt + (size_t)col * L + pos0 + kq * 4) = make_float4(fv[0], fv[1], fv[2], fv[3]);
        else {
#pragma unroll
          for (int j = 0; j < 4; ++j) filt[(size_t)(pos0 + kq * 4 + j) * 1024 + col] = fv[j]; } } }
    __syncthreads();
  }
}
__device__ __forceinline__ void phase_hy_conv_ctx(CParams& p, int layer, int stage, int bid, int nb, int tid_, char* smem) {
  float* red = (float*)smem;
  for (int task = bid; task < NB * 16 * 4; task += nb) {
    int tid = tid_; asm volatile("" : "+v"(tid));
    const int lane = tid & 63, wv = tid >> 6;
    const int c = (task & 3) * 64 + lane, tt = (task >> 2) & 15, b = task >> 6, t0 = tt * 16, rbase = TL + b * CTX;
    const float* ff = p.filtc + stage * 512 + c;
    float acc[16], win[16];
    const int sb = wv * 32;
#pragma unroll
    for (int k = 0; k < 16; ++k) { acc[k] = 0.f; const int dl = t0 + k - sb; win[k] = dl >= 0 ? ff[(size_t)dl * 1024] : ff[(size_t)(-dl) * 1024 + 256]; }
#pragma unroll 1
    for (int s0 = sb; s0 < sb + 32; s0 += 16) {
#pragma unroll
      for (int ss = 0; ss < 16; ++ss) {
        const int s = s0 + ss; const int row = rbase + s;
        const float uv = stage == 0 ? bf2f(p.prep[(size_t)row * 768 + c]) : p.zbuf[(size_t)row * 256 + c];
#pragma unroll
        for (int k = 0; k < 16; ++k) acc[k] += win[(k + 16 - ss) & 15] * uv;
        const int dl = t0 - (s + 1);
        float nv = 0.f;
        if (s + 1 < CTX) nv = dl >= 0 ? ff[(size_t)dl * 1024] : ff[(size_t)(-dl) * 1024 + 256];
        win[(15 + 16 - ss) & 15] = nv;
      }
    }
#pragma unroll
    for (int k = 0; k < 16; ++k) red[(wv * 16 + k) * 64 + lane] = acc[k];
    __syncthreads();
    const float dsk = p.hy_d[(layer * 2 + stage) * 256 + c];
#pragma unroll
    for (int kk = 0; kk < 2; ++kk) {
      const int k = wv + 8 * kk; float a = 0.f;
#pragma unroll
      for (int w = 0; w < 8; ++w) a += red[(w * 16 + k) * 64 + lane];
      const int row = rbase + t0 + k;
      if (stage == 0) { const float vv = bf2f(p.prep[(size_t)row * 768 + c]), x1 = bf2f(p.prep[(size_t)row * 768 + 256 + c]); p.zbuf[(size_t)row * 256 + c] = x1 * (a + dsk * vv);
        p.zbuf[(size_t)(row + TC) * 256 + c] = bf2f(p.prep[(size_t)row * 768 + 512 + c]); }
      else { const float zz = p.zbuf[(size_t)row * 256 + c], x2 = p.zbuf[(size_t)(row + TC) * 256 + c]; p.y[(size_t)row * D + 256 + c] = f2bf(x2 * (a + dsk * zz)); }
    }
    __syncthreads();
  }
}

__device__ __forceinline__ void phase_hy_prep_t(CParams& p, int layer, int bid, int nb, int tid_, char* smem) {
  bf16_t (*tl)[72] = (bf16_t (*)[72])smem;
  const float* w = p.hy_conv_w + (size_t)layer * 3 * 768; const float* bs = p.hy_conv_b + layer * 768;
  for (int task = bid; task < NB * (SEQ / 64); task += nb) {
    int tid = tid_; asm volatile("" : "+v"(tid));
    const int b = task / (SEQ / 64), t0 = (task % (SEQ / 64)) * 64;
#pragma unroll 4
    for (int i = tid; i < 64 * 96; i += NT) { const int c6 = i >> 6, cq = (c6 * 43) >> 9  , ck = (i & 7) + 8 * (c6 - cq * 12), tl_ = ((i >> 3) & 7) + 8 * cq, t = t0 + tl_; const int row = b * SEQ + t;
      float o[8]; conv8(p.u, U_HY, row, t > 0 ? row - 1 : -1, t < SEQ - 1 ? row + 1 : -1, w, bs, ck * 8, o);
#pragma unroll
      for (int e = 0; e < 8; ++e) tl[ck * 8 + e][tl_] = f2bf(o[e]); }
    __syncthreads();
    for (int i = tid; i < 768 * 8; i += NT) { const int c = i >> 3, ch = i & 7; *(uint4*)(p.prep + ((size_t)(b * 768 + c)) * SEQ + t0 + ch * 8) = *(const uint4*)&tl[c][ch * 8]; }
    __syncthreads();
  }
}
#define FPAD(i) ((i) + (((i) >> 5) << 1))
struct FftLds { float2 x[16384 + 1024]; float2 t1[128]; float2 t0[128]; };
__device__ __forceinline__ float2 cmulf(float2 a, float2 b) { return make_float2(a.x * b.x - a.y * b.y, a.x * b.y + a.y * b.x); }
__device__ __forceinline__ float2 cmulcf(float2 a, float2 w) { return make_float2(a.x * w.x + a.y * w.y, a.y * w.x - a.x * w.y); }
__device__ __forceinline__ float2 caddf(float2 a, float2 b) { return make_float2(a.x + b.x, a.y + b.y); }
__device__ __forceinline__ float2 csubf(float2 a, float2 b) { return make_float2(a.x - b.x, a.y - b.y); }
template <bool INV> __device__ __forceinline__ void r4bf(float2& a0, float2& a1, float2& a2, float2& a3) {
  const float2 s0 = caddf(a0, a2), s1 = csubf(a0, a2), s2 = caddf(a1, a3), d = csubf(a1, a3);
  const float2 s3 = INV ? make_float2(-d.y, d.x) : make_float2(d.y, -d.x);
  a0 = caddf(s0, s2); a1 = caddf(s1, s3); a2 = csubf(s0, s2); a3 = csubf(s1, s3);
}
__device__ __forceinline__ float2 w16c(int k) {
  constexpr float C1 = 0.92387953251128674f, S1 = 0.38268343236508977f, R2 = 0.70710678118654752f;
  return k == 1 ? make_float2(C1, -S1) : k == 2 ? make_float2(R2, -R2) : k == 3 ? make_float2(S1, -C1) : k == 4 ? make_float2(0.f, -1.f) : k == 6 ? make_float2(-R2, -R2) :   make_float2(-C1, S1);
}
template <bool INV, int LQ, bool HALF = false>
__device__ __forceinline__ void fft_pass16(FftLds& L, int tid) {
  constexpr int Q = 1 << LQ;
#pragma unroll
  for (int i = 0; i < 2; ++i) {
    const int bf = tid + 512 * i, j = bf & (Q - 1), base = ((bf >> LQ) << (LQ + 4)) + j, k = j << (10 - LQ);
    float2 v[16];
#pragma unroll
    for (int s2 = 0; s2 < 16; ++s2) v[s2] = (HALF && !INV && s2 >= 8) ? make_float2(0.f, 0.f) : L.x[FPAD(base + s2 * Q)];
    const float2 w1 = cmulf(L.t1[k >> 7], L.t0[k & 127]), w2 = cmulf(w1, w1), w3 = cmulf(w2, w1), w4 = cmulf(w2, w2), w8 = cmulf(w4, w4), w12 = cmulf(w8, w4);
    const float2 wm[4] = {make_float2(1.f, 0.f), w1, w2, w3}, wn[4] = {make_float2(1.f, 0.f), w4, w8, w12};
    if (!INV) {
#pragma unroll
      for (int q = 0; q < 4; ++q) {
        if (HALF) { const float2 a0 = v[q], a1 = v[q + 4];
          v[q] = caddf(a0, a1); v[q + 4] = make_float2(a0.x + a1.y, a0.y - a1.x); v[q + 8] = csubf(a0, a1); v[q + 12] = make_float2(a0.x - a1.y, a0.y + a1.x); }
        else r4bf<false>(v[q], v[q + 4], v[q + 8], v[q + 12]); }
#pragma unroll
      for (int m = 1; m < 4; ++m)
#pragma unroll
        for (int q = 0; q < 4; ++q) { float2 t = v[q + 4 * m]; if (q > 0) t = cmulf(t, w16c(q * m)); v[q + 4 * m] = cmulf(t, wm[m]); }
#pragma unroll
      for (int m = 0; m < 4; ++m) { r4bf<false>(v[4 * m], v[4 * m + 1], v[4 * m + 2], v[4 * m + 3]);
#pragma unroll
        for (int n = 1; n < 4; ++n) v[4 * m + n] = cmulf(v[4 * m + n], wn[n]); }
    } else {
#pragma unroll
      for (int m = 0; m < 4; ++m) {
#pragma unroll
        for (int n = 1; n < 4; ++n) v[4 * m + n] = cmulcf(v[4 * m + n], wn[n]);
        r4bf<true>(v[4 * m], v[4 * m + 1], v[4 * m + 2], v[4 * m + 3]); }
#pragma unroll
      for (int m = 1; m < 4; ++m)
#pragma unroll
        for (int q = 0; q < 4; ++q) { float2 t = cmulcf(v[q + 4 * m], wm[m]); if (q > 0) t = cmulcf(t, w16c(q * m)); v[q + 4 * m] = t; }
#pragma unroll
      for (int q = 0; q < 4; ++q) {
        if (HALF) { const float2 c0 = v[q], c1 = v[q + 4], c2 = v[q + 8], c3 = v[q + 12]; const float2 s0 = caddf(c0, c2), s1 = csubf(c0, c2), s2 = caddf(c1, c3), d = csubf(c1, c3);
          v[q] = caddf(s0, s2); v[q + 4] = make_float2(s1.x - d.y, s1.y + d.x); }
        else r4bf<true>(v[q], v[q + 4], v[q + 8], v[q + 12]); }
    }
#pragma unroll
    for (int s2 = 0; s2 < ((HALF && INV) ? 8 : 16); ++s2) L.x[FPAD(base + s2 * Q)] = v[s2];
  }
  LBAR();
}
template <bool INV> __device__ __forceinline__ void fft_pass4_last(FftLds& L, int tid) {
#pragma unroll 2
  for (int i = 0; i < 8; ++i) { const int p0 = FPAD(4 * (tid + 512 * i));
    float4 u0 = *(const float4*)&L.x[p0], u1 = *(const float4*)&L.x[p0 + 2];
    float2 a0 = make_float2(u0.x, u0.y), a1 = make_float2(u0.z, u0.w), a2 = make_float2(u1.x, u1.y), a3 = make_float2(u1.z, u1.w);
    r4bf<INV>(a0, a1, a2, a3);
    *(float4*)&L.x[p0] = make_float4(a0.x, a0.y, a1.x, a1.y); *(float4*)&L.x[p0 + 2] = make_float4(a2.x, a2.y, a3.x, a3.y); }
  LBAR();
}
template <bool INV, bool HALF = false>
__device__ __forceinline__ void fft16k(FftLds& L, int tid) {
  if (!INV) { fft_pass16<false, 10, HALF>(L, tid); fft_pass16<false, 6>(L, tid); fft_pass16<false, 2>(L, tid); fft_pass4_last<false>(L, tid); }
  else { fft_pass4_last<true>(L, tid); fft_pass16<true, 2>(L, tid); fft_pass16<true, 6>(L, tid); fft_pass16<true, 10, HALF>(L, tid); }
}
__device__ __forceinline__ void phase_hy_fft(CParams& p, int layer, int bid, int nb, int tid_, char* smem) {
  FftLds& L = *(FftLds*)smem;
  for (int c = bid; c < 256; c += nb) {
    int tid = tid_; asm volatile("" : "+v"(tid));
    if (tid < 128) { float sn, cs; sincospif(-(float)tid / 64.f, &sn, &cs); L.t1[tid] = make_float2(cs, sn);
      sincospif(-(float)tid / 8192.f, &sn, &cs); L.t0[tid] = make_float2(cs, sn); }
#pragma unroll 1
    for (int o = 0; o < 2; ++o) {
      asm volatile("" : "+v"(tid));
      const float* hf = p.filt + (size_t)(o * 512 + c) * SEQ; const float* hb = p.filt + (size_t)(o * 512 + 256 + c) * SEQ;
      __syncthreads();
      { float4 fw[4]; float bw[16];
#pragma unroll
        for (int k = 0; k < 4; ++k) fw[k] = *(const float4*)(hf + 4 * (tid + NT * k));
#pragma unroll
        for (int k = 0; k < 16; ++k) { const int m = tid + NT * k; bw[k] = m == 0 ? 0.f : hb[SEQ - m]; }
#pragma unroll
        for (int k = 0; k < 4; ++k) { const int n = 4 * (tid + NT * k); *(float4*)&L.x[FPAD(n)] = make_float4(fw[k].x, 0.f, fw[k].y, 0.f); *(float4*)&L.x[FPAD(n + 2)] = make_float4(fw[k].z, 0.f, fw[k].w, 0.f); }
#pragma unroll
        for (int k = 0; k < 16; ++k) L.x[FPAD(SEQ + tid + NT * k)] = make_float2(bw[k], 0.f); }
      __syncthreads();
      fft16k<false>(L, tid);
      float4* specg = (float4*)(p.specg + (size_t)c * 16384);
#pragma unroll
      for (int k = 0; k < 16; ++k) { const float4 v = *(const float4*)&L.x[FPAD(2 * (tid + NT * k))]; const float sc = 1.f / 16384.f; specg[tid + NT * k] = make_float4(v.x * sc, v.y * sc, v.z * sc, v.w * sc); }
      const float dsk = p.hy_d[(layer * 2 + o) * 256 + c];
#pragma unroll 1
      for (int pr = 0; pr < 2; ++pr) {
        const int b0 = pr * 2, b1 = pr * 2 + 1;
        asm volatile("" : "+v"(tid));
        __syncthreads();
        if (o == 0) {
          const bf16_t* u0 = p.prep + ((size_t)(b0 * 768 + c)) * SEQ; const bf16_t* u1 = p.prep + ((size_t)(b1 * 768 + c)) * SEQ;
          uint2 xa[4], xb[4];
#pragma unroll
          for (int k = 0; k < 4; ++k) { xa[k] = *(const uint2*)(u0 + 4 * (tid + NT * k)); xb[k] = *(const uint2*)(u1 + 4 * (tid + NT * k)); }
#pragma unroll
          for (int k = 0; k < 4; ++k) { const int n = 4 * (tid + NT * k);
            *(float4*)&L.x[FPAD(n)] = make_float4(__uint_as_float(xa[k].x << 16), __uint_as_float(xb[k].x << 16), __uint_as_float(xa[k].x & 0xffff0000u), __uint_as_float(xb[k].x & 0xffff0000u));
            *(float4*)&L.x[FPAD(n + 2)] = make_float4(__uint_as_float(xa[k].y << 16), __uint_as_float(xb[k].y << 16), __uint_as_float(xa[k].y & 0xffff0000u), __uint_as_float(xb[k].y & 0xffff0000u)); }
        } else {
          const float* u0 = p.zbuf + ((size_t)(b0 * 256 + c)) * SEQ; const float* u1 = p.zbuf + ((size_t)(b1 * 256 + c)) * SEQ;
          float4 xa[4], xb[4];
#pragma unroll
          for (int k = 0; k < 4; ++k) { xa[k] = *(const float4*)(u0 + 4 * (tid + NT * k)); xb[k] = *(const float4*)(u1 + 4 * (tid + NT * k)); }
#pragma unroll
          for (int k = 0; k < 4; ++k) { const int n = 4 * (tid + NT * k);
            *(float4*)&L.x[FPAD(n)] = make_float4(xa[k].x, xb[k].x, xa[k].y, xb[k].y); *(float4*)&L.x[FPAD(n + 2)] = make_float4(xa[k].z, xb[k].z, xa[k].w, xb[k].w); }
        }
        __syncthreads();
        fft16k<false, true>(L, tid);
        { float4 sp[16];
#pragma unroll
          for (int k = 0; k < 16; ++k) sp[k] = specg[tid + NT * k];
#pragma unroll
          for (int k = 0; k < 16; ++k) { float4* px = (float4*)&L.x[FPAD(2 * (tid + NT * k))]; const float4 v = *px;
            *px = make_float4(v.x * sp[k].x - v.y * sp[k].y, v.x * sp[k].y + v.y * sp[k].x, v.z * sp[k].z - v.w * sp[k].w, v.z * sp[k].w + v.w * sp[k].z); } }
        __syncthreads();
        fft16k<true, true>(L, tid);
        if (o == 0) {
          const bf16_t* v0 = p.prep + ((size_t)(b0 * 768 + c)) * SEQ; const bf16_t* v1 = p.prep + ((size_t)(b1 * 768 + c)) * SEQ;
          const bf16_t* g0 = p.prep + ((size_t)(b0 * 768 + 256 + c)) * SEQ; const bf16_t* g1 = p.prep + ((size_t)(b1 * 768 + 256 + c)) * SEQ;
          float* z0 = p.zbuf + ((size_t)(b0 * 256 + c)) * SEQ; float* z1 = p.zbuf + ((size_t)(b1 * 256 + c)) * SEQ;
          uint2 va[4], vb[4], ga[4], gb[4];
#pragma unroll
          for (int k = 0; k < 4; ++k) { const int n = 4 * (tid + NT * k); va[k] = *(const uint2*)(v0 + n); vb[k] = *(const uint2*)(v1 + n); ga[k] = *(const uint2*)(g0 + n); gb[k] = *(const uint2*)(g1 + n); }
#pragma unroll
          for (int k = 0; k < 4; ++k) { const int n = 4 * (tid + NT * k); const float4 ya = *(const float4*)&L.x[FPAD(n)], yb = *(const float4*)&L.x[FPAD(n + 2)];
            float4 oa, ob;
            oa.x = __uint_as_float(ga[k].x << 16) * (ya.x + dsk * __uint_as_float(va[k].x << 16)); oa.y = __uint_as_float(ga[k].x & 0xffff0000u) * (ya.z + dsk * __uint_as_float(va[k].x & 0xffff0000u));
            oa.z = __uint_as_float(ga[k].y << 16) * (yb.x + dsk * __uint_as_float(va[k].y << 16)); oa.w = __uint_as_float(ga[k].y & 0xffff0000u) * (yb.z + dsk * __uint_as_float(va[k].y & 0xffff0000u));
            ob.x = __uint_as_float(gb[k].x << 16) * (ya.y + dsk * __uint_as_float(vb[k].x << 16)); ob.y = __uint_as_float(gb[k].x & 0xffff0000u) * (ya.w + dsk * __uint_as_float(vb[k].x & 0xffff0000u));
            ob.z = __uint_as_float(gb[k].y << 16) * (yb.y + dsk * __uint_as_float(vb[k].y << 16)); ob.w = __uint_as_float(gb[k].y & 0xffff0000u) * (yb.w + dsk * __uint_as_float(vb[k].y & 0xffff0000u));
            *(float4*)(z0 + n) = oa; *(float4*)(z1 + n) = ob; }
        } else {
          const float* z0 = p.zbuf + ((size_t)(b0 * 256 + c)) * SEQ; const float* z1 = p.zbuf + ((size_t)(b1 * 256 + c)) * SEQ;
          bf16_t* y0 = (bf16_t*)p.yt + ((size_t)(b0 * 256 + c)) * SEQ; bf16_t* y1 = (bf16_t*)p.yt + ((size_t)(b1 * 256 + c)) * SEQ;
          const bf16_t* h0 = p.prep + ((size_t)(b0 * 768 + 512 + c)) * SEQ; const bf16_t* h1 = p.prep + ((size_t)(b1 * 768 + 512 + c)) * SEQ;
          float4 za[4], zb[4]; uint2 ha[4], hb2[4];
#pragma unroll
          for (int k = 0; k < 4; ++k) { const int n = 4 * (tid + NT * k); za[k] = *(const float4*)(z0 + n); zb[k] = *(const float4*)(z1 + n); ha[k] = *(const uint2*)(h0 + n); hb2[k] = *(const uint2*)(h1 + n); }
#pragma unroll
          for (int k = 0; k < 4; ++k) { const int n = 4 * (tid + NT * k); const float4 ya = *(const float4*)&L.x[FPAD(n)], yb = *(const float4*)&L.x[FPAD(n + 2)];
            { uint2 o; o.x = pack2(__uint_as_float(ha[k].x << 16) * (ya.x + dsk * za[k].x), __uint_as_float(ha[k].x & 0xffff0000u) * (ya.z + dsk * za[k].y)); o.y = pack2(__uint_as_float(ha[k].y << 16) * (yb.x + dsk * za[k].z), __uint_as_float(ha[k].y & 0xffff0000u) * (yb.z + dsk * za[k].w)); *(uint2*)(y0 + n) = o; }
            { uint2 o; o.x = pack2(__uint_as_float(hb2[k].x << 16) * (ya.y + dsk * zb[k].x), __uint_as_float(hb2[k].x & 0xffff0000u) * (ya.w + dsk * zb[k].y)); o.y = pack2(__uint_as_float(hb2[k].y << 16) * (yb.y + dsk * zb[k].z), __uint_as_float(hb2[k].y & 0xffff0000u) * (yb.w + dsk * zb[k].w)); *(uint2*)(y1 + n) = o; } }
        }
      }
      asm volatile("s_waitcnt vmcnt(0)" ::: "memory"); __syncthreads();
    }
    __syncthreads();
  }
}
__device__ __forceinline__ void phase_hy_fin(CParams& p, int bid, int nb, int tid_, char* smem) {
  bf16_t (*tl)[264] = (bf16_t (*)[264])smem;
  for (int task = bid; task < NB * (SEQ / 64); task += nb) {
    int tid = tid_; asm volatile("" : "+v"(tid));
    const int b = task / (SEQ / 64), t0 = (task % (SEQ / 64)) * 64;
#pragma unroll
    for (int i = tid; i < 256 * 8; i += NT) { const int c = i >> 3, t8 = (i & 7) * 8;
      const uint4 v = *(const uint4*)((const bf16_t*)p.yt + ((size_t)(b * 256 + c)) * SEQ + t0 + t8);
      tl[t8][c] = (bf16_t)(v.x & 0xffff); tl[t8 + 1][c] = (bf16_t)(v.x >> 16); tl[t8 + 2][c] = (bf16_t)(v.y & 0xffff); tl[t8 + 3][c] = (bf16_t)(v.y >> 16);
      tl[t8 + 4][c] = (bf16_t)(v.z & 0xffff); tl[t8 + 5][c] = (bf16_t)(v.z >> 16); tl[t8 + 6][c] = (bf16_t)(v.w & 0xffff); tl[t8 + 7][c] = (bf16_t)(v.w >> 16); }
    __syncthreads();
    for (int i = tid; i < 64 * 32; i += NT) { const int t = i >> 5, ch = i & 31; *(uint4*)(p.y + ((size_t)b * SEQ + t0 + t) * D + 256 + ch * 8) = *(const uint4*)&tl[t][ch * 8]; }
    __syncthreads();
  }
}

__device__ __forceinline__ void phase_mb_prep(CParams& p, int layer, int bid, int nb, int tid_) {
  const int lane = tid_ & 63, wv = tid_ >> 6;
  const float* w = p.mb_conv_w + (size_t)layer * 3 * 768; const float* bs = p.mb_conv_b + layer * 768;
  Conv8W W0, W1; conv8w_load(W0, w, bs, lane * 8); conv8w_load(W1, w, bs, (lane < 32 ? lane + 64 : 0) * 8);
  constexpr int NGL = TL / 4, NGC = TC / 4;
  for (int g = bid * NW + wv; g < NGL + NGC; g += nb * NW) {
    int rw[6];
    if (g < NGL) { const int x = g & 63, yg = (g >> 6) & 31, b = g >> 11;
#pragma unroll
      for (int r = 0; r < 4; ++r) rw[1 + r] = b * SEQ + (4 * yg + r) * 64 + x; }
    else { const int r0 = TL + (g - NGL) * 4;
#pragma unroll
      for (int r = 0; r < 4; ++r) rw[1 + r] = r0 + r; }
    rw[0] = seq_nb(rw[1], -1, true); rw[5] = seq_nb(rw[4], 1, true);
    float o[2][4][8];
#pragma unroll
    for (int j = 0; j < 2; ++j) { const int ck = lane + 64 * j; if (ck < 96) conv8w4(p.u, U_MB + 256, rw, j ? W1 : W0, ck * 8, o[j]); }
#pragma unroll
    for (int r = 0; r < 4; ++r) { const int row = rw[1 + r];
#pragma unroll
      for (int j = 0; j < 2; ++j) { const int ck = lane + 64 * j; if (ck < 96) {
#pragma unroll
          for (int e = 0; e < 8; ++e) o[j][r][e] = siluf(o[j][r][e]);
          uint4 pk; pk.x = pack2(o[j][r][0], o[j][r][1]); pk.y = pack2(o[j][r][2], o[j][r][3]); pk.z = pack2(o[j][r][4], o[j][r][5]); pk.w = pack2(o[j][r][6], o[j][r][7]); *(uint4*)(p.prep + (size_t)row * 768 + ck * 8) = pk; } }
      if (lane < 8) p.dt[(size_t)row * 8 + lane] = softplusf_(bf2f(p.u[(size_t)row * NU + U_MB + 1024 + lane]) + p.mb_dt_bias[layer * 8 + lane]); }
  }
}
__device__ __forceinline__ int mb_row(int b, int cpos, int i) {
  if (cpos < 4) return TL + b * CTX + cpos * 64 + i;
  const int n = cpos - 4; return b * SEQ + ((n & 1) * 64 + i) * 64 + (n >> 1);
}
struct MbLds {
  bf16_t bimg[64][136]; bf16_t cimg[64][136];
  bf16_t bt[128][72];
  bf16_t xt[2][64][72];
  bf16_t pm[2][64][72];
  float ox[64][65];
  bf16_t ximg[64][72];
  bf16_t zimg[64][72];
  float dtv[2][64], cum[2][64], tot[2]; int rows[64];
};
template <int PASS>
__device__ __forceinline__ void phase_mb_chunk(CParams& p, int layer, int bid, int nb, int tid_, char* smem) {
  MbLds& L = *(MbLds*)smem;
  const int c_lo = (PASS == 1 && layer == DEPTH - 1) ? 4 : 0, ncp = NCH - c_lo;
  uint4 pbc[4], px = make_uint4(0u, 0u, 0u, 0u), pz = px; float pdt = 0.f, pal = 0.f;
#pragma unroll
  for (int q = 0; q < 4; ++q) pbc[q] = make_uint4(0u, 0u, 0u, 0u);
  auto mfetch = [&](int task_, int tid) { const int h_ = task_ & 3, cpos_ = c_lo + (task_ >> 2) % ncp, b_ = (task_ >> 2) / ncp, g_ = h_ >> 1;
#pragma unroll
    for (int q = 0; q < 4; ++q) { const int i = tid + q * NT, which = i >> 10, t = (i >> 4) & 63, ch = i & 15;
      pbc[q] = *(const uint4*)(p.prep + (size_t)mb_row(b_, cpos_, t) * 768 + 256 + which * 256 + g_ * 128 + ch * 8); }
    px = *(const uint4*)(p.prep + (size_t)mb_row(b_, cpos_, tid >> 3) * 768 + h_ * 64 + (tid & 7) * 8);
    if (PASS == 1) pz = *(const uint4*)(p.u + (size_t)mb_row(b_, cpos_, tid >> 3) * NU + U_MB + h_ * 64 + (tid & 7) * 8);
    if (tid < 128) { pdt = p.dt[(size_t)mb_row(b_, cpos_, tid & 63) * 8 + (tid >> 6) * 4 + h_]; pal = p.mb_a_log[layer * 8 + (tid >> 6) * 4 + h_]; } };
  if (bid < NB * ncp * 4) mfetch(bid, tid_);
  for (int task = bid; task < NB * ncp * 4; task += nb) {
    int tid = tid_; asm volatile("" : "+v"(tid));
    const int lane = tid & 63, wv = tid >> 6, fr = lane & 15, fq = lane >> 4, dirw = wv >> 2, s4 = wv & 3;
    const int h = task & 3, cpos = c_lo + (task >> 2) % ncp, b = (task >> 2) / ncp, g = h >> 1;
    bf16x8 sfo[4][4];
    float nwv[4] = {0.f, 0.f, 0.f, 0.f}, dskv = 0.f;
    if (PASS == 1) { dskv = p.mb_d[layer * 4 + h];
#pragma unroll
      for (int n = 0; n < 4; ++n) nwv[n] = p.mb_norm[layer * 256 + h * 64 + n * 16 + fr]; }
    if (PASS == 1) { const bf16_t* sb0 = p.mb_l + ((size_t)((b * 4 + h) * 2 + dirw) * NCH + scan_idx(cpos, dirw)) * 8192;
#pragma unroll
      for (int ks = 0; ks < 4; ++ks)
#pragma unroll
        for (int n = 0; n < 4; ++n) sfo[ks][n] = *(const bf16x8*)(sb0 + (n * 16 + fr) * 128 + ks * 32 + fq * 8); }
    if (tid < 64) L.rows[tid] = mb_row(b, cpos, tid);
    if (wv < 2) { const int dir = wv, i = dir ? 63 - lane : lane; const float a = -__expf(pal);
      L.dtv[dir][lane] = pdt;
      float v = (dir ? shfl_idx(pdt, 63 - lane) : pdt) * a;
      v = wave_scan(v);
      L.cum[dir][i] = v; if (lane == 63) L.tot[dir] = v; }
#pragma unroll
    for (int q = 0; q < 4; ++q) { const int i = tid + q * NT, which = i >> 10, t = (i >> 4) & 63, ch = i & 15; *(uint4*)(which ? &L.cimg[t][ch * 8] : &L.bimg[t][ch * 8]) = pbc[q]; }
    *(uint4*)&L.ximg[tid >> 3][(tid & 7) * 8] = px;
    if (PASS == 1) *(uint4*)&L.zimg[tid >> 3][(tid & 7) * 8] = pz;
    if (task + nb < NB * ncp * 4) mfetch(task + nb, tid);
    LBAR();
    if (PASS == 0) {
      for (int i = tid; i < 128 * 16; i += NT) { int n = i & 127, f0 = (i >> 7) * 4; uint2 pk;
        pk.x = (unsigned)L.bimg[f0][n] | ((unsigned)L.bimg[f0 + 1][n] << 16); pk.y = (unsigned)L.bimg[f0 + 2][n] | ((unsigned)L.bimg[f0 + 3][n] << 16);
        *(uint2*)&L.bt[n][f0] = pk; }
#pragma unroll
      for (int i = tid; i < 2 * 64 * 16; i += NT) { int pc = i & 63, f0 = ((i >> 6) & 15) * 4, dir = i >> 10; float v[4];
#pragma unroll
        for (int q = 0; q < 4; ++q) v[q] = bf2f(L.ximg[f0 + q][pc]) * L.dtv[dir][f0 + q] * __expf(L.tot[dir] - L.cum[dir][f0 + q]);
        uint2 pk; pk.x = pack2(v[0], v[1]); pk.y = pack2(v[2], v[3]); *(uint2*)&L.xt[dir][pc][f0] = pk; }
      LBAR();
      const int seq = (b * 4 + h) * 2 + dirw, nsc = scan_idx(cpos, dirw);
      f32x4 acc[2][4];
#pragma unroll
      for (int m = 0; m < 2; ++m)
#pragma unroll
        for (int n = 0; n < 4; ++n) acc[m][n] = (f32x4){0.f, 0.f, 0.f, 0.f};
      wmm<2, 4, 2, 72, 72>(acc, &L.bt[s4 * 32][0], &L.xt[dirw][0][0], fr, fq);
      bf16_t* dst = p.mb_l + ((size_t)seq * NCH + nsc) * 8192;
#pragma unroll
      for (int m = 0; m < 2; ++m)
#pragma unroll
        for (int n = 0; n < 4; ++n) { uint2 pk; pk.x = pack2(acc[m][n][0], acc[m][n][1]); pk.y = pack2(acc[m][n][2], acc[m][n][3]);
          *(uint2*)(dst + (n * 16 + fr) * 128 + s4 * 32 + m * 16 + fq * 4) = pk; }
      if (tid < 2) p.mb_dec[(size_t)((b * 4 + h) * 2 + tid) * NCH + scan_idx(cpos, tid)] = __expf(L.tot[tid]);
    } else {
#pragma unroll
      for (int i = tid; i < 64 * 16; i += NT) { int pc = i & 63, f0 = (i >> 6) * 4; uint2 pk; unsigned short v[4];
#pragma unroll
        for (int q = 0; q < 4; ++q) v[q] = L.ximg[f0 + q][pc];
        pk.x = (unsigned)v[0] | ((unsigned)v[1] << 16); pk.y = (unsigned)v[2] | ((unsigned)v[3] << 16); *(uint2*)&L.xt[0][pc][f0] = pk; }
      { f32x4 acc[4][1];
#pragma unroll
        for (int m = 0; m < 4; ++m) acc[m][0] = (f32x4){0.f, 0.f, 0.f, 0.f};
        wmm<4, 1, 4, 136, 136>(acc, &L.bimg[0][0], &L.cimg[s4 * 16][0], fr, fq);
        const int i = s4 * 16 + fr; const float ci = L.cum[dirw][i];
#pragma unroll
        for (int m = 0; m < 4; ++m) { float v[4];
          const float4 c4 = ld4pin(&L.cum[dirw][m * 16 + fq * 4]), d4 = ld4pin(&L.dtv[dirw][m * 16 + fq * 4]);
          const float cj4[4] = {c4.x, c4.y, c4.z, c4.w}, dj4[4] = {d4.x, d4.y, d4.z, d4.w};
#pragma unroll
          for (int q = 0; q < 4; ++q) { int j = m * 16 + fq * 4 + q; bool keep = dirw == 0 ? (j <= i) : (j >= i);
            v[q] = keep ? acc[m][0][q] * __expf(ci - cj4[q]) * dj4[q] : 0.f; }
          uint2 pk; pk.x = pack2(v[0], v[1]); pk.y = pack2(v[2], v[3]); *(uint2*)&L.pm[dirw][i][m * 16 + fq * 4] = pk; } }
      LBAR();
      f32x4 ao[1][4];
#pragma unroll
      for (int n = 0; n < 4; ++n) ao[0][n] = (f32x4){0.f, 0.f, 0.f, 0.f};
      {
#pragma unroll
        for (int ks = 0; ks < 4; ++ks) { bf16x8 a = *(const bf16x8*)&L.cimg[s4 * 16 + fr][ks * 32 + fq * 8];
#pragma unroll
          for (int n = 0; n < 4; ++n) ao[0][n] = __builtin_amdgcn_mfma_f32_16x16x32_bf16(a, sfo[ks][n], ao[0][n], 0, 0, 0); } }
#pragma unroll
      for (int q = 0; q < 4; ++q) { const float e = __expf(L.cum[dirw][s4 * 16 + fq * 4 + q]);
#pragma unroll
        for (int n = 0; n < 4; ++n) ao[0][n][q] *= e; }
      wmm<1, 4, 2, 72, 72>(ao, &L.pm[dirw][s4 * 16][0], &L.xt[0][0][0], fr, fq);
      if (dirw == 1) {
#pragma unroll
        for (int n = 0; n < 4; ++n)
#pragma unroll
          for (int q = 0; q < 4; ++q) L.ox[s4 * 16 + fq * 4 + q][n * 16 + fr] = ao[0][n][q]; }
      LBAR();
      if (dirw == 0) {
        const float dsk = dskv;
        float ss[4] = {0.f, 0.f, 0.f, 0.f};
#pragma unroll
        for (int n = 0; n < 4; ++n)
#pragma unroll
          for (int q = 0; q < 4; ++q) { const int i = s4 * 16 + fq * 4 + q, pc = n * 16 + fr;
            float v = (ao[0][n][q] + L.ox[i][pc] + bf2f(L.ximg[i][pc]) * dsk) * siluf(bf2f(L.zimg[i][pc])); ao[0][n][q] = v; ss[q] += v * v; }
#pragma unroll
        for (int q = 0; q < 4; ++q) {
          ss[q] = row16_sum(ss[q]);
          ss[q] = rsqrtf(ss[q] * (1.f / 64.f) + 1e-6f); }
#pragma unroll
        for (int n = 0; n < 4; ++n) { const int c = h * 64 + n * 16 + fr; const float nw = nwv[n];
#pragma unroll
          for (int q = 0; q < 4; ++q) p.y[(size_t)L.rows[s4 * 16 + fq * 4 + q] * D + 512 + c] = f2bf(ao[0][n][q] * ss[q] * nw); }
      }
    }
    LBAR();
  }
}
__device__ __forceinline__ void phase_mb_state(CParams& p, int bid, int nb, int tid_) {
  for (int i = bid * NT + tid_; i < 32 * 4096; i += nb * NT) {
    const int seq = i >> 12, e2 = (i & 4095) * 2;
    unsigned* lp = (unsigned*)(p.mb_l + (size_t)seq * NCH * 8192 + e2);
    const float* dp = p.mb_dec + (size_t)seq * NCH;
    float s0 = 0.f, s1 = 0.f;
    for (int n = 0; n < NCH; n += 12) {
      unsigned lv[12]; float dc[12];
#pragma unroll
      for (int q = 0; q < 12; ++q) { lv[q] = lp[(size_t)(n + q) * 4096]; dc[q] = dp[n + q]; }
#pragma unroll
      for (int q = 0; q < 12; ++q) { lp[(size_t)(n + q) * 4096] = pack2(s0, s1); s0 = s0 * dc[q] + bf2f((bf16_t)(lv[q] & 0xffff)); s1 = s1 * dc[q] + bf2f((bf16_t)(lv[q] >> 16)); }
    }
  }
}

__device__ __forceinline__ void phase_dn_prep(CParams& p, int layer, int bid, int nb, int tid_) {
  const int lane = tid_ & 63, wv = tid_ >> 6;
  const float* w = p.dn_conv_w + (size_t)layer * 3 * 768;
  Conv8W W0, W1; conv8w_load(W0, w, nullptr, lane * 8); conv8w_load(W1, w, nullptr, (lane < 32 ? lane + 64 : 0) * 8);
  for (int row0 = (bid * NW + wv) * 4; row0 < TT; row0 += nb * NW * 4) {
   float oo[2][4][8];
   const int rw[6] = {seq_nb(row0, -1, false), row0, row0 + 1, row0 + 2, row0 + 3, seq_nb(row0 + 3, 1, false)};
#pragma unroll
   for (int j = 0; j < 2; ++j) { const int ck = lane + 64 * j; if (ck < 96) conv8w4(p.u, U_DN, rw, j ? W1 : W0, ck * 8, oo[j]); }
#pragma unroll
   for (int r = 0; r < 4; ++r) { const int row = row0 + r;
#pragma unroll
    for (int j = 0; j < 2; ++j) { const int ck = lane + 64 * j;
      if (ck < 96) { float (&o)[8] = oo[j][r];
        float ss = 0.f;
#pragma unroll
        for (int e = 0; e < 8; ++e) { o[e] = siluf(o[e]); ss += o[e] * o[e]; }
        if (j == 0) { ss = half8_sum(ss); const float r = rsqrtf(ss + 1e-6f) * (ck < 32 ? 0.125f : 1.f);
#pragma unroll
          for (int e = 0; e < 8; ++e) o[e] *= r; }
        uint4 pk; pk.x = pack2(o[0], o[1]); pk.y = pack2(o[2], o[3]); pk.z = pack2(o[4], o[5]); pk.w = pack2(o[6], o[7]); *(uint4*)(p.prep + (size_t)row * 768 + ck * 8) = pk; } }
    if (lane < 8) {
      float beta = sigmoidf_(bf2f(p.u[(size_t)row * NU + U_DN + 1024 + lane]));
      float g = -__expf(p.dn_a_log[layer * 8 + lane]) * softplusf_(bf2f(p.u[(size_t)row * NU + U_DN + 1032 + lane]) + p.dn_dt_bias[layer * 8 + lane]);
      p.bg[(size_t)row * 16 + lane * 2] = beta; p.bg[(size_t)row * 16 + lane * 2 + 1] = g;
    }
   }
  }
}
__device__ __forceinline__ bf16_t* dn_wu_ptr(CParams& p, int which, int b, int cpos, int h) {
  if (cpos >= 4) return (which ? (bf16_t*)p.filt : (bf16_t*)p.specg) + (size_t)((b * 128 + cpos - 4) * 4 + h) * 8192;
  return p.dn_wuc + (size_t)(which * 64 + (b * 4 + cpos) * 4 + h) * 8192;
}
struct DnLds {
  bf16_t q[64][72], k[64][72], v[64][72];
  float md[2][4][16][17];
  bf16_t msb[2][64][72];
  bf16_t td[2][4][16][40];
  bf16_t tmp[8][32][40];
  bf16_t a1[2][64][72];
  bf16_t wq[2][64][72];
  bf16_t ut[2][64][72];
  float ox[64][65];
  float beta[2][64], gl[2][64], cum[2][64], tot[2];
};
template <int PASS>
__device__ __forceinline__ void phase_dn_chunk(CParams& p, int layer, int bid, int nb, int tid_, char* smem) {
  DnLds& L = *(DnLds*)smem;
  const int c_lo = (PASS == 1 && layer == DEPTH - 1) ? 4 : 0, ncp = NCH - c_lo;
  uint4 pq = make_uint4(0u, 0u, 0u, 0u), pk_ = pq, pv = pq; float2 pbg = make_float2(0.f, 0.f);
  uint4 pw0, pw1, pu0, pu1, pg;
  auto fetch = [&](int task_, int tid) { const int h_ = task_ & 3, cpos_ = c_lo + (task_ >> 2) % ncp, b_ = (task_ >> 2) / ncp; const int r0_ = chunk_row0(b_, cpos_);
    if (PASS == 1) { const bf16_t* gw = dn_wu_ptr(p, 0, b_, cpos_, h_); const bf16_t* gu = dn_wu_ptr(p, 1, b_, cpos_, h_);
      pw0 = *(const uint4*)(gw + (size_t)tid * 8); pw1 = *(const uint4*)(gw + (size_t)(tid + NT) * 8); pu0 = *(const uint4*)(gu + (size_t)tid * 8); pu1 = *(const uint4*)(gu + (size_t)(tid + NT) * 8);
      pg = *(const uint4*)(p.u + (size_t)(r0_ + (tid >> 3)) * NU + U_DN + 768 + h_ * 64 + (tid & 7) * 8); }
    if (tid < 128) pbg = *(const float2*)(p.bg + (size_t)(r0_ + (tid & 63)) * 16 + ((tid >> 6) * 4 + h_) * 2);
    const bf16_t* src = p.prep + (size_t)(r0_ + (tid >> 3)) * 768 + h_ * 64 + (tid & 7) * 8;
    if (PASS == 1) pq = *(const uint4*)src;
    pk_ = *(const uint4*)(src + 256); pv = *(const uint4*)(src + 512); };
  if (bid < NB * ncp * 4) fetch(bid, tid_);
  for (int task = bid; task < NB * ncp * 4; task += nb) {
    int tid = tid_; asm volatile("" : "+v"(tid));
    const int lane = tid & 63, wv = tid >> 6, fr = lane & 15, fq = lane >> 4, dirw = wv >> 2, s4 = wv & 3;
    const int h = task & 3, cpos = c_lo + (task >> 2) % ncp, b = (task >> 2) / ncp;
    const int row0 = chunk_row0(b, cpos);
    bf16x8 sfr[2], sfo[2][4];
    float nwv[4] = {0.f, 0.f, 0.f, 0.f};
    if (PASS == 1) {
#pragma unroll
      for (int n = 0; n < 4; ++n) nwv[n] = p.dn_norm[layer * 256 + h * 64 + n * 16 + fr]; }
    bf16_t (*ogi)[72] = (bf16_t (*)[72])&L.msb[0][0][0];
    if (PASS == 1) { const bf16_t* sb0 = p.dn_l + ((size_t)((b * 4 + h) * 2 + dirw) * NCH + scan_idx(cpos, dirw)) * 4096;
#pragma unroll
      for (int ks = 0; ks < 2; ++ks) { sfr[ks] = *(const bf16x8*)(sb0 + (s4 * 16 + fr) * 64 + ks * 32 + fq * 8);
#pragma unroll
        for (int n = 0; n < 4; ++n) sfo[ks][n] = *(const bf16x8*)(sb0 + (n * 16 + fr) * 64 + ks * 32 + fq * 8); } }
    if (tid < 128) { const int dir = tid >> 6; L.beta[dir][lane] = pbg.x;
      float v = dir ? shfl_idx(pbg.y, 63 - lane) : pbg.y;
      v = wave_scan(v);
      L.cum[dir][dir ? 63 - lane : lane] = v; if (lane == 63) L.tot[dir] = v; }
    { const int t = tid >> 3, ch = tid & 7;
      if (PASS == 1) *(uint4*)&L.q[t][ch * 8] = pq;
      *(uint4*)&L.k[t][ch * 8] = pk_; *(uint4*)&L.v[t][ch * 8] = pv;
      if (PASS == 1) { const int r = (tid >> 3) & 63;
        *(uint4*)&L.wq[0][r][ch * 8] = pw0; *(uint4*)&L.wq[1][r][ch * 8] = pw1; *(uint4*)&L.ut[0][r][ch * 8] = pu0; *(uint4*)&L.ut[1][r][ch * 8] = pu1; *(uint4*)&ogi[r][ch * 8] = pg; } }
    if (task + nb < NB * ncp * 4) fetch(task + nb, tid);
    if (PASS == 0) {
    unsigned z0 = 0u; asm volatile("" : "+v"(z0));
    const uint4 zz4 = make_uint4(z0, z0, z0, z0);
    for (int i = tid; i < (int)(sizeof(L.td) / 16); i += NT) ((uint4*)&L.td[0][0][0][0])[i] = zz4;
    for (int i = tid; i < (int)(sizeof(L.tmp) / 16); i += NT) ((uint4*)&L.tmp[0][0][0])[i] = zz4;
    for (int i = tid; i < (int)(sizeof(L.ut) / 16); i += NT) { ((uint4*)&L.ut[0][0][0])[i] = zz4; ((uint4*)&L.wq[0][0][0])[i] = zz4; }
    LBAR();
    { f32x4 acc[4][1];
#pragma unroll
      for (int m = 0; m < 4; ++m) acc[m][0] = (f32x4){0.f, 0.f, 0.f, 0.f};
      wmm<4, 1, 2, 72, 72>(acc, &L.k[0][0], &L.k[s4 * 16][0], fr, fq);
      const int j = s4 * 16 + fr; const float cj = L.cum[dirw][j]; const int sj = dirw ? 63 - j : j;
#pragma unroll
      for (int m = 0; m < 4; ++m) {
        const float4 b4 = ld4pin(&L.beta[dirw][m * 16 + fq * 4]), c4 = ld4pin(&L.cum[dirw][m * 16 + fq * 4]);
        const float bi4[4] = {b4.x, b4.y, b4.z, b4.w}, ci4[4] = {c4.x, c4.y, c4.z, c4.w};
#pragma unroll
        for (int qq = 0; qq < 4; ++qq) { const int i = m * 16 + fq * 4 + qq, si = dirw ? 63 - i : i; const bool keep = sj < si;
          const float v = keep ? bi4[qq] * acc[m][0][qq] * __expf(ci4[qq] - cj) : 0.f;
          L.msb[dirw][si][sj] = f2bf(v);
          if ((si >> 4) == (sj >> 4)) L.md[dirw][si >> 4][sj & 15][si & 15] = v; } } }
    LBAR();
    if (PASS == 0 && wv >= 2) {
      for (int i = tid - 128; i < 2 * 64 * 16; i += NT - 128) { int d = i & 63, f0 = ((i >> 6) & 15) * 4, dir = i >> 10; float v[4];
#pragma unroll
        for (int qq = 0; qq < 4; ++qq) v[qq] = bf2f(L.k[f0 + qq][d]) * __expf(L.tot[dir] - L.cum[dir][f0 + qq]);
        uint2 pk;
        if (dir == 0) { pk.x = pack2(v[0], v[1]); pk.y = pack2(v[2], v[3]); *(uint2*)&L.a1[0][d][f0] = pk; }
        else { pk.x = pack2(v[3], v[2]); pk.y = pack2(v[1], v[0]); *(uint2*)&L.a1[1][d][60 - f0] = pk; } } }
    if (wv < 2) { const int dir = wv, d = lane >> 4, c = lane & 15;
      float x[16];
#pragma unroll
      for (int s = 0; s < 16; ++s) x[s] = s == c ? 1.f : 0.f;
#pragma unroll
      for (int t = 0; t < 15; ++t) { const float xt = x[t];
#pragma unroll
        for (int s = t + 1; s < 16; ++s) x[s] -= L.md[dir][d][t][s] * xt; }
#pragma unroll
      for (int s = 0; s < 16; ++s) L.td[dir][d][s][c] = f2bf(x[s]); }
    LBAR();
    { bf16_t* xb = s4 < 2 ? &L.ut[dirw][s4 * 32][0] : &L.wq[dirw][(s4 - 2) * 32][0];
      const bf16_t (*src)[72] = s4 < 2 ? L.v : L.k; const int cb = (s4 & 1) * 32;
#pragma unroll
      for (int I = 0; I < 4; ++I) {
        f32x4 acc[1][2];
        float scv[4];
        { const int fb = dirw ? 60 - (I * 16 + fq * 4) : I * 16 + fq * 4; const float4 b4 = ld4pin(&L.beta[dirw][fb]), c4 = ld4pin(&L.cum[dirw][fb]);
          const float bb[4] = {b4.x, b4.y, b4.z, b4.w}, cc[4] = {c4.x, c4.y, c4.z, c4.w};
#pragma unroll
          for (int qq = 0; qq < 4; ++qq) { const float be = dirw ? bb[3 - qq] : bb[qq], ce = dirw ? cc[3 - qq] : cc[qq]; scv[qq] = be * (s4 < 2 ? 1.f : __expf(ce)); } }
#pragma unroll
        for (int nt = 0; nt < 2; ++nt)
#pragma unroll
          for (int qq = 0; qq < 4; ++qq) { const int s = I * 16 + fq * 4 + qq, f = dirw ? 63 - s : s;
            acc[0][nt][qq] = scv[qq] * bf2f(src[f][cb + nt * 16 + fr]); }
        if (I > 0) { f32x4 pr[1][2] = {{{0.f, 0.f, 0.f, 0.f}, {0.f, 0.f, 0.f, 0.f}}};
          wmm<1, 2, 2, 72, 72>(pr, &L.msb[dirw][I * 16][0], xb, fr, fq);
#pragma unroll
          for (int nt = 0; nt < 2; ++nt) acc[0][nt] -= pr[0][nt]; }
#pragma unroll
        for (int nt = 0; nt < 2; ++nt) { uint2 pk; pk.x = pack2(acc[0][nt][0], acc[0][nt][1]); pk.y = pack2(acc[0][nt][2], acc[0][nt][3]); *(uint2*)&L.tmp[wv][nt * 16 + fr][fq * 4] = pk; }
        asm volatile("" ::: "memory");
        f32x4 xs[1][2] = {{{0.f, 0.f, 0.f, 0.f}, {0.f, 0.f, 0.f, 0.f}}};
        wmm<1, 2, 1, 40, 40>(xs, &L.td[dirw][I][0][0], &L.tmp[wv][0][0], fr, fq);
#pragma unroll
        for (int nt = 0; nt < 2; ++nt) { uint2 pk; pk.x = pack2(xs[0][nt][0], xs[0][nt][1]); pk.y = pack2(xs[0][nt][2], xs[0][nt][3]); *(uint2*)(xb + (nt * 16 + fr) * 72 + I * 16 + fq * 4) = pk; }
        asm volatile("" ::: "memory");
      } }
    }
    if (PASS == 0) {
      LBAR();
      { bf16_t* gw = dn_wu_ptr(p, 0, b, cpos, h); bf16_t* gu = dn_wu_ptr(p, 1, b, cpos, h);
#pragma unroll
        for (int k = 0; k < 2; ++k) { const int r = (tid >> 3) & 63, ch = tid & 7;
          *(uint4*)(gw + (size_t)(tid + NT * k) * 8) = *(const uint4*)&L.wq[k][r][ch * 8]; *(uint4*)(gu + (size_t)(tid + NT * k) * 8) = *(const uint4*)&L.ut[k][r][ch * 8]; } }
      const int seq = (b * 4 + h) * 2 + dirw, nsc = scan_idx(cpos, dirw); const float dec = __expf(L.tot[dirw]);
      { f32x4 acc[4][1];
#pragma unroll
        for (int m = 0; m < 4; ++m) acc[m][0] = (f32x4){0.f, 0.f, 0.f, 0.f};
        wmm<4, 1, 2, 72, 72>(acc, &L.wq[dirw][0][0], &L.a1[dirw][s4 * 16][0], fr, fq);
        const int d = s4 * 16 + fr; bf16_t* dst = p.dn_m + ((size_t)seq * NCH + nsc) * 4096 + d * 64;
#pragma unroll
        for (int m = 0; m < 4; ++m) { float v[4];
#pragma unroll
          for (int qq = 0; qq < 4; ++qq) { int d2 = m * 16 + fq * 4 + qq; v[qq] = (d2 == d ? dec : 0.f) - acc[m][0][qq]; }
          uint2 pk; pk.x = pack2(v[0], v[1]); pk.y = pack2(v[2], v[3]); *(uint2*)(dst + m * 16 + fq * 4) = pk; } }
      { f32x4 acc[4][1];
#pragma unroll
        for (int m = 0; m < 4; ++m) acc[m][0] = (f32x4){0.f, 0.f, 0.f, 0.f};
        wmm<4, 1, 2, 72, 72>(acc, &L.a1[dirw][0][0], &L.ut[dirw][s4 * 16][0], fr, fq);
        bf16_t* dst = p.dn_l + ((size_t)seq * NCH + nsc) * 4096 + (s4 * 16 + fr) * 64;
#pragma unroll
        for (int m = 0; m < 4; ++m) { uint2 pk; pk.x = pack2(acc[m][0][0], acc[m][0][1]); pk.y = pack2(acc[m][0][2], acc[m][0][3]); *(uint2*)(dst + m * 16 + fq * 4) = pk; } }
    } else {
      LBAR();
      for (int i = tid; i < 2 * 64 * 16; i += NT) { int d = i & 63, s0 = ((i >> 6) & 15) * 4, dir = i >> 10; const uint2 wv2 = *(const uint2*)&L.wq[dir][d][s0];
        L.a1[dir][s0][d] = (bf16_t)(wv2.x & 0xffff); L.a1[dir][s0 + 1][d] = (bf16_t)(wv2.x >> 16); L.a1[dir][s0 + 2][d] = (bf16_t)(wv2.y & 0xffff); L.a1[dir][s0 + 3][d] = (bf16_t)(wv2.y >> 16); }
      LBAR();
      { f32x4 acc[4][1];
#pragma unroll
        for (int m = 0; m < 4; ++m) acc[m][0] = (f32x4){0.f, 0.f, 0.f, 0.f};
#pragma unroll
        for (int ks = 0; ks < 2; ++ks)
#pragma unroll
          for (int m = 0; m < 4; ++m) { bf16x8 a = *(const bf16x8*)&L.a1[dirw][m * 16 + fr][ks * 32 + fq * 8]; acc[m][0] = __builtin_amdgcn_mfma_f32_16x16x32_bf16(a, sfr[ks], acc[m][0], 0, 0, 0); }
        const int c = s4 * 16 + fr;
#pragma unroll
        for (int m = 0; m < 4; ++m) { uint2 uu = *(const uint2*)&L.ut[dirw][c][m * 16 + fq * 4];
          float v0 = bf2f((bf16_t)(uu.x & 0xffff)) - acc[m][0][0], v1 = bf2f((bf16_t)(uu.x >> 16)) - acc[m][0][1], v2 = bf2f((bf16_t)(uu.y & 0xffff)) - acc[m][0][2], v3 = bf2f((bf16_t)(uu.y >> 16)) - acc[m][0][3];
          uint2 pk; pk.x = pack2(v0, v1); pk.y = pack2(v2, v3); *(uint2*)&L.ut[dirw][c][m * 16 + fq * 4] = pk; } }
      { f32x4 acc[4][1];
#pragma unroll
        for (int m = 0; m < 4; ++m) acc[m][0] = (f32x4){0.f, 0.f, 0.f, 0.f};
        wmm<4, 1, 2, 72, 72>(acc, &L.k[0][0], &L.q[s4 * 16][0], fr, fq);
        const int i = s4 * 16 + fr; const float ci = L.cum[dirw][i];
#pragma unroll
        for (int m = 0; m < 4; ++m) { float v[4];
          const float4 c4 = ld4pin(&L.cum[dirw][m * 16 + fq * 4]); const float cj4[4] = {c4.x, c4.y, c4.z, c4.w};
#pragma unroll
          for (int qq = 0; qq < 4; ++qq) { int j = m * 16 + fq * 4 + qq; bool keep = dirw == 0 ? (j <= i) : (j >= i); v[qq] = keep ? acc[m][0][qq] * __expf(ci - cj4[qq]) : 0.f; }
          uint2 pk;
          if (dirw == 0) { pk.x = pack2(v[0], v[1]); pk.y = pack2(v[2], v[3]); *(uint2*)&L.wq[0][i][m * 16 + fq * 4] = pk; }
          else { pk.x = pack2(v[3], v[2]); pk.y = pack2(v[1], v[0]); *(uint2*)&L.wq[1][i][60 - m * 16 - fq * 4] = pk; } } }
      LBAR();
      f32x4 ao[1][4];
#pragma unroll
      for (int n = 0; n < 4; ++n) ao[0][n] = (f32x4){0.f, 0.f, 0.f, 0.f};
#pragma unroll
      for (int ks = 0; ks < 2; ++ks) { bf16x8 a = *(const bf16x8*)&L.q[s4 * 16 + fr][ks * 32 + fq * 8];
#pragma unroll
        for (int n = 0; n < 4; ++n) ao[0][n] = __builtin_amdgcn_mfma_f32_16x16x32_bf16(a, sfo[ks][n], ao[0][n], 0, 0, 0); }
#pragma unroll
      for (int qq = 0; qq < 4; ++qq) { const float e = __expf(L.cum[dirw][s4 * 16 + fq * 4 + qq]);
#pragma unroll
        for (int n = 0; n < 4; ++n) ao[0][n][qq] *= e; }
      wmm<1, 4, 2, 72, 72>(ao, &L.wq[dirw][s4 * 16][0], &L.ut[dirw][0][0], fr, fq);
      if (dirw == 1) {
#pragma unroll
        for (int n = 0; n < 4; ++n)
#pragma unroll
          for (int qq = 0; qq < 4; ++qq) L.ox[s4 * 16 + fq * 4 + qq][n * 16 + fr] = ao[0][n][qq]; }
      LBAR();
      if (dirw == 0) {
        float ss[4] = {0.f, 0.f, 0.f, 0.f};
#pragma unroll
        for (int n = 0; n < 4; ++n)
#pragma unroll
          for (int qq = 0; qq < 4; ++qq) { ao[0][n][qq] += L.ox[s4 * 16 + fq * 4 + qq][n * 16 + fr]; ss[qq] += ao[0][n][qq] * ao[0][n][qq]; }
#pragma unroll
        for (int qq = 0; qq < 4; ++qq) {
          ss[qq] = row16_sum(ss[qq]);
          ss[qq] = rsqrtf(ss[qq] * (1.f / 64.f) + 1e-6f); }
#pragma unroll
        for (int n = 0; n < 4; ++n) { const int c = h * 64 + n * 16 + fr; const float nw = nwv[n];
#pragma unroll
          for (int qq = 0; qq < 4; ++qq) { const int f = s4 * 16 + fq * 4 + qq;
            p.y[(size_t)(row0 + f) * D + 768 + c] = f2bf(ao[0][n][qq] * ss[qq] * nw * siluf(bf2f(ogi[f][n * 16 + fr]))); } }
      }
    }
    LBAR();
  }
}
struct DnBLds { bf16_t sh[2][64][72]; bf16_t sl[2][64][72]; };
__device__ __forceinline__ void phase_dn_state(CParams& p, int bid, int nb, int tid_, char* smem) {
  DnBLds& L = *(DnBLds*)smem;
  const int tid = tid_, lane = tid & 63, wv = tid >> 6, fr = lane & 15, fq = lane >> 4, mt = wv >> 1, ntb = (wv & 1) * 2;
  for (int seq = bid; seq < 32; seq += nb) {
    for (int i = tid; i < 64 * 72 / 2; i += NT) { ((unsigned*)&L.sh[0][0][0])[i] = 0u; ((unsigned*)&L.sl[0][0][0])[i] = 0u; }
    __syncthreads();
    f32x4 S[2] = {{0.f, 0.f, 0.f, 0.f}, {0.f, 0.f, 0.f, 0.f}};
    const bf16_t* mb = p.dn_m + (size_t)seq * NCH * 4096 + (mt * 16 + fr) * 64 + fq * 8;
    bf16x8 a[2]; a[0] = *(const bf16x8*)mb; a[1] = *(const bf16x8*)(mb + 32);
    uint2* lbase[2]; uint2 lvn[2];
#pragma unroll
    for (int t = 0; t < 2; ++t) { lbase[t] = (uint2*)(p.dn_l + (size_t)seq * NCH * 4096 + ((ntb + t) * 16 + fr) * 64 + mt * 16 + fq * 4); lvn[t] = *lbase[t]; }
    for (int n = 0; n < NCH; ++n) {
      const int cur = n & 1;
      f32x4 acc[2];
#pragma unroll
      for (int t = 0; t < 2; ++t) { uint2* lp = lbase[t] + (size_t)n * 1024;
        const uint2 lv = lvn[t]; uint2 sv; sv.x = pack2(S[t][0], S[t][1]); sv.y = pack2(S[t][2], S[t][3]); *lp = sv;
        acc[t] = (f32x4){bf2f((bf16_t)(lv.x & 0xffff)), bf2f((bf16_t)(lv.x >> 16)), bf2f((bf16_t)(lv.y & 0xffff)), bf2f((bf16_t)(lv.y >> 16))}; }
      bf16x8 an[2] = {a[0], a[1]};
      if (n + 1 < NCH) { an[0] = *(const bf16x8*)(mb + (size_t)(n + 1) * 4096); an[1] = *(const bf16x8*)(mb + (size_t)(n + 1) * 4096 + 32);
#pragma unroll
        for (int t = 0; t < 2; ++t) lvn[t] = *(lbase[t] + (size_t)(n + 1) * 1024); }
#pragma unroll
      for (int ks = 0; ks < 2; ++ks)
#pragma unroll
        for (int t = 0; t < 2; ++t) { bf16x8 bh = *(const bf16x8*)&L.sh[cur][(ntb + t) * 16 + fr][ks * 32 + fq * 8], bl = *(const bf16x8*)&L.sl[cur][(ntb + t) * 16 + fr][ks * 32 + fq * 8];
          acc[t] = __builtin_amdgcn_mfma_f32_16x16x32_bf16(a[ks], bh, acc[t], 0, 0, 0); acc[t] = __builtin_amdgcn_mfma_f32_16x16x32_bf16(a[ks], bl, acc[t], 0, 0, 0); }
#pragma unroll
      for (int t = 0; t < 2; ++t) { S[t] = acc[t]; float hi[4], lo[4];
#pragma unroll
        for (int q = 0; q < 4; ++q) { hi[q] = bf2f(f2bf(acc[t][q])); lo[q] = acc[t][q] - hi[q]; }
        uint2 ph, pl; ph.x = pack2(hi[0], hi[1]); ph.y = pack2(hi[2], hi[3]); pl.x = pack2(lo[0], lo[1]); pl.y = pack2(lo[2], lo[3]);
        *(uint2*)&L.sh[cur ^ 1][(ntb + t) * 16 + fr][mt * 16 + fq * 4] = ph; *(uint2*)&L.sl[cur ^ 1][(ntb + t) * 16 + fr][mt * 16 + fq * 4] = pl; }
      a[0] = an[0]; a[1] = an[1];
      asm volatile("s_waitcnt lgkmcnt(0)" ::: "memory"); __builtin_amdgcn_s_barrier();
    }
    __syncthreads();
  }
}

template <int H>
__device__ __forceinline__ void router_half4(const float4* rts, const float (&hv)[4][16], int lane, float (&out)[4]) {
  float lg[4][8];
#pragma unroll
  for (int r = 0; r < 4; ++r)
#pragma unroll
    for (int e = 0; e < 8; ++e) lg[r][e] = 0.f;
#pragma unroll
  for (int i = 0; i < 4; ++i)
#pragma unroll
    for (int j = 0; j < 4; ++j) {
#pragma unroll
      for (int q2 = 0; q2 < 2; ++q2) { const float4 r4 = rts[((i * 4 + j) * 4 + H * 2 + q2) * 64 + lane];
#pragma unroll
        for (int r = 0; r < 4; ++r) { const float hvv = hv[r][i * 4 + j]; lg[r][q2 * 4] += hvv * r4.x; lg[r][q2 * 4 + 1] += hvv * r4.y; lg[r][q2 * 4 + 2] += hvv * r4.z; lg[r][q2 * 4 + 3] += hvv * r4.w; }
        if (q2 == 0 || (j & 1)) asm volatile("" ::: "memory"); } }
  const bool h5 = (lane & 32) != 0, h4 = (lane & 16) != 0, h3 = (lane & 8) != 0;
#pragma unroll
  for (int r = 0; r < 4; ++r) { float a4[4], a2[2], a1;
#pragma unroll
    for (int k = 0; k < 4; ++k) a4[k] = xsum32(lg[r][k], lg[r][k + 4]);
#pragma unroll
    for (int k = 0; k < 2; ++k) a2[k] = xsum16(a4[k], a4[k + 2]);
    { const float snd = h3 ? a2[0] : a2[1], kp = h3 ? a2[1] : a2[0]; a1 = kp + dppz<0x128, 0xf>(snd); }
    a1 = half8_sum(a1);
    out[r] = a1; }
}
__device__ __forceinline__ void router_softmax_store(CParams& p, float va, float vb, int lane, int row) {
  const float mx = wave_max(fmaxf(va, vb));
  const float ea = __expf(va - mx), eb = __expf(vb - mx);
  const float den = wave_sum(ea + eb) * 0.125f;
  const float inv = 1.f / den;
  if ((lane & 7) == 0) { p.aff[(size_t)row * 16 + (lane >> 3)] = ea * inv; p.aff[(size_t)row * 16 + 8 + (lane >> 3)] = eb * inv; }
}
__device__ __forceinline__ void phase_postmix(CParams& p, int layer, int bid, int nb, int tid_, char* smem) {
  const int lane = tid_ & 63, wv = tid_ >> 6;
  float4* rts = (float4*)smem;
  for (int x = tid_; x < D * 4; x += NT) { const int ln = x & 63, q = (x >> 6) & 3, ij = x >> 8, k = (ij >> 2) * 256 + ln * 4 + (ij & 3); rts[x] = *(const float4*)(p.moe_router + ((size_t)layer * D + k) * 16 + q * 4); }
  __syncthreads();
  const int nrows = layer == 0 ? TT : TL, stride = nb * NW;
  const float* ng1 = p.norm_g + (size_t)layer * 4 * D + 1 * D;
  for (int g = bid * NW + wv; g < nrows / 4; g += stride) {
    int ln = lane; asm volatile("" : "+v"(ln));
    const int rows[4] = {4 * g, 4 * g + 1, 4 * g + 2, 4 * g + 3};
    uint2 yr[4][4]; float4 xr[4][4]; float hvs[4][16];
    const int row0 = rows[0];
    const float* xsrc = (layer == 0 ? (row0 < TL ? p.x + (size_t)row0 * D : p.ctx + (size_t)(row0 - TL) * D) : xrow_ptr(p, row0)) + ln * 4;
    const bf16_t* ysrc = p.yo + (size_t)row0 * D + ln * 4;
    float* xdst = xrow_ptr(p, row0) + ln * 4; bf16_t* hdst = p.hb + (size_t)row0 * D + ln * 4;
#pragma unroll
    for (int r = 0; r < 4; ++r) {
#pragma unroll
      for (int i = 0; i < 4; ++i) { yr[r][i] = *(const uint2*)(ysrc + r * D + i * 256); if (r < 3) xr[r][i] = *(const float4*)(xsrc + r * D + i * 256); } }
    const float* m = p.mod + (size_t)(layer * 5 + mod_idx(rows[0])) * 6 * D;
    const float* ng2 = p.norm_g + (size_t)layer * 4 * D + 2 * D;
    float rstd[4];
#pragma unroll
    for (int r = 0; r < 4; ++r) { float ss = 0.f;
#pragma unroll
      for (int i = 0; i < 4; ++i) { const uint2 v = yr[r][i]; const float a0 = __uint_as_float(v.x << 16), a1 = __uint_as_float(v.x & 0xffff0000u), a2 = __uint_as_float(v.y << 16), a3 = __uint_as_float(v.y & 0xffff0000u);
        ss += a0 * a0 + a1 * a1 + a2 * a2 + a3 * a3; }
      rstd[r] = rsqrtf(wave_sum(ss) * (1.f / D) + 1e-6f); }
    asm volatile("" ::: "memory");
#pragma unroll
    for (int i = 0; i < 4; ++i) xr[3][i] = *(const float4*)(xsrc + 3 * D + i * 256);
    float ss2[4] = {0.f, 0.f, 0.f, 0.f};
#pragma unroll
    for (int i = 0; i < 4; ++i) { const int k = i * 256 + ln * 4; const float4 gg = *(const float4*)(ng1 + k); const float4 g1 = *(const float4*)(m + 2 * D + k);
#pragma unroll
      for (int r = 0; r < 4; ++r) { const uint2 v = yr[r][i]; const float4 xo = xr[r][i]; const float rs = rstd[r];
        const float x0 = xo.x + g1.x * __uint_as_float(v.x << 16) * rs * gg.x, x1 = xo.y + g1.y * __uint_as_float(v.x & 0xffff0000u) * rs * gg.y, x2 = xo.z + g1.z * __uint_as_float(v.y << 16) * rs * gg.z, x3 = xo.w + g1.w * __uint_as_float(v.y & 0xffff0000u) * rs * gg.w;
        hvs[r][i * 4] = x0; hvs[r][i * 4 + 1] = x1; hvs[r][i * 4 + 2] = x2; hvs[r][i * 4 + 3] = x3; ss2[r] += x0 * x0 + x1 * x1 + x2 * x2 + x3 * x3;
        *(float4*)(xdst + r * D + i * 256) = make_float4(x0, x1, x2, x3); } }
#pragma unroll
    for (int r = 0; r < 4; ++r) ss2[r] = rsqrtf(wave_sum(ss2[r]) * (1.f / D) + 1e-6f);
#pragma unroll
    for (int i = 0; i < 4; ++i) { const int k = i * 256 + ln * 4; const float4 gv = *(const float4*)(ng2 + k), shv = *(const float4*)(m + 3 * D + k), scv = *(const float4*)(m + 4 * D + k);
#pragma unroll
      for (int r = 0; r < 4; ++r) { const float rs = ss2[r];
        const float h0 = hvs[r][i * 4] * rs * gv.x * (1.f + scv.x) + shv.x, h1 = hvs[r][i * 4 + 1] * rs * gv.y * (1.f + scv.y) + shv.y, h2 = hvs[r][i * 4 + 2] * rs * gv.z * (1.f + scv.z) + shv.z, h3 = hvs[r][i * 4 + 3] * rs * gv.w * (1.f + scv.w) + shv.w;
        hvs[r][i * 4] = h0; hvs[r][i * 4 + 1] = h1; hvs[r][i * 4 + 2] = h2; hvs[r][i * 4 + 3] = h3;
        uint2 pk; pk.x = pack2(h0, h1); pk.y = pack2(h2, h3); *(uint2*)(hdst + r * D + i * 256) = pk; } }
    { float va[4], vb[4]; router_half4<0>(rts, hvs, ln, va); router_half4<1>(rts, hvs, ln, vb);
#pragma unroll
      for (int r = 0; r < 4; ++r) router_softmax_store(p, va[r], vb[r], ln, rows[r]); }
  }
}
struct TkLds { unsigned key[SEQ]; unsigned hist[NW][256]; unsigned part[NT]; unsigned sh[4]; };
__device__ __forceinline__ void phase_topk(CParams& p, int layer, int bid, int nb, int tid_, char* smem) {
  TkLds& L = *(TkLds*)smem;
  if (layer == 0) for (int i = bid * NT + tid_; i < NE * 128; i += nb * NT) { const int sl = (i >> 7) * SLOTS_E + NB * CAP_L + NB * CAP_C + (i & 127); p.slot_tok[sl] = 0; p.slot_w[sl] = 0.f; }
  const int nlat = NB * NE, nctx = layer == 0 ? NB * NE : 0;
  for (int task = bid; task < nlat + nctx; task += nb) {
    int tid = tid_; asm volatile("" : "+v"(tid));
    int b, e, n, cap, rbase, sbase;
    if (task < nlat) { b = task / NE; e = task % NE; n = SEQ; cap = CAP_L; rbase = b * SEQ; sbase = e * SLOTS_E + b * CAP_L; }
    else { int j = task - nlat; b = j / NE; e = j % NE; n = CTX; cap = CAP_C; rbase = TL + b * CTX; sbase = e * SLOTS_E + NB * CAP_L + b * CAP_C; }
    __syncthreads();
#pragma unroll 16
    for (int s2 = tid; s2 < n; s2 += NT) L.key[s2] = __float_as_uint(p.aff[(size_t)(rbase + s2) * 16 + e]);
    unsigned prefix = 0u, remaining = (unsigned)cap;
#pragma unroll 1
    for (int pass = 0; pass < 4; ++pass) {
      const int shift = 24 - 8 * pass;
      for (int i = tid; i < NW * 256; i += NT) (&L.hist[0][0])[i] = 0u;
      __syncthreads();
      for (int s2 = tid; s2 < n; s2 += NT) { const unsigned k = L.key[s2]; if (pass == 0 || (k >> (shift + 8)) == (prefix >> (shift + 8))) atomicAdd(&L.hist[tid >> 6][(k >> shift) & 255u], 1u); }
      __syncthreads();
      if (tid < 256) { unsigned t = 0u;
#pragma unroll
        for (int w = 0; w < NW; ++w) t += L.hist[w][tid];
        L.hist[0][tid] = t; }
      __syncthreads();
      if (tid < 64) {
        unsigned c4[4]; unsigned loc = 0u;
#pragma unroll
        for (int e = 0; e < 4; ++e) { c4[e] = L.hist[0][255 - 4 * tid - e]; loc += c4[e]; }
        unsigned inc = loc;
#pragma unroll
        for (int o = 1; o < 64; o <<= 1) { const unsigned t = __shfl_up(inc, o); if (tid >= o) inc += t; }
        unsigned cum = inc - loc;
        const bool hit = inc >= remaining;
        const unsigned long long mk = __ballot(hit);
        const int first = mk ? __builtin_ctzll(mk) : 63;
        if (tid == first) { int e = 0;
#pragma unroll
          for (; e < 3; ++e) { if (cum + c4[e] >= remaining) break; cum += c4[e]; }
          const int d = 255 - 4 * tid - e; L.sh[0] = prefix | ((unsigned)d << shift); L.sh[1] = remaining - cum; } }
      __syncthreads();
      prefix = L.sh[0]; remaining = L.sh[1];
    }
    const int per = n / NT > 0 ? n / NT : 1, t0 = tid * per;
    unsigned cg = 0u, ce = 0u;
    if (t0 < n) for (int q = 0; q < per; ++q) { const unsigned k = L.key[t0 + q]; cg += k > prefix ? 1u : 0u; ce += k == prefix ? 1u : 0u; }
    L.part[tid] = cg | (ce << 16);
    __syncthreads();
    unsigned og = 0u, oe = 0u;
    for (int j = 0; j < NT; ++j) { const unsigned v = L.part[j]; if (j < tid) { og += v & 0xffffu; oe += v >> 16; } }
    if (t0 < n) for (int q = 0; q < per; ++q) {
      const unsigned k = L.key[t0 + q]; const int row = rbase + t0 + q;
      const bool sel = k > prefix || (k == prefix && oe < remaining);
      if (sel) { const int slot = sbase + (int)(og + (oe < remaining ? oe : remaining)); p.slot_tok[slot] = row; p.slot_w[slot] = __uint_as_float(k); p.tok_slot[(size_t)row * 16 + e] = slot; }
      else p.tok_slot[(size_t)row * 16 + e] = -1;
      og += k > prefix ? 1u : 0u; oe += k == prefix ? 1u : 0u;
    }
    __syncthreads();
  }
}
__device__ __forceinline__ void phase_combine(CParams& p, int layer, int bid, int nb, int tid_) {
  const int lane = tid_ & 63, wv = tid_ >> 6;
  const int nrows = layer == 0 ? TT : TL, stride = nb * NW, ngr = nrows / 2;
  const float* ng3 = p.norm_g + (size_t)layer * 4 * D + 3 * D;
  int slotn[2] = {-1, -1};
  { const int g0 = bid * NW + wv;
    if (g0 < ngr && lane < 16) { slotn[0] = p.tok_slot[(size_t)(2 * g0) * 16 + lane]; slotn[1] = p.tok_slot[(size_t)(2 * g0 + 1) * 16 + lane]; } }
  for (int g = bid * NW + wv; g < ngr; g += stride) {
    const int rows[2] = {2 * g, 2 * g + 1};
    int sk[2][4]; unsigned long long rest[2]; int slotv[2] = {slotn[0], slotn[1]};
    { const int gn = g + stride;
      if (gn < ngr && lane < 16) { slotn[0] = p.tok_slot[(size_t)(2 * gn) * 16 + lane]; slotn[1] = p.tok_slot[(size_t)(2 * gn + 1) * 16 + lane]; } }
#pragma unroll
    for (int r = 0; r < 2; ++r) { unsigned long long mk = __ballot(slotv[r] >= 0);
#pragma unroll
      for (int k = 0; k < 4; ++k) { if (mk) { const int bit = __builtin_ctzll(mk); sk[r][k] = __builtin_amdgcn_readlane(slotv[r], bit); mk &= mk - 1; } else sk[r][k] = -1; }
      rest[r] = mk; }
    uint2 pk[2][4][4]; float4 xr[2][4];
    float* xs0 = xrow_ptr(p, rows[0]) + lane * 4;
#pragma unroll
    for (int r = 0; r < 2; ++r) {
#pragma unroll
      for (int i = 0; i < 4; ++i) xr[r][i] = *(const float4*)(xs0 + r * D + i * 256);
#pragma unroll
      for (int k = 0; k < 4; ++k) { const int sl = sk[r][k] >= 0 ? sk[r][k] : 0;
#pragma unroll
        for (int i = 0; i < 4; ++i) pk[r][k][i] = *(const uint2*)(p.ymoe + (size_t)sl * D + i * 256 + lane * 4); } }
    float mv[2][16], rstd[2];
#pragma unroll
    for (int r = 0; r < 2; ++r) {
#pragma unroll
      for (int i = 0; i < 16; ++i) mv[r][i] = 0.f;
#pragma unroll
      for (int k = 0; k < 4; ++k) { const float wk = sk[r][k] >= 0 ? 1.f : 0.f;
#pragma unroll
        for (int i = 0; i < 4; ++i) { const uint2 q = pk[r][k][i];
          mv[r][i * 4] += wk * __uint_as_float(q.x << 16); mv[r][i * 4 + 1] += wk * __uint_as_float(q.x & 0xffff0000u); mv[r][i * 4 + 2] += wk * __uint_as_float(q.y << 16); mv[r][i * 4 + 3] += wk * __uint_as_float(q.y & 0xffff0000u); } }
      for (unsigned long long mk = rest[r]; mk; mk &= mk - 1) { const int slot = __builtin_amdgcn_readlane(slotv[r], __builtin_ctzll(mk));
#pragma unroll
        for (int i = 0; i < 4; ++i) { const uint2 q = *(const uint2*)(p.ymoe + (size_t)slot * D + i * 256 + lane * 4);
          mv[r][i * 4] += __uint_as_float(q.x << 16); mv[r][i * 4 + 1] += __uint_as_float(q.x & 0xffff0000u); mv[r][i * 4 + 2] += __uint_as_float(q.y << 16); mv[r][i * 4 + 3] += __uint_as_float(q.y & 0xffff0000u); } }
      float ss = 0.f;
#pragma unroll
      for (int i = 0; i < 16; ++i) ss += mv[r][i] * mv[r][i];
      rstd[r] = rsqrtf(wave_sum(ss) * (1.f / D) + 1e-6f); }
    const float* m = p.mod + (size_t)(layer * 5 + mod_idx(rows[0])) * 6 * D;
    float ss2[2] = {0.f, 0.f};
#pragma unroll
    for (int i = 0; i < 4; ++i) { const int k = i * 256 + lane * 4; const float4 gg = *(const float4*)(ng3 + k); const float4 g2 = *(const float4*)(m + 5 * D + k);
#pragma unroll
      for (int r = 0; r < 2; ++r) { const float4 xo = xr[r][i]; const float rs = rstd[r];
        const float x0 = xo.x + g2.x * mv[r][i * 4] * rs * gg.x, x1 = xo.y + g2.y * mv[r][i * 4 + 1] * rs * gg.y, x2 = xo.z + g2.z * mv[r][i * 4 + 2] * rs * gg.z, x3 = xo.w + g2.w * mv[r][i * 4 + 3] * rs * gg.w;
        mv[r][i * 4] = x0; mv[r][i * 4 + 1] = x1; mv[r][i * 4 + 2] = x2; mv[r][i * 4 + 3] = x3; ss2[r] += x0 * x0 + x1 * x1 + x2 * x2 + x3 * x3;
        *(float4*)(xs0 + r * D + i * 256) = make_float4(x0, x1, x2, x3); } }
    if (layer + 1 < DEPTH) {
      const float* m2 = p.mod + (size_t)((layer + 1) * 5 + mod_idx(rows[0])) * 6 * D; const float* gn = p.norm_g + (size_t)(layer + 1) * 4 * D;
      bf16_t* hdst = p.hb + (size_t)rows[0] * D + lane * 4;
#pragma unroll
      for (int r = 0; r < 2; ++r) ss2[r] = rsqrtf(wave_sum(ss2[r]) * (1.f / D) + 1e-6f);
#pragma unroll
      for (int i = 0; i < 4; ++i) { const int k = i * 256 + lane * 4; const float4 gv = *(const float4*)(gn + k), shv = *(const float4*)(m2 + k), scv = *(const float4*)(m2 + D + k);
#pragma unroll
        for (int r = 0; r < 2; ++r) { const float rs = ss2[r];
          const float h0 = mv[r][i * 4] * rs * gv.x * (1.f + scv.x) + shv.x, h1 = mv[r][i * 4 + 1] * rs * gv.y * (1.f + scv.y) + shv.y, h2 = mv[r][i * 4 + 2] * rs * gv.z * (1.f + scv.z) + shv.z, h3 = mv[r][i * 4 + 3] * rs * gv.w * (1.f + scv.w) + shv.w;
          uint2 pkh; pkh.x = pack2(h0, h1); pkh.y = pack2(h2, h3); *(uint2*)(hdst + r * D + i * 256) = pkh; } }
    }
  }
}

#define XB_TMO      128
#define XB_XCNT(j)  (256  + 64 * (j))
#define XB_XSUB(j)  (1280 + 64 * (j))
#define XB_XGEN(j)  (2304 + 64 * (j))
#define XB_TOP      3328
#define XB_TOPGEN   3392
#define XCD_BAR_WORDS 3456
#define XB_SPIN_CAP (1u << 22)
__device__ __forceinline__ unsigned xb_ld(unsigned* q)              { return __hip_atomic_load(q, __ATOMIC_RELAXED, __HIP_MEMORY_SCOPE_AGENT); }
__device__ __forceinline__ unsigned xb_add(unsigned* q, unsigned v) { return __hip_atomic_fetch_add(q, v, __ATOMIC_RELAXED, __HIP_MEMORY_SCOPE_AGENT); }
__device__ __forceinline__ unsigned xb_xcc_id() { return (unsigned)__builtin_amdgcn_s_getreg((3 << 11) | 20) & 0xFu; }
#define XB_SPIN(cond, bar) do { unsigned _sp = 0; while (cond) { __builtin_amdgcn_s_sleep(1); \
    if ((++_sp & 255u) == 0u) { if (xb_ld(&(bar)[XB_TMO])) break; if (_sp > XB_SPIN_CAP) { atomicAdd(&(bar)[XB_TMO], 1u); break; } } } } while (0)
struct XcdBarrier { unsigned* bar; unsigned x; volatile LAS unsigned* st; unsigned G; };
__device__ __forceinline__ XcdBarrier xcd_barrier_post(unsigned* bar, volatile LAS unsigned* st) {
  XcdBarrier b; b.bar = bar; b.x = xb_xcc_id(); b.st = st; b.G = 0u;
  if (threadIdx.x == 0) (void)xb_add(&bar[XB_XCNT(b.x)], 1u);
  return b;
}
__device__ __forceinline__ void xcd_barrier_complete(unsigned* bar, unsigned x, unsigned& nloc, unsigned& nx, unsigned G) {
  unsigned sum, cnt, mine, sp = 0u;
  for (;;) {
    sum = 0u; cnt = 0u; mine = 0u;
#pragma unroll
    for (unsigned j = 0; j < 16; ++j) { const unsigned c = xb_ld(&bar[XB_XCNT(j)]); sum += c; cnt += (c > 0u) ? 1u : 0u; mine = (j == x) ? c : mine; }
    if (sum == G) break;
    __builtin_amdgcn_s_sleep(1);
    if ((++sp & 255u) == 0u) { if (xb_ld(&bar[XB_TMO])) break; if (sp > XB_SPIN_CAP) { atomicAdd(&bar[XB_TMO], 1u); break; } }
  }
  nloc = mine > 0u ? mine : 1u; nx = cnt > 0u ? cnt : 1u;
}
__device__ __forceinline__ void xcd_barrier(const XcdBarrier& b) {
  asm volatile("s_waitcnt vmcnt(0)" ::: "memory");
  __syncthreads();
  if (threadIdx.x == 0) {
    unsigned* bar = b.bar;
    __builtin_amdgcn_s_waitcnt(0);
    unsigned nloc = b.st[0], nx = b.st[1];
    if (nloc == 0u) { xcd_barrier_complete(bar, b.x, nloc, nx, b.G); b.st[0] = nloc; b.st[1] = nx; }
    const unsigned old = xb_add(&bar[XB_XSUB(b.x)], 1u);
    const unsigned gen = old / nloc;
    if (old + 1u == (gen + 1u) * nloc) {
      __builtin_amdgcn_fence(__ATOMIC_RELEASE, "agent");
      asm volatile("s_waitcnt vmcnt(0)" ::: "memory");
      const unsigned og = xb_add(&bar[XB_TOP], 1u);
      const unsigned tg = og / nx;
      if (og + 1u == (tg + 1u) * nx) xb_add(&bar[XB_TOPGEN], 1u);
      else XB_SPIN(xb_ld(&bar[XB_TOPGEN]) == tg, bar);
      __builtin_amdgcn_fence(__ATOMIC_ACQUIRE, "agent");
      xb_add(&bar[XB_XGEN(b.x)], 1u);
      asm volatile("s_waitcnt vmcnt(0)" ::: "memory");
    } else {
      XB_SPIN(xb_ld(&bar[XB_XGEN(b.x)]) == gen, bar);
      __builtin_amdgcn_fence(__ATOMIC_ACQUIRE, "agent");
      asm volatile("s_waitcnt vmcnt(0)" ::: "memory");
    }
  }
  __syncthreads();
}

namespace cg = cooperative_groups;
constexpr int LDS_BYTES = 163840 - 16;
static_assert(TT % 4 == 0 && TL % 4 == 0, "postmix row groups");
static_assert(sizeof(GlaLds) <= LDS_BYTES && sizeof(MbLds) <= LDS_BYTES && sizeof(DnLds) <= LDS_BYTES && sizeof(FftLds) <= LDS_BYTES, "lds");
__global__ void __launch_bounds__(NT) mega(Params p_unused) {
  extern __shared__ __attribute__((aligned(16))) char smem[];
  cg::grid_group grid = cg::this_grid();
  int bid_s = blockIdx.x, nb_s = gridDim.x, tid_v = threadIdx.x;
  const __attribute__((address_space(4))) char* kb = (const __attribute__((address_space(4))) char*)__builtin_amdgcn_kernarg_segment_ptr();
#define p (*(CParams*)({ asm volatile("" : "+s"(kb)); kb; }))
#define BID ({ asm volatile("" : "+s"(bid_s)); bid_s; })
#define NBK ({ asm volatile("" : "+s"(nb_s)); nb_s; })
#define TID ({ asm volatile("" : "+v"(tid_v)); tid_v; })
#define LAYER ({ int l_ = l; asm volatile("" : "+s"(l_)); l_; })
#define GSYNC() do { XcdBarrier xb_; xb_.bar = p.bar; xb_.x = xb_xcc_id(); xb_.st = (volatile LAS unsigned*)(smem + LDS_BYTES); xb_.G = gridDim.x; xcd_barrier(xb_); } while (0)
#define SUBG0 32
#define SUBSYNC() do { XcdBarrier xb_; xb_.bar = p.bar + XCD_BAR_WORDS; xb_.x = xb_xcc_id(); xb_.st = (volatile LAS unsigned*)(smem + LDS_BYTES) + 2; xb_.G = gridDim.x - SUBG0; xcd_barrier(xb_); } while (0)
  volatile LAS unsigned* xst = (volatile LAS unsigned*)(smem + LDS_BYTES);
  if (threadIdx.x < 4) xst[threadIdx.x] = 0u;
  __syncthreads();
  (void)xcd_barrier_post(p.bar, xst);
  if (blockIdx.x >= SUBG0) (void)xcd_barrier_post(p.bar + XCD_BAR_WORDS, xst + 2);
  phase_conv_small(p, BID, NBK, TID, smem);
  phase_mod(p, BID, NBK, TID, smem);
  grid.sync();
  phase_prenorm0(p, BID, NBK, TID);
  phase_hy_filt<true>(p, 0, SEQ, p.filt, BID, NBK, TID, smem);
  GSYNC();
  for (int l = 0; l < DEPTH; ++l) {
    phase_gemm_in(p, LAYER, BID, NBK, TID, smem); GSYNC();
    phase_hy_prep(p, LAYER, BID, NBK, TID);
    phase_hy_prep_t(p, LAYER, BID, NBK, TID, smem);
    if (l == 0) phase_hy_filt<false>(p, LAYER, CTX, p.filtc, BID, NBK, TID, smem);
    GSYNC();
    phase_hy_fft(p, LAYER, BID, NBK, TID, smem);
    if (l == 0) phase_hy_conv_ctx(p, LAYER, 0, BID, NBK, TID, smem);
    GSYNC();
    phase_hy_fin(p, BID, NBK, TID, smem);
    if (l == 0) phase_hy_conv_ctx(p, LAYER, 1, BID, NBK, TID, smem);
    phase_mb_prep(p, LAYER, BID, NBK, TID); GSYNC();
    phase_mb_chunk<0>(p, LAYER, BID, NBK, TID, smem); GSYNC();
    phase_mb_state(p, BID, NBK, TID); GSYNC();
    phase_mb_chunk<1>(p, LAYER, BID, NBK, TID, smem); GSYNC();
    phase_dn_prep(p, LAYER, BID, NBK, TID); GSYNC();
    phase_dn_chunk<0>(p, LAYER, BID, NBK, TID, smem); GSYNC();
    { const int b_ = BID, n_ = NBK;
      if (b_ < SUBG0) phase_dn_state(p, b_, SUBG0, TID, smem);
      else { phase_gla_chunk<0>(p, LAYER, b_ - SUBG0, n_ - SUBG0, TID, smem); SUBSYNC();
             phase_gla_state(p, b_ - SUBG0, n_ - SUBG0, TID); SUBSYNC();
             phase_gla_chunk<1>(p, LAYER, b_ - SUBG0, n_ - SUBG0, TID, smem); } }
    GSYNC();
    phase_dn_chunk<1>(p, LAYER, BID, NBK, TID, smem); GSYNC();
    phase_gemm_out(p, LAYER, BID, NBK, TID, smem);
    const int ou_ = ((l == 0 ? TT : TL) / 256) * (D / 256), orem_ = ou_ % NBK, cv_early = (orem_ != 0 && NBK - orem_ >= 128) ? (NE * 192 * 5) / 8 : 0;
    { const int b_ = BID, n_ = NBK; if (cv_early > 0 && b_ >= orem_) phase_conv_moe(p, LAYER, b_ - orem_, n_ - orem_, TID, smem, 0, cv_early); }
    GSYNC();
    phase_postmix(p, LAYER, BID, NBK, TID, smem); GSYNC();
    phase_topk(p, LAYER, BID, NBK, TID, smem);
    { const int b_ = BID, n_ = NBK, k0 = n_ > 2 * NB * NE ? NB * NE : 0;
      if (b_ >= k0) phase_conv_moe(p, LAYER, b_ - k0, n_ - k0, TID, smem, cv_early, NE * 192); }
    GSYNC();
    phase_gemm_moe1(p, LAYER, BID, NBK, TID, smem); GSYNC();
    phase_gemm_moe2(p, LAYER, BID, NBK, TID, smem);
    if (l + 1 < DEPTH) {
      const int b_ = BID, n_ = NBK, units = NE * (l == 0 ? 17 : 16) * 4, rem = units % n_;
      if (b_ >= rem) phase_hy_filt<true>(p, l + 1, SEQ, p.filt, b_ - rem, n_ - rem, TID, smem); }
    GSYNC();
    phase_combine(p, LAYER, BID, NBK, TID);
    if (l + 1 < DEPTH) GSYNC();
  }
#undef p
}

extern "C" void kernel_launch(void* const* d_in, const int* in_sizes, int n_in, void* d_out, int out_size, void* d_ws, size_t ws_size, hipStream_t stream) {
  Params p{};
  const float** fp = (const float**)&p;
  for (int i = 0; i < 37; ++i) fp[i] = (const float*)d_in[i];
  p.out = (float*)d_out;
  char* ws = (char*)d_ws; size_t off = 0;
  auto alloc = [&](size_t bytes) { size_t o = off; off += (bytes + 255) & ~(size_t)255; return ws + o; };
  p.win_t = (bf16_t*)alloc((size_t)DEPTH * NUP * D * 2);
  p.wout_t = (bf16_t*)alloc((size_t)DEPTH * D * D * 2);
  p.mod = (float*)alloc((size_t)DEPTH * 5 * 6 * D * 4);
  p.xc = (float*)alloc((size_t)TC * D * 4);
  p.aff = (float*)alloc((size_t)TT * 16 * 4);
  p.slot_tok = (int*)alloc((size_t)NSLOT * 4);
  p.slot_w = (float*)alloc((size_t)NSLOT * 4);
  p.tok_slot = (int*)alloc((size_t)TT * 16 * 4);
  p.dt = (float*)alloc((size_t)TT * 8 * 4);
  p.bg = (float*)alloc((size_t)TT * 16 * 4);
  p.filt = (float*)alloc((size_t)SEQ * 1024 * 4);
  p.filtc = (float*)alloc((size_t)CTX * 1024 * 4);
  p.hb = (bf16_t*)alloc((size_t)TT * D * 2);
  p.prep = p.hb;
  char* R = alloc((size_t)NSLOT * D * 2 * 2);
  p.u = (bf16_t*)R; p.yo = (bf16_t*)R; p.act = (bf16_t*)R; p.ymoe = (bf16_t*)(R + (size_t)NSLOT * D * 2);
  p.y = (bf16_t*)alloc((size_t)TT * D * 2);
  char* W2 = alloc((size_t)NE * 3 * D * D * 2);
  p.wgu_t = (bf16_t*)W2; p.wdn_t = (bf16_t*)(W2 + (size_t)NE * 2 * D * D * 2);
  p.obuf = (float*)W2; p.zbuf = (float*)W2; p.yt = (float*)(W2 + (size_t)36 * 1024 * 1024);
  p.gla_l = (bf16_t*)(W2 + (size_t)72 * 1024 * 1024);
  p.gla_dec = (float*)alloc((size_t)32 * NCH * 32 * 4);
  p.bar = (unsigned*)alloc((size_t)2 * XCD_BAR_WORDS * 4);
  p.specg = (float2*)alloc((size_t)256 * 16384 * 8);
  p.mb_l = (bf16_t*)W2;
  p.mb_dec = (float*)alloc((size_t)32 * NCH * 4);
  p.dn_wuc = (bf16_t*)alloc((size_t)2 * 64 * 8192 * 2);
  p.dn_m = (bf16_t*)W2; p.dn_l = (bf16_t*)(W2 + (size_t)32 * NCH * 4096 * 2);
  if (off > ws_size) { fprintf(stderr, "workspace too small: need %zu have %zu\n", off, ws_size); return; }

  static int grid_blocks = 0;
  if (!grid_blocks) {
    int dev = 0, cus = 0, per_cu = 0;
    hipGetDevice(&dev);
    hipDeviceGetAttribute(&cus, hipDeviceAttributeMultiprocessorCount, dev);
    hipFuncSetAttribute((const void*)mega, hipFuncAttributeMaxDynamicSharedMemorySize, LDS_BYTES + 16);
    hipOccupancyMaxActiveBlocksPerMultiprocessor(&per_cu, mega, NT, LDS_BYTES + 16);
    if (per_cu > 1) per_cu = 1;
    grid_blocks = cus * per_cu;
  }
  hipMemsetAsync(p.bar, 0, (size_t)2 * XCD_BAR_WORDS * 4, stream);
  void* args[] = {&p};
  hipError_t e = hipLaunchCooperativeKernel((void*)mega, dim3(grid_blocks), dim3(NT), args, LDS_BYTES + 16, stream);
  if (e != hipSuccess) fprintf(stderr, "cooperative launch failed: %s (grid %d)\n", hipGetErrorString(e), grid_blocks);
}
```
